# Optimizing an MI355X kernel written in HIP

```python
import math
import jax, jax.numpy as jnp
from jax import lax
import numpy as np

D_MODEL = 2048
BATCH = 4
SEQ = 4096
DEPTH = 2

CHUNK = 64
Q_BLOCK = 128
HEAD_DIM = 128
EPS = 1e-6
A_HEADS = 6
A_DIM = A_HEADS * HEAD_DIM
B_HEADS = 6
B_Q_LORA = 512
B_KV_LORA = 256
B_NOPE = 128
B_ROPE = 64
B_V = 128
B_DIM = B_HEADS * B_V
ROPE_THETA = 10000.0
C_HEADS = 4
C_QK = 64
C_V = 2 * C_QK
C_DIM = C_HEADS * C_V
REL_BUCKETS = 32
REL_MAX_DIST = 128
D_MIX = A_DIM + B_DIM + C_DIM
IN_SIZES = (A_DIM, A_DIM, A_DIM, A_HEADS, A_DIM,
            B_Q_LORA, B_KV_LORA, B_ROPE, B_DIM,
            2 * C_HEADS * C_QK, 2 * C_HEADS * C_QK, C_DIM, C_DIM)
IN_OFFSETS = tuple(int(v) for v in np.cumsum(IN_SIZES)[:-1])
N_IN = int(sum(IN_SIZES))

kernel_name = "hybrid_fox_mla_diff_stream_encoder"


def _rms_norm(x, g):
    xf = x.astype(jnp.float32)
    y = xf * lax.rsqrt(jnp.mean(xf * xf, axis=-1, keepdims=True) + EPS)
    return (y * g.astype(jnp.float32)).astype(x.dtype)


def _rope(x, pos):
    half = x.shape[-1] // 2
    inv = ROPE_THETA ** (-jnp.arange(half, dtype=jnp.float32) / half)
    ang = pos.astype(jnp.float32)[:, None] * inv[None, :]
    cos = jnp.cos(ang)[None, :, None, :].astype(x.dtype)
    sin = jnp.sin(ang)[None, :, None, :].astype(x.dtype)
    x1, x2 = x[..., :half], x[..., half:]
    return jnp.concatenate([x1 * cos - x2 * sin, x1 * sin + x2 * cos], axis=-1)


def _sweep(block_fn, seq):
    return jnp.concatenate([block_fn(i * Q_BLOCK, (i + 1) * Q_BLOCK)
                            for i in range(seq // Q_BLOCK)], axis=1)


def _chunk_mask(q0, q1):
    tq = jnp.arange(q0, q1) // CHUNK
    tk = jnp.arange(q1) // CHUNK
    return tk[None, :] <= tq[:, None]


def _frame_mask(q0, q1):
    return jnp.arange(q1)[None, :] <= jnp.arange(q0, q1)[:, None]


def _t5_bucket(rel):
    nb = REL_BUCKETS // 2
    max_exact = nb // 2
    ret = (rel > 0).astype(jnp.int32) * nb
    n = jnp.abs(rel)
    nf = jnp.maximum(n, 1).astype(jnp.float32)
    large = max_exact + (jnp.log(nf / max_exact) / math.log(REL_MAX_DIST / max_exact)
                         * (nb - max_exact)).astype(jnp.int32)
    large = jnp.minimum(large, nb - 1)
    return ret + jnp.where(n < max_exact, n, large)


def _fox_attention(q, k, v, cum_logf):
    scale = 1.0 / math.sqrt(q.shape[-1])
    cum_t = jnp.transpose(cum_logf, (0, 2, 1))

    def blk(q0, q1):
        s = jnp.einsum('bqhd,bkhd->bhqk', q[:, q0:q1], k[:, :q1]).astype(jnp.float32) * scale
        decay = cum_t[:, :, q0:q1, None] - cum_t[:, :, None, :q1]
        s = jnp.where(_frame_mask(q0, q1), s + decay, -jnp.inf)
        p = jax.nn.softmax(s, axis=-1).astype(v.dtype)
        return jnp.einsum('bhqk,bkhd->bqhd', p, v[:, :q1])

    return _sweep(blk, q.shape[1])


def _mla_attention(q_nope, q_rope, k_nope, k_rope, v):
    scale = 1.0 / math.sqrt(B_NOPE + B_ROPE)

    def blk(q0, q1):
        s = (jnp.einsum('bqhd,bkhd->bhqk', q_nope[:, q0:q1], k_nope[:, :q1])
             + jnp.einsum('bqhr,bkr->bhqk', q_rope[:, q0:q1], k_rope[:, :q1]))
        s = jnp.where(_chunk_mask(q0, q1), s.astype(jnp.float32) * scale, -jnp.inf)
        p = jax.nn.softmax(s, axis=-1).astype(v.dtype)
        return jnp.einsum('bhqk,bkhd->bqhd', p, v[:, :q1])

    return _sweep(blk, q_nope.shape[1])


def _diff_attention(q1, q2, k1, k2, v, lam, rel_bias):
    scale = 1.0 / math.sqrt(q1.shape[-1])

    def blk(q0, q1_):
        rel = jnp.arange(q1_)[None, :] - jnp.arange(q0, q1_)[:, None]
        bias = jnp.transpose(rel_bias[_t5_bucket(rel)], (2, 0, 1)).astype(jnp.float32)
        mask = _chunk_mask(q0, q1_)
        s1 = jnp.einsum('bqhd,bkhd->bhqk', q1[:, q0:q1_], k1[:, :q1_]).astype(jnp.float32) * scale + bias
        s2 = jnp.einsum('bqhd,bkhd->bhqk', q2[:, q0:q1_], k2[:, :q1_]).astype(jnp.float32) * scale + bias
        p1 = jax.nn.softmax(jnp.where(mask, s1, -jnp.inf), axis=-1)
        p2 = jax.nn.softmax(jnp.where(mask, s2, -jnp.inf), axis=-1)
        w = (p1 - lam * p2).astype(v.dtype)
        return jnp.einsum('bhqk,bkhd->bqhd', w, v[:, :q1_])

    return _sweep(blk, q1.shape[1])


def setup_inputs(seed: int = 0) -> dict:
    key = jax.random.key(seed)
    ks = jax.random.split(key, 20)
    nrm = lambda k, shape, s: jax.random.normal(k, shape, jnp.float32) * s
    return {
        "x": nrm(ks[0], (BATCH, SEQ, D_MODEL), 1.0),
        "norm_g": 1.0 + nrm(ks[1], (DEPTH, D_MODEL), 0.02),
        "w_in": nrm(ks[2], (DEPTH, D_MODEL, N_IN), D_MODEL ** -0.5),
        "b_forget": jax.random.uniform(ks[3], (DEPTH, A_HEADS), jnp.float32, 1.0, 4.0),
        "mla_q_norm_g": 1.0 + nrm(ks[4], (DEPTH, B_Q_LORA), 0.02),
        "w_uq": nrm(ks[5], (DEPTH, B_Q_LORA, B_HEADS * (B_NOPE + B_ROPE)), B_Q_LORA ** -0.5),
        "mla_kv_norm_g": 1.0 + nrm(ks[6], (DEPTH, B_KV_LORA), 0.02),
        "w_ukv": nrm(ks[7], (DEPTH, B_KV_LORA, B_HEADS * (B_NOPE + B_V)), B_KV_LORA ** -0.5),
        "lambda_q1": nrm(ks[8], (DEPTH, C_QK), 0.1),
        "lambda_k1": nrm(ks[9], (DEPTH, C_QK), 0.1),
        "lambda_q2": nrm(ks[10], (DEPTH, C_QK), 0.1),
        "lambda_k2": nrm(ks[11], (DEPTH, C_QK), 0.1),
        "diff_subln_g": 1.0 + nrm(ks[12], (DEPTH, C_V), 0.02),
        "rel_bias": nrm(ks[13], (REL_BUCKETS, C_HEADS), 0.5),
        "w_out": nrm(ks[14], (DEPTH, D_MIX, D_MODEL), D_MIX ** -0.5),
        "final_norm_g": 1.0 + nrm(ks[15], (D_MODEL,), 0.02),
    }


def reference(x, norm_g, w_in, b_forget, mla_q_norm_g, w_uq, mla_kv_norm_g, w_ukv,
              lambda_q1, lambda_k1, lambda_q2, lambda_k2, diff_subln_g, rel_bias,
              w_out, final_norm_g):
    Bsz, S, _ = x.shape
    pos = jnp.arange(S)
    for l in range(DEPTH):
        h = _rms_norm(x, norm_g[l])
        proj = jnp.einsum('bsd,dn->bsn', h, w_in[l])
        (a_q, a_k, a_v, a_f, a_gate,
         b_cq, b_ckv, b_krope, b_gate,
         c_q, c_k, c_v, c_gate) = jnp.split(proj, IN_OFFSETS, axis=-1)

        logf = jax.nn.log_sigmoid((a_f + b_forget[l]).astype(jnp.float32))
        cum_logf = jnp.cumsum(logf, axis=1)
        a_out = _fox_attention(a_q.reshape(Bsz, S, A_HEADS, HEAD_DIM),
                               a_k.reshape(Bsz, S, A_HEADS, HEAD_DIM),
                               a_v.reshape(Bsz, S, A_HEADS, HEAD_DIM), cum_logf)
        a_out = a_out.reshape(Bsz, S, A_DIM) * jax.nn.silu(a_gate)

        q = jnp.einsum('bsr,rn->bsn', _rms_norm(b_cq, mla_q_norm_g[l]), w_uq[l])
        q = q.reshape(Bsz, S, B_HEADS, B_NOPE + B_ROPE)
        q_nope, q_rope = q[..., :B_NOPE], _rope(q[..., B_NOPE:], pos)
        kv = jnp.einsum('bsr,rn->bsn', _rms_norm(b_ckv, mla_kv_norm_g[l]), w_ukv[l])
        kv = kv.reshape(Bsz, S, B_HEADS, B_NOPE + B_V)
        k_nope, b_v = kv[..., :B_NOPE], kv[..., B_NOPE:]
        k_rope = _rope(b_krope[:, :, None, :], pos)[:, :, 0, :]
        b_out = _mla_attention(q_nope, q_rope, k_nope, k_rope, b_v)
        b_out = b_out.reshape(Bsz, S, B_DIM) * jax.nn.silu(b_gate)

        lam_init = 0.8 - 0.6 * math.exp(-0.3 * l)
        lam = (jnp.exp(jnp.sum(lambda_q1[l].astype(jnp.float32) * lambda_k1[l].astype(jnp.float32)))
               - jnp.exp(jnp.sum(lambda_q2[l].astype(jnp.float32) * lambda_k2[l].astype(jnp.float32)))
               + lam_init)
        cq = c_q.reshape(Bsz, S, C_HEADS, 2, C_QK)
        ck = c_k.reshape(Bsz, S, C_HEADS, 2, C_QK)
        c_out = _diff_attention(cq[..., 0, :], cq[..., 1, :], ck[..., 0, :], ck[..., 1, :],
                                c_v.reshape(Bsz, S, C_HEADS, C_V), lam, rel_bias)
        c_out = _rms_norm(c_out, diff_subln_g[l]) * (1.0 - lam_init)
        c_out = c_out.reshape(Bsz, S, C_DIM) * jax.nn.silu(c_gate)

        mixed = jnp.concatenate([a_out, b_out, c_out], axis=-1)
        x = x + jnp.einsum('bsm,md->bsd', mixed, w_out[l])
    return _rms_norm(x, final_norm_g)
```

```cpp
#include <hip/hip_runtime.h>
#include <hip/hip_cooperative_groups.h>
#include <cstdio>
#include <cstdint>
#include <cmath>
namespace cg = cooperative_groups;

constexpr int NB = 4, SEQ = 4096, DM = 2048, M = NB * SEQ, DEPTH = 2;
constexpr int NIN = 6726, NIN_PAD = 6912;
constexpr int NUQ_PAD = 1280, NUKV = 1536;
constexpr float EPS = 1e-6f;

constexpr size_t MiB = 1u << 20;
constexpr size_t WS_CTL = 0, CTL_ZERO_BYTES = 1 * MiB;
constexpr size_t WS_WIN = 1 * MiB;
constexpr size_t WS_WUQ = WS_WIN + 54 * MiB;
constexpr size_t WS_WUKV = WS_WUQ + 5 * MiB / 2;
constexpr size_t WS_WOUT = WS_WUKV + 3 * MiB / 2;
constexpr size_t WS_ROPE = WS_WOUT + 16 * MiB;
constexpr size_t WS_XSS = WS_ROPE + 1 * MiB;
constexpr size_t WS_LOGF = WS_XSS + 2 * MiB;
constexpr size_t WS_CUMT = WS_LOGF + MiB / 2;
constexpr size_t WS_CQSS = WS_CUMT + MiB / 2;
constexpr size_t WS_CKVSS = WS_CQSS + MiB / 2;
constexpr size_t WS_XB = WS_CKVSS + MiB / 2;
constexpr size_t WS_G = WS_XB + 64 * MiB;
constexpr size_t WS_AQ = WS_G + 64 * MiB, WS_AK = WS_AQ + 24 * MiB, WS_AV = WS_AK + 24 * MiB;
constexpr size_t WS_CQ = WS_AV + 24 * MiB;
constexpr size_t WS_CKV = WS_CQ + 16 * MiB;
constexpr size_t WS_QB = WS_CKV + 8 * MiB, WS_KB = WS_QB + 36 * MiB, WS_VB = WS_KB + 36 * MiB;
constexpr size_t WS_CQ2 = WS_VB + 24 * MiB, WS_CK2 = WS_CQ2 + 16 * MiB, WS_CV = WS_CK2 + 16 * MiB;
constexpr size_t WS_END = WS_CV + 16 * MiB;
static_assert(WS_END <= 512 * MiB, "workspace map");

constexpr int RING_BYTES = 131072, LDS_BYTES = 147456;
constexpr int NWAVES = 8, NTHREADS = 512;

namespace pg8 {
#define PG8_LAS __attribute__((address_space(3)))
typedef unsigned short bf16_t;
typedef short bf16x8 __attribute__((ext_vector_type(8)));
typedef float f32x4 __attribute__((ext_vector_type(4)));
typedef unsigned u32x4 __attribute__((ext_vector_type(4)));
constexpr int BM = 256, BK = 64, HALF = 128, HTB = HALF * BK * 2  , STAGE_BYTES = 8 * HTB, NXCD = 8, WGM = 8;

__host__ __device__ __forceinline__ int lds_byte(int r, int c) { const int st = (r >> 4) * 2 + (c >> 5), rr = r & 15, cc = c & 31, ob = rr * 64 + cc * 2; return st * 1024 + (ob ^ (((ob >> 9) & 1) << 5)); }
__host__ __device__ __forceinline__ void stage_rc(int b, int& R, int& C) { const int st = b / 1024, sb = b % 1024, swz = sb ^ (((sb >> 9) & 1) << 5); R = (st >> 1) * 16 + swz / 64; C = (st & 1) * 32 + (swz % 64) / 2; }
__host__ __device__ __forceinline__ int perm32(int rho) { const int n = rho >> 4, i = rho & 15; return 8 * (i >> 2) + 4 * n + (i & 3); }

struct Unit { int pm, pn; };
struct Gemm { const bf16_t* A; const bf16_t* Bt; int M, N, K; };

struct StaticOrder {
    int nM, nN, nwg, G, c;
    __host__ __device__ void init(int M, int N, int G_, int c_) { nM = M / BM; nN = N / BM; nwg = nM * nN; G = G_; c = c_; }
    __host__ __device__ bool next(int i, Unit& u) const {
        const long L = (long)i * G + c; if (L >= nwg) return false;
        int wgid = (int)L; { const int q = nwg / NXCD, r = nwg % NXCD, xcd = wgid % NXCD, off = wgid / NXCD; wgid = (xcd < r ? xcd * (q + 1) : r * (q + 1) + (xcd - r) * q) + off; }
        const int nig = WGM * nN, gid = wgid / nig, fm = gid * WGM, gsz = (nM - fm) < WGM ? (nM - fm) : WGM;
        u.pm = fm + ((wgid % nig) % gsz); u.pn = (wgid % nig) / gsz; return true;
    }
    __device__ __forceinline__ void a_ready(const Unit&) const {}
    __device__ __forceinline__ void done(const Unit&) const {}
};


__device__ __forceinline__ unsigned cvt_pk_bf16(float lo, float hi) { unsigned r; asm volatile("v_cvt_pk_bf16_f32 %0, %1, %2" : "=v"(r) : "v"(lo), "v"(hi)); return r; }
typedef float f32x2 __attribute__((ext_vector_type(2)));
typedef unsigned u32x2 __attribute__((ext_vector_type(2)));
constexpr float RMS_EPS = 1e-6f;
__device__ __forceinline__ float silu_f(float v) { return v / (1.0f + __expf(-v)); }
__device__ __forceinline__ u32x4 pack8v(f32x4 a, f32x4 b) { u32x4 w; w.x = cvt_pk_bf16(a[0], a[1]); w.y = cvt_pk_bf16(a[2], a[3]); w.z = cvt_pk_bf16(b[0], b[1]); w.w = cvt_pk_bf16(b[2], b[3]); return w; }
__device__ __forceinline__ void rope4(f32x4 v0, f32x4 v1, f32x4 cs, f32x4 sn, u32x2& lo, u32x2& hi) {
    const float a0 = v0[0], b0 = v0[1], a1 = v0[2], b1 = v0[3], a2 = v1[0], b2 = v1[1], a3 = v1[2], b3 = v1[3];
    lo.x = cvt_pk_bf16(a0 * cs[0] - b0 * sn[0], a1 * cs[1] - b1 * sn[1]); lo.y = cvt_pk_bf16(a2 * cs[2] - b2 * sn[2], a3 * cs[3] - b3 * sn[3]);
    hi.x = cvt_pk_bf16(a0 * sn[0] + b0 * cs[0], a1 * sn[1] + b1 * cs[1]); hi.y = cvt_pk_bf16(a2 * sn[2] + b2 * cs[2], a3 * sn[3] + b3 * cs[3]);
}

struct EpiIn {
    static constexpr bool PERM = true, AFTER_DRAIN = false;
    unsigned char* ws;
    const float* bforget;
    __device__ __forceinline__ void operator()(const f32x4 (&acc)[2][2][4][2], const Unit& u, int wr, int wc, int fr, int fq) const {
        const int row0 = u.pm * BM + wr * 64 + fr; const int pn = u.pn;
        const float* xss = (const float*)(ws + WS_XSS);
        float rs[2][4];
#pragma unroll
        for (int ai = 0; ai < 2; ++ai)
#pragma unroll
            for (int m = 0; m < 4; ++m) { const int row = row0 + ai * HALF + m * 16; const f32x4* p = (const f32x4*)(xss + (size_t)row * 32 + fq * 8);
                const f32x4 a = p[0], b = p[1]; float s = ((a[0] + a[1]) + (a[2] + a[3])) + ((b[0] + b[1]) + (b[2] + b[3]));
                s += __shfl_xor(s, 16); s += __shfl_xor(s, 32); rs[ai][m] = rsqrtf(s * (1.0f / 2048.0f) + RMS_EPS); }
        if (pn < 26) {
            size_t doff; int ld, cb, kind = 0; size_t ssoff = 0; int sld = 0, slot = 0;
            if (pn < 3) { doff = WS_AQ; ld = 768; cb = pn * 256; }
            else if (pn < 6) { doff = WS_AK; ld = 768; cb = (pn - 3) * 256; }
            else if (pn < 9) { doff = WS_AV; ld = 768; cb = (pn - 6) * 256; }
            else if (pn < 12) { doff = WS_G; ld = 2048; cb = (pn - 9) * 256; kind = 1; }
            else if (pn < 14) { doff = WS_CQ; ld = 512; cb = (pn - 12) * 256; kind = 2; ssoff = WS_CQSS; sld = 8; slot = (pn - 12) * 4 + wc; }
            else if (pn == 14) { doff = WS_CKV; ld = 256; cb = 0; kind = 2; ssoff = WS_CKVSS; sld = 4; slot = wc; }
            else if (pn < 18) { doff = WS_G; ld = 2048; cb = 768 + (pn - 15) * 256; kind = 1; }
            else if (pn < 20) { doff = WS_CQ2; ld = 512; cb = (pn - 18) * 256; }
            else if (pn < 22) { doff = WS_CK2; ld = 512; cb = (pn - 20) * 256; }
            else if (pn < 24) { doff = WS_CV; ld = 512; cb = (pn - 22) * 256; }
            else { doff = WS_G; ld = 2048; cb = 1536 + (pn - 24) * 256; kind = 1; }
            bf16_t* dst = (bf16_t*)(ws + doff); float* ss = (float*)(ws + ssoff);
            const int col0 = cb + wc * 32 + 8 * fq;
#pragma unroll
            for (int ai = 0; ai < 2; ++ai)
#pragma unroll
                for (int m = 0; m < 4; ++m) { const int row = row0 + ai * HALF + m * 16; bf16_t* rowp = dst + (size_t)row * ld + col0; const float r = rs[ai][m]; float sq = 0.f;
#pragma unroll
                    for (int bj = 0; bj < 2; ++bj) { f32x4 v0 = acc[ai][bj][m][0] * r, v1 = acc[ai][bj][m][1] * r;
                        if (kind == 1) {
#pragma unroll
                            for (int j = 0; j < 4; ++j) { v0[j] = silu_f(v0[j]); v1[j] = silu_f(v1[j]); } }
                        if (kind == 2) sq += ((v0[0] * v0[0] + v0[1] * v0[1]) + (v0[2] * v0[2] + v0[3] * v0[3])) + ((v1[0] * v1[0] + v1[1] * v1[1]) + (v1[2] * v1[2] + v1[3] * v1[3]));
                        *(u32x4*)(rowp + bj * HALF) = pack8v(v0, v1); }
                    if (kind == 2) { sq += __shfl_xor(sq, 16); sq += __shfl_xor(sq, 32); if (fq == 0) ss[(size_t)row * sld + slot] = sq; } }
        } else {
            if (wc < 2) {
                const int i0 = 16 * wc + 4 * fq; const float* ropeC = (const float*)(ws + WS_ROPE); const float* ropeS = ropeC + 4096 * 32; bf16_t* KB = (bf16_t*)(ws + WS_KB);
#pragma unroll
                for (int ai = 0; ai < 2; ++ai)
#pragma unroll
                    for (int m = 0; m < 4; ++m) { const int row = row0 + ai * HALF + m * 16; const float r = rs[ai][m]; const int t = row & 4095;
                        const f32x4 cs = *(const f32x4*)(ropeC + t * 32 + i0), sn = *(const f32x4*)(ropeS + t * 32 + i0);
                        u32x2 lo, hi; rope4(acc[ai][0][m][0] * r, acc[ai][0][m][1] * r, cs, sn, lo, hi);
                        bf16_t* kp = KB + (size_t)row * 1152 + 128 + i0;
#pragma unroll
                        for (int h = 0; h < 6; ++h) { *(u32x2*)(kp + h * 192) = lo; *(u32x2*)(kp + h * 192 + 32) = hi; }
                        asm volatile("" ::: "memory"); }
            } else if (wc == 2 && fq == 0) {
                float* LOGF = (float*)(ws + WS_LOGF);
                f32x4 b0; b0[0] = bforget[0]; b0[1] = bforget[1]; b0[2] = bforget[2]; b0[3] = bforget[3]; f32x4 b1; b1[0] = bforget[4]; b1[1] = bforget[5]; b1[2] = 0.f; b1[3] = 0.f;
#pragma unroll
                for (int ai = 0; ai < 2; ++ai)
#pragma unroll
                    for (int m = 0; m < 4; ++m) { const int row = row0 + ai * HALF + m * 16; const float r = rs[ai][m];
                        f32x4 z0 = acc[ai][0][m][0] * r + b0, z1 = acc[ai][0][m][1] * r + b1, l0, l1;
#pragma unroll
                        for (int j = 0; j < 4; ++j) { l0[j] = fminf(z0[j], 0.f) - log1pf(__expf(-fabsf(z0[j]))); l1[j] = fminf(z1[j], 0.f) - log1pf(__expf(-fabsf(z1[j]))); }
                        l1[2] = 0.f; l1[3] = 0.f;
                        *(f32x4*)(LOGF + (size_t)row * 8) = l0; *(f32x4*)(LOGF + (size_t)row * 8 + 4) = l1; }
            }
        }
    }
};

struct EpiUq {
    static constexpr bool PERM = true, AFTER_DRAIN = false;
    unsigned char* ws;
    __device__ __forceinline__ void operator()(const f32x4 (&acc)[2][2][4][2], const Unit& u, int wr, int wc, int fr, int fq) const {
        const int row0 = u.pm * BM + wr * 64 + fr; const int pn = u.pn;
        const float* CQSS = (const float*)(ws + WS_CQSS); bf16_t* QB = (bf16_t*)(ws + WS_QB); const float* ropeC = (const float*)(ws + WS_ROPE); const float* ropeS = ropeC + 4096 * 32;
        float rs[2][4];
#pragma unroll
        for (int ai = 0; ai < 2; ++ai)
#pragma unroll
            for (int m = 0; m < 4; ++m) { const int row = row0 + ai * HALF + m * 16; const f32x2 a = *(const f32x2*)(CQSS + (size_t)row * 8 + fq * 2);
                float s = a[0] + a[1]; s += __shfl_xor(s, 16); s += __shfl_xor(s, 32); rs[ai][m] = rsqrtf(s * (1.0f / 512.0f) + RMS_EPS); }
        if (pn < 3) {
#pragma unroll
            for (int ai = 0; ai < 2; ++ai)
#pragma unroll
                for (int m = 0; m < 4; ++m) { const int row = row0 + ai * HALF + m * 16; const float r = rs[ai][m];
#pragma unroll
                    for (int bj = 0; bj < 2; ++bj) { const int h = pn * 2 + bj; bf16_t* p = QB + (size_t)row * 1152 + 192 * h + wc * 32 + 8 * fq;
                        *(u32x4*)p = pack8v(acc[ai][bj][m][0] * r, acc[ai][bj][m][1] * r); } }
        } else {
            const int i0 = 16 * (wc & 1) + 4 * fq;
#pragma unroll
            for (int ai = 0; ai < 2; ++ai)
#pragma unroll
                for (int m = 0; m < 4; ++m) { const int row = row0 + ai * HALF + m * 16; const float r = rs[ai][m]; const int t = row & 4095;
                    const f32x4 cs = *(const f32x4*)(ropeC + t * 32 + i0), sn = *(const f32x4*)(ropeS + t * 32 + i0);
#pragma unroll
                    for (int bj = 0; bj < 2; ++bj) { const int cc = (pn - 3) * 256 + bj * HALF + wc * 32; const int hh = cc >> 6;
                        if (hh < 6) { u32x2 lo, hi; rope4(acc[ai][bj][m][0] * r, acc[ai][bj][m][1] * r, cs, sn, lo, hi);
                            bf16_t* p = QB + (size_t)row * 1152 + 192 * hh + 128 + i0; *(u32x2*)p = lo; *(u32x2*)(p + 32) = hi; } }
                    asm volatile("" ::: "memory"); }
        }
    }
};
struct EpiUkv {
    static constexpr bool PERM = true, AFTER_DRAIN = false;
    unsigned char* ws;
    __device__ __forceinline__ void operator()(const f32x4 (&acc)[2][2][4][2], const Unit& u, int wr, int wc, int fr, int fq) const {
        const int row0 = u.pm * BM + wr * 64 + fr; const int pn = u.pn;
        const float* CKVSS = (const float*)(ws + WS_CKVSS); bf16_t* KB = (bf16_t*)(ws + WS_KB); bf16_t* VB = (bf16_t*)(ws + WS_VB);
#pragma unroll
        for (int ai = 0; ai < 2; ++ai)
#pragma unroll
            for (int m = 0; m < 4; ++m) { const int row = row0 + ai * HALF + m * 16; const f32x4 a = *(const f32x4*)(CKVSS + (size_t)row * 4);
                const float r = rsqrtf(((a[0] + a[1]) + (a[2] + a[3])) * (1.0f / 256.0f) + RMS_EPS);
#pragma unroll
                for (int bj = 0; bj < 2; ++bj) {
                    bf16_t* p;
                    if (pn < 3) p = KB + (size_t)row * 1152 + 192 * (pn * 2 + bj) + wc * 32 + 8 * fq;
                    else p = VB + (size_t)row * 768 + (pn - 3) * 256 + bj * HALF + wc * 32 + 8 * fq;
                    *(u32x4*)p = pack8v(acc[ai][bj][m][0] * r, acc[ai][bj][m][1] * r); } }
    }
};
struct EpiOut {
    static constexpr bool PERM = true, AFTER_DRAIN = false;
    const float* base; float* out; unsigned char* ws;
    __device__ __forceinline__ void operator()(const f32x4 (&acc)[2][2][4][2], const Unit& u, int wr, int wc, int fr, int fq) const {
        const int row0 = u.pm * BM + wr * 64 + fr; const int col0 = u.pn * BM + wc * 32 + 8 * fq;
        bf16_t* XB = (bf16_t*)(ws + WS_XB); float* xss = (float*)(ws + WS_XSS);
#pragma unroll
        for (int ai = 0; ai < 2; ++ai)
#pragma unroll
            for (int m = 0; m < 4; ++m) { const int row = row0 + ai * HALF + m * 16; const size_t off = (size_t)row * 2048 + col0; float sq = 0.f;
#pragma unroll
                for (int bj = 0; bj < 2; ++bj) { const f32x4 x0 = *(const f32x4*)(base + off + bj * HALF), x1 = *(const f32x4*)(base + off + bj * HALF + 4);
                    const f32x4 v0 = x0 + acc[ai][bj][m][0], v1 = x1 + acc[ai][bj][m][1];
                    sq += ((v0[0] * v0[0] + v0[1] * v0[1]) + (v0[2] * v0[2] + v0[3] * v0[3])) + ((v1[0] * v1[0] + v1[1] * v1[1]) + (v1[2] * v1[2] + v1[3] * v1[3]));
                    *(f32x4*)(out + off + bj * HALF) = v0; *(f32x4*)(out + off + bj * HALF + 4) = v1;
                    *(u32x4*)(XB + off + bj * HALF) = pack8v(v0, v1); }
                sq += __shfl_xor(sq, 16); sq += __shfl_xor(sq, 32); if (fq == 0) xss[(size_t)row * 32 + u.pn * 4 + wc] = sq; }
    }
};

template <class Epi, class Sched, bool ALIGN_EPI = false, bool SP2 = false>
__device__ __forceinline__ void gemm_phase(PG8_LAS unsigned char* lds, const Gemm g, const Sched& S, const Epi& E) {
    int tid_ = threadIdx.x; asm volatile("" : "+v"(tid_));
    const int tid = tid_, wid = __builtin_amdgcn_readfirstlane(tid >> 6), lane = tid & 63, wr = wid >> 2, wc = wid & 3, fr = lane & 15, fq = lane >> 4;
    const int K = g.K, nt = K / BK;
    unsigned voffA[2], voffB[2];
#pragma unroll
    for (int i = 0; i < 2; ++i) { int R, C; stage_rc(tid * 16 + i * 8192, R, C); const int Rb = Epi::PERM ? ((R & ~31) + perm32(R & 31)) : R;
        voffA[i] = (unsigned)(R * K + C) * 2u; voffB[i] = (unsigned)(Rb * K + C) * 2u; }
    const size_t kstep = (size_t)(BK * 2);
    const size_t hstep = (size_t)HALF * K * 2;
    const size_t tstep = 2 * hstep;
    const unsigned ldsw = (unsigned)wid * 1024u;
    const int aoff = lds_byte(wr * 64 + fr, fq * 8), boff = lds_byte(wc * 32 + fr, fq * 8);
#define PG8_SA(b, h) (((b) * 2 + (h)) * HTB)
#define PG8_SB(b, h) ((4 + (b) * 2 + (h)) * HTB)
#define PG8_STAGE(bufoff, gbase, voff) do { _Pragma("unroll") for (int _i = 0; _i < 2; ++_i) \
        __builtin_amdgcn_global_load_lds((const unsigned*)((const char*)(gbase) + (voff)[_i]), (PG8_LAS unsigned*)(lds + (bufoff) + ldsw + _i * 8192), 16, 0, 0); } while (0)
#define PG8_LDA(dst, b, h) do { _Pragma("unroll") for (int m = 0; m < 4; ++m) _Pragma("unroll") for (int k = 0; k < 2; ++k) dst[m][k] = *(const PG8_LAS bf16x8*)(lds + PG8_SA(b, h) + aoff + m * 2048 + k * 1024); } while (0)
#define PG8_LDB(dst, b, h) do { _Pragma("unroll") for (int n = 0; n < 2; ++n) _Pragma("unroll") for (int k = 0; k < 2; ++k) dst[n][k] = *(const PG8_LAS bf16x8*)(lds + PG8_SB(b, h) + boff + n * 2048 + k * 1024); } while (0)
#define PG8_MMA(ai, bj, At, Bt) do { __builtin_amdgcn_s_setprio(1); _Pragma("unroll") for (int m = 0; m < 4; ++m) _Pragma("unroll") for (int n = 0; n < 2; ++n) _Pragma("unroll") for (int k = 0; k < 2; ++k) \
        acc[ai][bj][m][n] = __builtin_amdgcn_mfma_f32_16x16x32_bf16(Bt[n][k], At[m][k], acc[ai][bj][m][n], 0, 0, 0); __builtin_amdgcn_s_setprio(0); } while (0)
#define PG8_WAIT_V(n) asm volatile("s_waitcnt vmcnt(" #n ")" ::: "memory")
#define PG8_WAIT_L(n) asm volatile("s_waitcnt lgkmcnt(" #n ")" ::: "memory")
#define PG8_BAR __builtin_amdgcn_s_barrier()
#define PG8_SCHED __builtin_amdgcn_sched_barrier(0)
    Unit cur, nxt; int ui = 0;
    if (!S.next(0, cur)) return;
    f32x4 acc[2][2][4][2];
#pragma unroll
    for (int a = 0; a < 2; ++a)
#pragma unroll
        for (int b = 0; b < 2; ++b)
#pragma unroll
            for (int m = 0; m < 4; ++m)
#pragma unroll
                for (int n = 0; n < 2; ++n) acc[a][b][m][n] = (f32x4){0.f, 0.f, 0.f, 0.f};
    bf16x8 At[4][2], B0[2][2], B1[2][2];
    const char* cA = (const char*)g.A + (size_t)cur.pm * tstep; const char* cB = (const char*)g.Bt + (size_t)cur.pn * tstep;
    S.a_ready(cur);
    if constexpr (SP2) {
        PG8_STAGE(PG8_SB(0, 0), cB, voffB); PG8_STAGE(PG8_SB(0, 1), cB + hstep, voffB); PG8_STAGE(PG8_SA(0, 0), cA, voffA); PG8_STAGE(PG8_SA(0, 1), cA + hstep, voffA);
        if (wr == 1) PG8_BAR;
        PG8_WAIT_V(2); PG8_BAR;
        PG8_STAGE(PG8_SB(1, 0), cB + kstep, voffB); PG8_STAGE(PG8_SA(1, 0), cA + kstep, voffA); PG8_STAGE(PG8_SB(1, 1), cB + hstep + kstep, voffB);
        PG8_WAIT_V(6); PG8_BAR;
    } else {
        PG8_STAGE(PG8_SB(0, 0), cB, voffB); PG8_STAGE(PG8_SA(0, 0), cA, voffA); PG8_STAGE(PG8_SB(0, 1), cB + hstep, voffB); PG8_STAGE(PG8_SA(0, 1), cA + hstep, voffA);
        if (wr == 1) PG8_BAR;
        PG8_WAIT_V(4); PG8_BAR;
        PG8_STAGE(PG8_SB(1, 0), cB + kstep, voffB); PG8_STAGE(PG8_SA(1, 0), cA + kstep, voffA); PG8_STAGE(PG8_SB(1, 1), cB + hstep + kstep, voffB);
        PG8_WAIT_V(6); PG8_BAR;
    }
    for (;;) {
        const bool has_next = S.next(ui + 1, nxt);
        const char* nA = has_next ? (const char*)g.A + (size_t)nxt.pm * tstep : cA; const char* nB = has_next ? (const char*)g.Bt + (size_t)nxt.pn * tstep : cB;
        for (int t = 0; t < nt; t += 2) {
            const bool last = (t == nt - 2);
            const char* a1 = cA + (size_t)(t + 1) * kstep;
            const char* a2 = last ? nA : cA + (size_t)(t + 2) * kstep; const char* b2 = last ? nB : cB + (size_t)(t + 2) * kstep;
            const char* a3 = a2 + kstep; const char* b3 = b2 + kstep;
            if (last && has_next) S.a_ready(nxt);
            if constexpr (SP2) {
            PG8_LDB(B0, 0, 0); PG8_LDB(B1, 0, 1); PG8_SCHED; PG8_LDA(At, 0, 0); PG8_STAGE(PG8_SA(1, 1), a1 + hstep, voffA);
            PG8_WAIT_V(8); PG8_WAIT_L(0); PG8_BAR; PG8_MMA(0, 0, At, B0); PG8_MMA(0, 1, At, B1); PG8_BAR; PG8_SCHED;
            PG8_LDA(At, 0, 1); PG8_STAGE(PG8_SB(0, 0), b2, voffB); PG8_STAGE(PG8_SB(0, 1), b2 + hstep, voffB); PG8_STAGE(PG8_SA(0, 0), a2, voffA);
            PG8_WAIT_V(8); PG8_WAIT_L(0); PG8_BAR; PG8_MMA(1, 0, At, B0); PG8_MMA(1, 1, At, B1); PG8_BAR; PG8_SCHED;
            PG8_LDB(B0, 1, 0); PG8_LDB(B1, 1, 1); PG8_SCHED; PG8_LDA(At, 1, 0); PG8_STAGE(PG8_SA(0, 1), a2 + hstep, voffA);
            PG8_WAIT_V(8); PG8_WAIT_L(0); PG8_BAR; PG8_MMA(0, 0, At, B0); PG8_MMA(0, 1, At, B1); PG8_BAR; PG8_SCHED;
            PG8_LDA(At, 1, 1); PG8_STAGE(PG8_SB(1, 0), b3, voffB); PG8_STAGE(PG8_SB(1, 1), b3 + hstep, voffB); PG8_STAGE(PG8_SA(1, 0), a3, voffA);
            PG8_WAIT_V(8); PG8_WAIT_L(0); PG8_BAR; PG8_MMA(1, 0, At, B0); PG8_MMA(1, 1, At, B1); PG8_BAR; PG8_SCHED;
            } else {
            PG8_LDB(B0, 0, 0); PG8_SCHED; PG8_LDA(At, 0, 0); PG8_STAGE(PG8_SA(1, 1), a1 + hstep, voffA);
            PG8_WAIT_L(8); PG8_BAR; PG8_WAIT_L(0); PG8_MMA(0, 0, At, B0); PG8_BAR; PG8_SCHED;
            PG8_LDB(B1, 0, 1); PG8_STAGE(PG8_SB(0, 0), b2, voffB);
            PG8_BAR; PG8_WAIT_L(0); PG8_MMA(0, 1, At, B1); PG8_BAR;
            PG8_LDA(At, 0, 1); PG8_STAGE(PG8_SA(0, 0), a2, voffA);
            PG8_BAR; PG8_WAIT_L(0); PG8_MMA(1, 0, At, B0); PG8_BAR; PG8_SCHED;
            PG8_STAGE(PG8_SB(0, 1), b2 + hstep, voffB);
            PG8_WAIT_V(6); PG8_BAR; PG8_MMA(1, 1, At, B1); PG8_BAR;
            PG8_LDB(B0, 1, 0); PG8_SCHED; PG8_LDA(At, 1, 0); PG8_STAGE(PG8_SA(0, 1), a2 + hstep, voffA);
            PG8_WAIT_L(8); PG8_BAR; PG8_WAIT_L(0); PG8_MMA(0, 0, At, B0); PG8_BAR; PG8_SCHED;
            PG8_LDB(B1, 1, 1); PG8_STAGE(PG8_SB(1, 0), b3, voffB);
            PG8_BAR; PG8_WAIT_L(0); PG8_MMA(0, 1, At, B1); PG8_BAR;
            PG8_LDA(At, 1, 1); PG8_STAGE(PG8_SA(1, 0), a3, voffA);
            PG8_BAR; PG8_WAIT_L(0); PG8_MMA(1, 0, At, B0); PG8_BAR; PG8_SCHED;
            PG8_STAGE(PG8_SB(1, 1), b3 + hstep, voffB);
            PG8_WAIT_V(6); PG8_BAR; PG8_MMA(1, 1, At, B1); PG8_BAR;
            }
        }
        if constexpr (ALIGN_EPI) { if (wr == 0) PG8_BAR; }
        if constexpr (!Epi::AFTER_DRAIN) { E(acc, cur, wr, wc, fr, fq); S.done(cur); }
        if (!has_next) break;
#pragma unroll
        for (int a = 0; a < 2; ++a)
#pragma unroll
            for (int b = 0; b < 2; ++b)
#pragma unroll
                for (int m = 0; m < 4; ++m)
#pragma unroll
                    for (int n = 0; n < 2; ++n) acc[a][b][m][n] = (f32x4){0.f, 0.f, 0.f, 0.f};
        cur = nxt; cA = nA; cB = nB; ++ui;
        if constexpr (ALIGN_EPI) { if (wr == 1) PG8_BAR; }
    }
    PG8_WAIT_V(0);
    if constexpr (!ALIGN_EPI) { if (wr == 0) PG8_BAR; }
    PG8_BAR;
    if constexpr (Epi::AFTER_DRAIN) { E.fused(acc, cur, wr, wc, fr, fq, lds, wid, lane); S.done(cur); }
#undef PG8_SA
#undef PG8_SB
#undef PG8_STAGE
#undef PG8_LDA
#undef PG8_LDB
#undef PG8_MMA
#undef PG8_WAIT_V
#undef PG8_WAIT_L
#undef PG8_BAR
#undef PG8_SCHED
}
}
#define GAS __attribute__((address_space(1)))
#define LAS __attribute__((address_space(3)))
typedef unsigned short bf16;
typedef unsigned v4u __attribute__((ext_vector_type(4)));
typedef float f32x4 __attribute__((ext_vector_type(4)));
typedef float f32x2 __attribute__((ext_vector_type(2)));
typedef short bf16x8 __attribute__((ext_vector_type(8)));
#define LDS_WAIT() asm volatile("s_waitcnt lgkmcnt(0)" ::: "memory")

__device__ __forceinline__ unsigned f2bf(float f) { unsigned u = __builtin_bit_cast(unsigned, f); return (u + 0x7fffu + ((u >> 16) & 1u)) >> 16; }
__device__ __forceinline__ unsigned pk2(float lo, float hi) { return f2bf(lo) | (f2bf(hi) << 16); }
__device__ __forceinline__ float bf2f(unsigned short h) { return __builtin_bit_cast(float, (unsigned)h << 16); }
__device__ __forceinline__ float wave_sum(float v) {
#pragma unroll
    for (int o = 1; o < 64; o <<= 1) v += __shfl_xor(v, o);
    return v;
}
__device__ __forceinline__ float wave_max(float v) {
#pragma unroll
    for (int o = 1; o < 64; o <<= 1) v = fmaxf(v, __shfl_xor(v, o));
    return v;
}

struct Args {
    const float* in[16]; float* out; unsigned char* ws; int ph_lo, ph_hi;
};

__device__ __forceinline__ int colmap_in(int n) {
    const int t = n >> 8;
    if (t < 9) return n;
    if (t < 12) return 2310 + (n - 2304);
    if (t < 14) return 3078 + (n - 3072);
    if (t == 14) return 3590 + (n - 3584);
    if (t < 18) return 3910 + (n - 3840);
    if (t < 20) return 4678 + (n - 4608);
    if (t < 22) return 5190 + (n - 5120);
    if (t < 24) return 5702 + (n - 5632);
    if (t < 26) return 6214 + (n - 6144);
    const int j = n & 255;
    if (j < 64) return 3846 + (j >> 1) + 32 * (j & 1);
    if (j < 70) return 2304 + (j - 64);
    return -1;
}
__device__ __forceinline__ int colmap_uq(int n) {
    if (n < 768) return 192 * (n >> 7) + (n & 127);
    if (n < 1152) { const int hh = (n - 768) >> 6, p = (n - 768) & 63; return 192 * hh + 128 + (p >> 1) + 32 * (p & 1); }
    return -1;
}
__device__ __forceinline__ int colmap_ukv(int n) {
    if (n < 768) return 256 * (n >> 7) + (n & 127);
    const int c = n - 768; return 256 * (c >> 7) + 128 + (c & 127);
}
template <int MAT> __device__ __forceinline__ void tr_item(const float* W, int Norig, const float* gk, bf16* WT, int K, int k0, int n0, LAS float* scr, int lane) {
    const int nn = lane & 31; int oc;
    if (MAT == 0) oc = colmap_in(n0 + nn); else if (MAT == 1) oc = colmap_uq(n0 + nn); else if (MAT == 2) oc = colmap_ukv(n0 + nn); else oc = n0 + nn;
#pragma unroll 8
    for (int i = 0; i < 32; ++i) { const int kk = 2 * i + (lane >> 5); float v = 0.f;
        if (oc >= 0) { v = W[(size_t)(k0 + kk) * Norig + oc]; if (gk) v *= gk[k0 + kk]; }
        scr[kk * 33 + nn] = v; }
    LDS_WAIT(); asm volatile("" ::: "memory");
    const int c = lane & 7;
#pragma unroll
    for (int j = 0; j < 4; ++j) { const int n = (lane >> 3) + 8 * j; const LAS float* s = scr + (8 * c) * 33 + n;
        v4u o; o.x = pk2(s[0 * 33], s[1 * 33]); o.y = pk2(s[2 * 33], s[3 * 33]); o.z = pk2(s[4 * 33], s[5 * 33]); o.w = pk2(s[6 * 33], s[7 * 33]);
        *(v4u*)(WT + (size_t)(n0 + n) * K + k0 + 8 * c) = o; }
    LDS_WAIT(); asm volatile("" ::: "memory");
}

__device__ __forceinline__ int t5_bucket(int rel) {
    const int n = rel < 0 ? -rel : rel; int v;
    if (n < 8) v = n; else if (n < 12) v = 8; else if (n < 16) v = 9; else if (n < 23) v = 10; else if (n < 32) v = 11; else if (n < 46) v = 12; else if (n < 64) v = 13; else if (n < 91) v = 14; else v = 15;
    return (rel > 0 ? 16 : 0) + v;
}

__device__ __forceinline__ int opaque_tid() { int t = threadIdx.x; asm volatile("" : "+v"(t)); return t; }
#define C_tid (tid_o)
#define C_lane (tid_o & 63)
#define C_wave (__builtin_amdgcn_readfirstlane(tid_o >> 6))
#define C_G ((int)gridDim.x)
#define C_bid ((int)blockIdx.x)
#define WSP(T, off) ((T*)(args.ws + (off)))

__device__ __forceinline__ void p0_prologue(const Args& args, LAS unsigned char* lds) {
    const int tid_o = opaque_tid();
    LAS float* scr = (LAS float*)(lds + C_wave * 16384);
    const int gw = C_bid * NWAVES + C_wave, NGW = C_G * NWAVES;
    constexpr int I_IN = (DM / 64) * (NIN_PAD / 32), I_UQ = (512 / 64) * (NUQ_PAD / 32), I_UKV = (256 / 64) * (NUKV / 32), I_OUT = (DM / 64) * (DM / 32);
    constexpr int PER_LAYER = I_IN + I_UQ + I_UKV + I_OUT;
    for (int it = gw; it < DEPTH * PER_LAYER; it += NGW) {
        const int l = it / PER_LAYER; int r = it - l * PER_LAYER;
        if (r < I_IN) { const int nb = NIN_PAD / 32, kb = r / nb, nbk = r - kb * nb;
            tr_item<0>(args.in[2] + (size_t)l * DM * NIN, NIN, args.in[1] + l * DM, WSP(bf16, WS_WIN) + (size_t)l * NIN_PAD * DM, DM, kb * 64, nbk * 32, scr, C_lane); continue; }
        r -= I_IN;
        if (r < I_UQ) { const int nb = NUQ_PAD / 32, kb = r / nb, nbk = r - kb * nb;
            tr_item<1>(args.in[5] + (size_t)l * 512 * 1152, 1152, args.in[4] + l * 512, WSP(bf16, WS_WUQ) + (size_t)l * NUQ_PAD * 512, 512, kb * 64, nbk * 32, scr, C_lane); continue; }
        r -= I_UQ;
        if (r < I_UKV) { const int nb = NUKV / 32, kb = r / nb, nbk = r - kb * nb;
            tr_item<2>(args.in[7] + (size_t)l * 256 * 1536, 1536, args.in[6] + l * 256, WSP(bf16, WS_WUKV) + (size_t)l * NUKV * 256, 256, kb * 64, nbk * 32, scr, C_lane); continue; }
        r -= I_UKV;
        { const int nb = DM / 32, kb = r / nb, nbk = r - kb * nb;
            tr_item<3>(args.in[14] + (size_t)l * DM * DM, DM, nullptr, WSP(bf16, WS_WOUT) + (size_t)l * DM * DM, DM, kb * 64, nbk * 32, scr, C_lane); }
    }
    for (int m = gw; m < M; m += NGW) {
        const f32x4* xr = (const f32x4*)(args.in[0] + (size_t)m * DM) + C_lane; float s = 0.f;
        unsigned long long* o8 = (unsigned long long*)(WSP(bf16, WS_XB) + (size_t)m * DM) + C_lane;
#pragma unroll
        for (int j = 0; j < 8; ++j) { const f32x4 v = xr[64 * j]; s += (v[0] * v[0] + v[1] * v[1]) + (v[2] * v[2] + v[3] * v[3]);
            o8[64 * j] = (unsigned long long)pk2(v[0], v[1]) | ((unsigned long long)pk2(v[2], v[3]) << 32); }
        s = wave_sum(s);
        if (C_lane < 32) WSP(float, WS_XSS)[(size_t)m * 32 + C_lane] = C_lane == 0 ? s : 0.f;
    }
    for (int e = C_bid * NTHREADS + C_tid; e < SEQ * 32; e += C_G * NTHREADS) {
        const int s = e >> 5, i = e & 31; const float inv = powf(10000.0f, -(float)i / 32.0f); const float ang = (float)s * inv;
        WSP(float, WS_ROPE)[e] = cosf(ang); WSP(float, WS_ROPE + SEQ * 32 * 4)[e] = sinf(ang);
    }
}

__device__ __forceinline__ void p2_scan(const Args& args) {
    const int tid_o = opaque_tid();
    if (C_bid >= NB * 6 || C_wave != 0) return;
    const int b = C_bid / 6, h = C_bid % 6, lane = C_lane;
    const float* src = WSP(float, WS_LOGF) + ((size_t)b * SEQ + 64 * lane) * 8 + h;
    float tot = 0.f;
#pragma unroll 8
    for (int j = 0; j < 64; ++j) tot += src[j * 8];
    float incl = tot;
#pragma unroll
    for (int o = 1; o < 64; o <<= 1) { const float y = __shfl_up(incl, o); if (lane >= o) incl += y; }
    float run = incl - tot;
    float* dst = WSP(float, WS_CUMT) + (size_t)C_bid * SEQ + 64 * lane;
#pragma unroll 8
    for (int j = 0; j < 64; ++j) { run += src[j * 8]; dst[j] = run; }
}

template <int DQK> __device__ __forceinline__ float dot_row(const bf16* kp, const LAS float* qs) {
    float s = 0.f;
#pragma unroll
    for (int c = 0; c < DQK / 8; ++c) { const v4u kv = *(const v4u*)(kp + c * 8);
        const f32x4 q0 = *(const LAS f32x4*)(qs + c * 8), q1 = *(const LAS f32x4*)(qs + c * 8 + 4);
        s += bf2f(kv.x & 0xffff) * q0[0] + bf2f(kv.x >> 16) * q0[1] + bf2f(kv.y & 0xffff) * q0[2] + bf2f(kv.y >> 16) * q0[3]
           + bf2f(kv.z & 0xffff) * q1[0] + bf2f(kv.z >> 16) * q1[1] + bf2f(kv.w & 0xffff) * q1[2] + bf2f(kv.w >> 16) * q1[3]; }
    return s;
}
template <int VAR, int DQK>
__device__ __forceinline__ void naive_map(const LAS float* qs, const bf16* Kbase, int kpitch, const bf16* Vbase, int vpitch, int nkeys, int t, const float* cum, float cumt,
                                          const float* relb, int h, int lane, float& o0, float& o1, float& l) {
    float m = -1e30f; l = 0.f; o0 = 0.f; o1 = 0.f;
    for (int k0 = 0; k0 < nkeys; k0 += 64) {
        const int key = k0 + lane;
        float s = dot_row<DQK>(Kbase + (size_t)key * kpitch, qs);
        if (VAR == 0) { s += cumt - cum[key]; if (key > t) s = -INFINITY; }
        if (VAR == 2) s += relb[t5_bucket(key - t) * 4 + h];
        const float tmax = wave_max(s), mn = fmaxf(m, tmax), alpha = __expf(m - mn), p = __expf(s - mn);
        l = l * alpha + wave_sum(p); o0 *= alpha; o1 *= alpha; m = mn;
        const bf16* vp = Vbase + (size_t)k0 * vpitch + 2 * lane;
#pragma unroll 8
        for (int kk = 0; kk < 64; ++kk) { const float pk = __shfl(p, kk); const unsigned vv = *(const unsigned*)(vp + (size_t)kk * vpitch);
            o0 += pk * bf2f(vv & 0xffff); o1 += pk * bf2f(vv >> 16); }
    }
}
__device__ __forceinline__ void p3_naive(const Args& args, int layer, LAS unsigned char* lds) {
    const int tid_o = opaque_tid();
    LAS float* qs = (LAS float*)(lds + C_wave * 1024);
    const int gw = C_bid * NWAVES + C_wave, NGW = C_G * NWAVES, lane = C_lane;
    const float lam_init = 0.8f - 0.6f * expf(-0.3f * (float)layer);
    const float d1 = wave_sum(args.in[8][layer * 64 + lane] * args.in[9][layer * 64 + lane]), d2 = wave_sum(args.in[10][layer * 64 + lane] * args.in[11][layer * 64 + lane]);
    const float lam = expf(d1) - expf(d2) + lam_init;
    for (int u = gw; u < M * 16; u += NGW) {
        const int row = u >> 4, hh = u & 15, b = row >> 12, t = row & 4095; const size_t rb = (size_t)b * SEQ;
        float o0, o1, l;
        if (hh < 6) {
            const int h = hh; const bf16* q = WSP(bf16, WS_AQ) + (size_t)row * 768 + 128 * h;
            qs[lane] = bf2f(q[lane]) * 0.08838834764831845f; qs[lane + 64] = bf2f(q[lane + 64]) * 0.08838834764831845f; LDS_WAIT();
            const float* cum = WSP(float, WS_CUMT) + (size_t)(b * 6 + h) * SEQ;
            naive_map<0, 128>(qs, WSP(bf16, WS_AK) + rb * 768 + 128 * h, 768, WSP(bf16, WS_AV) + rb * 768 + 128 * h, 768, t + 1, t, cum, cum[t], nullptr, h, lane, o0, o1, l);
            bf16* g = WSP(bf16, WS_G) + (size_t)row * 2048 + 128 * h + 2 * lane; const unsigned gv = *(const unsigned*)g; const float il = 1.0f / l;
            *(unsigned*)g = pk2(o0 * il * bf2f(gv & 0xffff), o1 * il * bf2f(gv >> 16));
        } else if (hh < 12) {
            const int h = hh - 6; const bf16* q = WSP(bf16, WS_QB) + (size_t)row * 1152 + 192 * h; const float sc = 0.07216878364870322f;
            qs[lane] = bf2f(q[lane]) * sc; qs[lane + 64] = bf2f(q[lane + 64]) * sc; qs[lane + 128] = bf2f(q[lane + 128]) * sc; LDS_WAIT();
            naive_map<1, 192>(qs, WSP(bf16, WS_KB) + rb * 1152 + 192 * h, 1152, WSP(bf16, WS_VB) + rb * 768 + 128 * h, 768, 64 * (t / 64 + 1), t, nullptr, 0.f, nullptr, h, lane, o0, o1, l);
            bf16* g = WSP(bf16, WS_G) + (size_t)row * 2048 + 768 + 128 * h + 2 * lane; const unsigned gv = *(const unsigned*)g; const float il = 1.0f / l;
            *(unsigned*)g = pk2(o0 * il * bf2f(gv & 0xffff), o1 * il * bf2f(gv >> 16));
        } else {
            const int h = hh - 12; const bf16* q = WSP(bf16, WS_CQ2) + (size_t)row * 512 + 128 * h;
            qs[lane] = bf2f(q[lane]) * 0.125f; qs[lane + 64] = bf2f(q[lane + 64]) * 0.125f; LDS_WAIT();
            float p0, p1, pl;
            naive_map<2, 64>(qs, WSP(bf16, WS_CK2) + rb * 512 + 128 * h, 512, WSP(bf16, WS_CV) + rb * 512 + 128 * h, 512, 64 * (t / 64 + 1), t, nullptr, 0.f, args.in[13], h, lane, o0, o1, l);
            naive_map<2, 64>(qs + 64, WSP(bf16, WS_CK2) + rb * 512 + 128 * h + 64, 512, WSP(bf16, WS_CV) + rb * 512 + 128 * h, 512, 64 * (t / 64 + 1), t, nullptr, 0.f, args.in[13], h, lane, p0, p1, pl);
            const float il1 = 1.0f / l, il2 = lam / pl; const float c0 = o0 * il1 - p0 * il2, c1 = o1 * il1 - p1 * il2;
            const float ss = wave_sum(c0 * c0 + c1 * c1); const float r = rsqrtf(ss * (1.0f / 128.0f) + EPS) * (1.0f - lam_init);
            const float* sg = args.in[12] + layer * 128 + 2 * lane;
            bf16* g = WSP(bf16, WS_G) + (size_t)row * 2048 + 1536 + 128 * h + 2 * lane; const unsigned gv = *(const unsigned*)g;
            *(unsigned*)g = pk2(c0 * r * sg[0] * bf2f(gv & 0xffff), c1 * r * sg[1] * bf2f(gv >> 16));
        }
        LDS_WAIT();
    }
}

__device__ __forceinline__ void p5_final(const Args& args) {
    const int tid_o = opaque_tid();
    const int gw = C_bid * NWAVES + C_wave, NGW = C_G * NWAVES, lane = C_lane;
    for (int m = gw; m < M; m += NGW) {
        float s = lane < 32 ? WSP(float, WS_XSS)[(size_t)m * 32 + lane] : 0.f; s = wave_sum(s);
        const float r = rsqrtf(s * (1.0f / 2048.0f) + EPS);
        f32x4* xr = (f32x4*)(args.out + (size_t)m * DM) + lane; const f32x4* gr = (const f32x4*)args.in[15] + lane;
#pragma unroll
        for (int j = 0; j < 8; ++j) { const f32x4 v = xr[64 * j], g = gr[64 * j]; xr[64 * j] = v * r * g; }
    }
}

#ifndef MK_FUSED
#define MK_FUSED 0
#endif
constexpr int N_PHASES = 10;

__global__ void __launch_bounds__(NTHREADS, 2) fwd_kernel(Args args) {
    extern __shared__ __attribute__((aligned(16))) unsigned char lds_raw[];
    LAS unsigned char* lds = (LAS unsigned char*)lds_raw;
    const int lo = args.ph_lo, hi = args.ph_hi;
#ifndef PH_MASK
#define PH_MASK 0x3ff
#endif
#define IN(k) (((PH_MASK >> ((k) > 4 ? (k) - 4 : (k))) & 1) && lo <= (k) && (k) < hi)
#if MK_FUSED
#define SEAM(k) do { if (IN(k) && IN((k) + 1)) { cg::this_grid().sync(); } } while (0)
#else
#define SEAM(k) do { } while (0)
#endif
    if (IN(0)) { p0_prologue(args, lds); __syncthreads(); }
    SEAM(0);
#pragma unroll 1
    for (int l = 0; l < DEPTH; ++l) {
        const int pb = 1 + 4 * l;
        if (IN(pb)) {
            pg8::Gemm g{WSP(bf16, WS_XB), WSP(bf16, WS_WIN) + (size_t)l * NIN_PAD * DM, M, NIN_PAD, DM}; pg8::StaticOrder S; S.init(M, NIN_PAD, C_G, C_bid);
            pg8::EpiIn E{args.ws, args.in[3] + l * 6};
            pg8::gemm_phase<pg8::EpiIn, pg8::StaticOrder, true, true>(lds, g, S, E);
        }
        SEAM(pb);
        if (IN(pb + 1)) {
            p2_scan(args);
            { pg8::Gemm g{WSP(bf16, WS_CQ), WSP(bf16, WS_WUQ) + (size_t)l * NUQ_PAD * 512, M, NUQ_PAD, 512}; pg8::StaticOrder S; S.init(M, NUQ_PAD, C_G, C_bid);
              pg8::EpiUq E{args.ws};
              pg8::gemm_phase<pg8::EpiUq, pg8::StaticOrder, true, true>(lds, g, S, E); }
            { pg8::Gemm g{WSP(bf16, WS_CKV), WSP(bf16, WS_WUKV) + (size_t)l * NUKV * 256, M, NUKV, 256}; pg8::StaticOrder S; S.init(M, NUKV, C_G, (C_bid + 128) % C_G);
              pg8::EpiUkv E{args.ws};
              pg8::gemm_phase<pg8::EpiUkv, pg8::StaticOrder, true, true>(lds, g, S, E); }
        }
        SEAM(pb + 1);
        if (IN(pb + 2)) { p3_naive(args, l, lds); __syncthreads(); }
        SEAM(pb + 2);
        if (IN(pb + 3)) {
            pg8::Gemm g{WSP(bf16, WS_G), WSP(bf16, WS_WOUT) + (size_t)l * DM * DM, M, DM, DM}; pg8::StaticOrder S; S.init(M, DM, C_G, C_bid);
            pg8::EpiOut E{l == 0 ? args.in[0] : args.out, args.out, args.ws};
            pg8::gemm_phase<pg8::EpiOut, pg8::StaticOrder, true, true>(lds, g, S, E);
        }
        SEAM(pb + 3);
    }
    if (IN(9)) p5_final(args);
#undef IN
#undef SEAM
}

extern "C" void kernel_launch(void* const* d_in, const int* in_sizes, int n_in, void* d_out, int out_size, void* d_ws, size_t ws_size, hipStream_t stream) {
    static int grid = 0;
    if (grid == 0) {
        if (n_in != 16 || in_sizes[0] != M * DM || out_size != M * DM || ws_size < WS_END) {
            fprintf(stderr, "kernel_launch: unexpected shapes (n_in %d, in0 %d, out %d, ws %zu; need ws >= %zu)\n", n_in, n_in > 0 ? in_sizes[0] : -1, out_size, ws_size, (size_t)WS_END); grid = -1; return; }
        int dev = 0, cus = 0, per_cu = 0;
        if (hipGetDevice(&dev) != hipSuccess || hipDeviceGetAttribute(&cus, hipDeviceAttributeMultiprocessorCount, dev) != hipSuccess) { fprintf(stderr, "kernel_launch: device query failed\n"); grid = -1; return; }
        if (hipFuncSetAttribute((const void*)fwd_kernel, hipFuncAttributeMaxDynamicSharedMemorySize, LDS_BYTES) != hipSuccess) { fprintf(stderr, "kernel_launch: hipFuncSetAttribute failed\n"); grid = -1; return; }
        if (hipOccupancyMaxActiveBlocksPerMultiprocessor(&per_cu, (const void*)fwd_kernel, NTHREADS, LDS_BYTES) != hipSuccess || per_cu < 1) {
            fprintf(stderr, "kernel_launch: occupancy query reports %d blocks per CU\n", per_cu); (void)hipGetLastError(); grid = -1; return; }
        grid = cus;
    }
    if (grid < 0) return;
    Args a{};
    for (int i = 0; i < 16; ++i) a.in[i] = (const float*)d_in[i];
    a.out = (float*)d_out; a.ws = (unsigned char*)d_ws;
#if MK_FUSED
    a.ph_lo = 0; a.ph_hi = N_PHASES;
    void* kargs[] = {&a};
    hipError_t e = hipLaunchCooperativeKernel((const void*)fwd_kernel, dim3(grid), dim3(NTHREADS), kargs, LDS_BYTES, stream);
    if (e != hipSuccess) fprintf(stderr, "kernel_launch: cooperative launch failed: %s (grid %d)\n", hipGetErrorString(e), grid);
#else
    for (int p = 0; p < N_PHASES; ++p) {
        a.ph_lo = p; a.ph_hi = p + 1;
        hipLaunchKernelGGL(fwd_kernel, dim3(grid), dim3(NTHREADS), LDS_BYTES, stream, a);
    }
#endif
}
```

```cpp
#include <hip/hip_runtime.h>
#include <hip/hip_cooperative_groups.h>
#include <cstdio>
#include <cstdint>
#include <cmath>
namespace cg = cooperative_groups;

constexpr int NB = 4, SEQ = 4096, DM = 2048, M = NB * SEQ, DEPTH = 2;
constexpr int NIN = 6726, NIN_PAD = 6912;
constexpr int NUQ_PAD = 1280, NUKV = 1536;
constexpr float EPS = 1e-6f;

constexpr size_t MiB = 1u << 20;
constexpr size_t WS_CTL = 0, CTL_ZERO_BYTES = 1 * MiB;
constexpr size_t WS_WIN = 1 * MiB;
constexpr size_t WS_WUQ = WS_WIN + 54 * MiB;
constexpr size_t WS_WUKV = WS_WUQ + 5 * MiB / 2;
constexpr size_t WS_WOUT = WS_WUKV + 3 * MiB / 2;
constexpr size_t WS_ROPE = WS_WOUT + 16 * MiB;
constexpr size_t WS_XSS = WS_ROPE + 1 * MiB;
constexpr size_t WS_LOGF = WS_XSS + 2 * MiB;
constexpr size_t WS_CUMT = WS_LOGF + MiB / 2;
constexpr size_t WS_CQSS = WS_CUMT + MiB / 2;
constexpr size_t WS_CKVSS = WS_CQSS + MiB / 2;
constexpr size_t WS_XB = WS_CKVSS + MiB / 2;
constexpr size_t WS_G = WS_XB + 64 * MiB;
constexpr size_t WS_AQ = WS_G + 64 * MiB, WS_AK = WS_AQ + 24 * MiB, WS_AV = WS_AK + 24 * MiB;
constexpr size_t WS_CQ = WS_AV + 24 * MiB;
constexpr size_t WS_CKV = WS_CQ + 16 * MiB;
constexpr size_t WS_QB = WS_CKV + 8 * MiB, WS_KB = WS_QB + 36 * MiB, WS_VB = WS_KB + 36 * MiB;
constexpr size_t WS_CQ2 = WS_VB + 24 * MiB, WS_CK2 = WS_CQ2 + 16 * MiB, WS_CV = WS_CK2 + 16 * MiB;
constexpr size_t WS_END = WS_CV + 16 * MiB;
static_assert(WS_END <= 512 * MiB, "workspace map");

constexpr int RING_BYTES = 131072, LDS_BYTES = 147456;
constexpr int NWAVES = 8, NTHREADS = 512;

namespace pg8 {
#define PG8_LAS __attribute__((address_space(3)))
typedef unsigned short bf16_t;
typedef short bf16x8 __attribute__((ext_vector_type(8)));
typedef float f32x4 __attribute__((ext_vector_type(4)));
typedef unsigned u32x4 __attribute__((ext_vector_type(4)));
constexpr int BM = 256, BK = 64, HALF = 128, HTB = HALF * BK * 2  , STAGE_BYTES = 8 * HTB, NXCD = 8, WGM = 8;

__host__ __device__ __forceinline__ int lds_byte(int r, int c) { const int st = (r >> 4) * 2 + (c >> 5), rr = r & 15, cc = c & 31, ob = rr * 64 + cc * 2; return st * 1024 + (ob ^ (((ob >> 9) & 1) << 5)); }
__host__ __device__ __forceinline__ void stage_rc(int b, int& R, int& C) { const int st = b / 1024, sb = b % 1024, swz = sb ^ (((sb >> 9) & 1) << 5); R = (st >> 1) * 16 + swz / 64; C = (st & 1) * 32 + (swz % 64) / 2; }
__host__ __device__ __forceinline__ int perm32(int rho) { const int n = rho >> 4, i = rho & 15; return 8 * (i >> 2) + 4 * n + (i & 3); }

struct Unit { int pm, pn; };
struct Gemm { const bf16_t* A; const bf16_t* Bt; int M, N, K; };

struct StaticOrder {
    int nM, nN, nwg, G, c;
    __host__ __device__ void init(int M, int N, int G_, int c_) { nM = M / BM; nN = N / BM; nwg = nM * nN; G = G_; c = c_; }
    __host__ __device__ bool next(int i, Unit& u) const {
        const long L = (long)i * G + c; if (L >= nwg) return false;
        int wgid = (int)L; { const int q = nwg / NXCD, r = nwg % NXCD, xcd = wgid % NXCD, off = wgid / NXCD; wgid = (xcd < r ? xcd * (q + 1) : r * (q + 1) + (xcd - r) * q) + off; }
        const int nig = WGM * nN, gid = wgid / nig, fm = gid * WGM, gsz = (nM - fm) < WGM ? (nM - fm) : WGM;
        u.pm = fm + ((wgid % nig) % gsz); u.pn = (wgid % nig) / gsz; return true;
    }
    __device__ __forceinline__ void a_ready(const Unit&) const {}
    __device__ __forceinline__ void done(const Unit&) const {}
};


__device__ __forceinline__ unsigned cvt_pk_bf16(float lo, float hi) { unsigned r; asm volatile("v_cvt_pk_bf16_f32 %0, %1, %2" : "=v"(r) : "v"(lo), "v"(hi)); return r; }
typedef float f32x2 __attribute__((ext_vector_type(2)));
typedef unsigned u32x2 __attribute__((ext_vector_type(2)));
constexpr float RMS_EPS = 1e-6f;
__device__ __forceinline__ float silu_f(float v) { return v / (1.0f + __expf(-v)); }
__device__ __forceinline__ u32x4 pack8v(f32x4 a, f32x4 b) { u32x4 w; w.x = cvt_pk_bf16(a[0], a[1]); w.y = cvt_pk_bf16(a[2], a[3]); w.z = cvt_pk_bf16(b[0], b[1]); w.w = cvt_pk_bf16(b[2], b[3]); return w; }
__device__ __forceinline__ void rope4(f32x4 v0, f32x4 v1, f32x4 cs, f32x4 sn, u32x2& lo, u32x2& hi) {
    const float a0 = v0[0], b0 = v0[1], a1 = v0[2], b1 = v0[3], a2 = v1[0], b2 = v1[1], a3 = v1[2], b3 = v1[3];
    lo.x = cvt_pk_bf16(a0 * cs[0] - b0 * sn[0], a1 * cs[1] - b1 * sn[1]); lo.y = cvt_pk_bf16(a2 * cs[2] - b2 * sn[2], a3 * cs[3] - b3 * sn[3]);
    hi.x = cvt_pk_bf16(a0 * sn[0] + b0 * cs[0], a1 * sn[1] + b1 * cs[1]); hi.y = cvt_pk_bf16(a2 * sn[2] + b2 * cs[2], a3 * sn[3] + b3 * cs[3]);
}

struct EpiIn {
    static constexpr bool PERM = true, AFTER_DRAIN = false;
    unsigned char* ws;
    const float* bforget;
    __device__ __forceinline__ void operator()(const f32x4 (&acc)[2][2][4][2], const Unit& u, int wr, int wc, int fr, int fq) const {
        const int row0 = u.pm * BM + wr * 64 + fr; const int pn = u.pn;
        const float* xss = (const float*)(ws + WS_XSS);
        float rs[2][4];
#pragma unroll
        for (int ai = 0; ai < 2; ++ai)
#pragma unroll
            for (int m = 0; m < 4; ++m) { const int row = row0 + ai * HALF + m * 16; const f32x4* p = (const f32x4*)(xss + (size_t)row * 32 + fq * 8);
                const f32x4 a = p[0], b = p[1]; float s = ((a[0] + a[1]) + (a[2] + a[3])) + ((b[0] + b[1]) + (b[2] + b[3]));
                s += __shfl_xor(s, 16); s += __shfl_xor(s, 32); rs[ai][m] = rsqrtf(s * (1.0f / 2048.0f) + RMS_EPS); }
        if (pn < 26) {
            size_t doff; int ld, cb, kind = 0; size_t ssoff = 0; int sld = 0, slot = 0;
            if (pn < 3) { doff = WS_AQ; ld = 768; cb = pn * 256; }
            else if (pn < 6) { doff = WS_AK; ld = 768; cb = (pn - 3) * 256; }
            else if (pn < 9) { doff = WS_AV; ld = 768; cb = (pn - 6) * 256; }
            else if (pn < 12) { doff = WS_G; ld = 2048; cb = (pn - 9) * 256; kind = 1; }
            else if (pn < 14) { doff = WS_CQ; ld = 512; cb = (pn - 12) * 256; kind = 2; ssoff = WS_CQSS; sld = 8; slot = (pn - 12) * 4 + wc; }
            else if (pn == 14) { doff = WS_CKV; ld = 256; cb = 0; kind = 2; ssoff = WS_CKVSS; sld = 4; slot = wc; }
            else if (pn < 18) { doff = WS_G; ld = 2048; cb = 768 + (pn - 15) * 256; kind = 1; }
            else if (pn < 20) { doff = WS_CQ2; ld = 512; cb = (pn - 18) * 256; }
            else if (pn < 22) { doff = WS_CK2; ld = 512; cb = (pn - 20) * 256; }
            else if (pn < 24) { doff = WS_CV; ld = 512; cb = (pn - 22) * 256; }
            else { doff = WS_G; ld = 2048; cb = 1536 + (pn - 24) * 256; kind = 1; }
            bf16_t* dst = (bf16_t*)(ws + doff); float* ss = (float*)(ws + ssoff);
            const int col0 = cb + wc * 32 + 8 * fq;
#pragma unroll
            for (int ai = 0; ai < 2; ++ai)
#pragma unroll
                for (int m = 0; m < 4; ++m) { const int row = row0 + ai * HALF + m * 16; bf16_t* rowp = dst + (size_t)row * ld + col0; const float r = rs[ai][m]; float sq = 0.f;
#pragma unroll
                    for (int bj = 0; bj < 2; ++bj) { f32x4 v0 = acc[ai][bj][m][0] * r, v1 = acc[ai][bj][m][1] * r;
                        if (kind == 1) {
#pragma unroll
                            for (int j = 0; j < 4; ++j) { v0[j] = silu_f(v0[j]); v1[j] = silu_f(v1[j]); } }
                        if (kind == 2) sq += ((v0[0] * v0[0] + v0[1] * v0[1]) + (v0[2] * v0[2] + v0[3] * v0[3])) + ((v1[0] * v1[0] + v1[1] * v1[1]) + (v1[2] * v1[2] + v1[3] * v1[3]));
                        *(u32x4*)(rowp + bj * HALF) = pack8v(v0, v1); }
                    if (kind == 2) { sq += __shfl_xor(sq, 16); sq += __shfl_xor(sq, 32); if (fq == 0) ss[(size_t)row * sld + slot] = sq; } }
        } else {
            if (wc < 2) {
                const int i0 = 16 * wc + 4 * fq; const float* ropeC = (const float*)(ws + WS_ROPE); const float* ropeS = ropeC + 4096 * 32; bf16_t* KB = (bf16_t*)(ws + WS_KB);
#pragma unroll
                for (int ai = 0; ai < 2; ++ai)
#pragma unroll
                    for (int m = 0; m < 4; ++m) { const int row = row0 + ai * HALF + m * 16; const float r = rs[ai][m]; const int t = row & 4095;
                        const f32x4 cs = *(const f32x4*)(ropeC + t * 32 + i0), sn = *(const f32x4*)(ropeS + t * 32 + i0);
                        u32x2 lo, hi; rope4(acc[ai][0][m][0] * r, acc[ai][0][m][1] * r, cs, sn, lo, hi);
                        bf16_t* kp = KB + (size_t)row * 1152 + 128 + i0;
#pragma unroll
                        for (int h = 0; h < 6; ++h) { *(u32x2*)(kp + h * 192) = lo; *(u32x2*)(kp + h * 192 + 32) = hi; }
                        asm volatile("" ::: "memory"); }
            } else if (wc == 2 && fq == 0) {
                float* LOGF = (float*)(ws + WS_LOGF);
                f32x4 b0; b0[0] = bforget[0]; b0[1] = bforget[1]; b0[2] = bforget[2]; b0[3] = bforget[3]; f32x4 b1; b1[0] = bforget[4]; b1[1] = bforget[5]; b1[2] = 0.f; b1[3] = 0.f;
#pragma unroll
                for (int ai = 0; ai < 2; ++ai)
#pragma unroll
                    for (int m = 0; m < 4; ++m) { const int row = row0 + ai * HALF + m * 16; const float r = rs[ai][m];
                        f32x4 z0 = acc[ai][0][m][0] * r + b0, z1 = acc[ai][0][m][1] * r + b1, l0, l1;
#pragma unroll
                        for (int j = 0; j < 4; ++j) { l0[j] = fminf(z0[j], 0.f) - log1pf(__expf(-fabsf(z0[j]))); l1[j] = fminf(z1[j], 0.f) - log1pf(__expf(-fabsf(z1[j]))); }
                        l1[2] = 0.f; l1[3] = 0.f;
                        *(f32x4*)(LOGF + (size_t)row * 8) = l0; *(f32x4*)(LOGF + (size_t)row * 8 + 4) = l1; }
            }
        }
    }
};

struct EpiUq {
    static constexpr bool PERM = true, AFTER_DRAIN = false;
    unsigned char* ws;
    __device__ __forceinline__ void operator()(const f32x4 (&acc)[2][2][4][2], const Unit& u, int wr, int wc, int fr, int fq) const {
        const int row0 = u.pm * BM + wr * 64 + fr; const int pn = u.pn;
        const float* CQSS = (const float*)(ws + WS_CQSS); bf16_t* QB = (bf16_t*)(ws + WS_QB); const float* ropeC = (const float*)(ws + WS_ROPE); const float* ropeS = ropeC + 4096 * 32;
        float rs[2][4];
#pragma unroll
        for (int ai = 0; ai < 2; ++ai)
#pragma unroll
            for (int m = 0; m < 4; ++m) { const int row = row0 + ai * HALF + m * 16; const f32x2 a = *(const f32x2*)(CQSS + (size_t)row * 8 + fq * 2);
                float s = a[0] + a[1]; s += __shfl_xor(s, 16); s += __shfl_xor(s, 32); rs[ai][m] = rsqrtf(s * (1.0f / 512.0f) + RMS_EPS); }
        if (pn < 3) {
#pragma unroll
            for (int ai = 0; ai < 2; ++ai)
#pragma unroll
                for (int m = 0; m < 4; ++m) { const int row = row0 + ai * HALF + m * 16; const float r = rs[ai][m];
#pragma unroll
                    for (int bj = 0; bj < 2; ++bj) { const int h = pn * 2 + bj; bf16_t* p = QB + (size_t)row * 1152 + 192 * h + wc * 32 + 8 * fq;
                        *(u32x4*)p = pack8v(acc[ai][bj][m][0] * r, acc[ai][bj][m][1] * r); } }
        } else {
            const int i0 = 16 * (wc & 1) + 4 * fq;
#pragma unroll
            for (int ai = 0; ai < 2; ++ai)
#pragma unroll
                for (int m = 0; m < 4; ++m) { const int row = row0 + ai * HALF + m * 16; const float r = rs[ai][m]; const int t = row & 4095;
                    const f32x4 cs = *(const f32x4*)(ropeC + t * 32 + i0), sn = *(const f32x4*)(ropeS + t * 32 + i0);
#pragma unroll
                    for (int bj = 0; bj < 2; ++bj) { const int cc = (pn - 3) * 256 + bj * HALF + wc * 32; const int hh = cc >> 6;
                        if (hh < 6) { u32x2 lo, hi; rope4(acc[ai][bj][m][0] * r, acc[ai][bj][m][1] * r, cs, sn, lo, hi);
                            bf16_t* p = QB + (size_t)row * 1152 + 192 * hh + 128 + i0; *(u32x2*)p = lo; *(u32x2*)(p + 32) = hi; } }
                    asm volatile("" ::: "memory"); }
        }
    }
};
struct EpiUkv {
    static constexpr bool PERM = true, AFTER_DRAIN = false;
    unsigned char* ws;
    __device__ __forceinline__ void operator()(const f32x4 (&acc)[2][2][4][2], const Unit& u, int wr, int wc, int fr, int fq) const {
        const int row0 = u.pm * BM + wr * 64 + fr; const int pn = u.pn;
        const float* CKVSS = (const float*)(ws + WS_CKVSS); bf16_t* KB = (bf16_t*)(ws + WS_KB); bf16_t* VB = (bf16_t*)(ws + WS_VB);
#pragma unroll
        for (int ai = 0; ai < 2; ++ai)
#pragma unroll
            for (int m = 0; m < 4; ++m) { const int row = row0 + ai * HALF + m * 16; const f32x4 a = *(const f32x4*)(CKVSS + (size_t)row * 4);
                const float r = rsqrtf(((a[0] + a[1]) + (a[2] + a[3])) * (1.0f / 256.0f) + RMS_EPS);
#pragma unroll
                for (int bj = 0; bj < 2; ++bj) {
                    bf16_t* p;
                    if (pn < 3) p = KB + (size_t)row * 1152 + 192 * (pn * 2 + bj) + wc * 32 + 8 * fq;
                    else p = VB + (size_t)row * 768 + (pn - 3) * 256 + bj * HALF + wc * 32 + 8 * fq;
                    *(u32x4*)p = pack8v(acc[ai][bj][m][0] * r, acc[ai][bj][m][1] * r); } }
    }
};
struct EpiOut {
    static constexpr bool PERM = true, AFTER_DRAIN = false;
    const float* base; float* out; unsigned char* ws;
    __device__ __forceinline__ void operator()(const f32x4 (&acc)[2][2][4][2], const Unit& u, int wr, int wc, int fr, int fq) const {
        const int row0 = u.pm * BM + wr * 64 + fr; const int col0 = u.pn * BM + wc * 32 + 8 * fq;
        bf16_t* XB = (bf16_t*)(ws + WS_XB); float* xss = (float*)(ws + WS_XSS);
#pragma unroll
        for (int ai = 0; ai < 2; ++ai)
#pragma unroll
            for (int m = 0; m < 4; ++m) { const int row = row0 + ai * HALF + m * 16; const size_t off = (size_t)row * 2048 + col0; float sq = 0.f;
#pragma unroll
                for (int bj = 0; bj < 2; ++bj) { const f32x4 x0 = *(const f32x4*)(base + off + bj * HALF), x1 = *(const f32x4*)(base + off + bj * HALF + 4);
                    const f32x4 v0 = x0 + acc[ai][bj][m][0], v1 = x1 + acc[ai][bj][m][1];
                    sq += ((v0[0] * v0[0] + v0[1] * v0[1]) + (v0[2] * v0[2] + v0[3] * v0[3])) + ((v1[0] * v1[0] + v1[1] * v1[1]) + (v1[2] * v1[2] + v1[3] * v1[3]));
                    *(f32x4*)(out + off + bj * HALF) = v0; *(f32x4*)(out + off + bj * HALF + 4) = v1;
                    *(u32x4*)(XB + off + bj * HALF) = pack8v(v0, v1); }
                sq += __shfl_xor(sq, 16); sq += __shfl_xor(sq, 32); if (fq == 0) xss[(size_t)row * 32 + u.pn * 4 + wc] = sq; }
    }
};

template <class Epi, class Sched, bool ALIGN_EPI = false, bool SP2 = false>
__device__ __forceinline__ void gemm_phase(PG8_LAS unsigned char* lds, const Gemm g, const Sched& S, const Epi& E) {
    int tid_ = threadIdx.x; asm volatile("" : "+v"(tid_));
    const int tid = tid_, wid = __builtin_amdgcn_readfirstlane(tid >> 6), lane = tid & 63, wr = wid >> 2, wc = wid & 3, fr = lane & 15, fq = lane >> 4;
    const int K = g.K, nt = K / BK;
    unsigned voffA[2], voffB[2];
#pragma unroll
    for (int i = 0; i < 2; ++i) { int R, C; stage_rc(tid * 16 + i * 8192, R, C); const int Rb = Epi::PERM ? ((R & ~31) + perm32(R & 31)) : R;
        voffA[i] = (unsigned)(R * K + C) * 2u; voffB[i] = (unsigned)(Rb * K + C) * 2u; }
    const size_t kstep = (size_t)(BK * 2);
    const size_t hstep = (size_t)HALF * K * 2;
    const size_t tstep = 2 * hstep;
    const unsigned ldsw = (unsigned)wid * 1024u;
    const int aoff = lds_byte(wr * 64 + fr, fq * 8), boff = lds_byte(wc * 32 + fr, fq * 8);
#define PG8_SA(b, h) (((b) * 2 + (h)) * HTB)
#define PG8_SB(b, h) ((4 + (b) * 2 + (h)) * HTB)
#define PG8_STAGE(bufoff, gbase, voff) do { _Pragma("unroll") for (int _i = 0; _i < 2; ++_i) \
        __builtin_amdgcn_global_load_lds((const unsigned*)((const char*)(gbase) + (voff)[_i]), (PG8_LAS unsigned*)(lds + (bufoff) + ldsw + _i * 8192), 16, 0, 0); } while (0)
#define PG8_LDA(dst, b, h) do { _Pragma("unroll") for (int m = 0; m < 4; ++m) _Pragma("unroll") for (int k = 0; k < 2; ++k) dst[m][k] = *(const PG8_LAS bf16x8*)(lds + PG8_SA(b, h) + aoff + m * 2048 + k * 1024); } while (0)
#define PG8_LDB(dst, b, h) do { _Pragma("unroll") for (int n = 0; n < 2; ++n) _Pragma("unroll") for (int k = 0; k < 2; ++k) dst[n][k] = *(const PG8_LAS bf16x8*)(lds + PG8_SB(b, h) + boff + n * 2048 + k * 1024); } while (0)
#define PG8_MMA(ai, bj, At, Bt) do { __builtin_amdgcn_s_setprio(1); _Pragma("unroll") for (int m = 0; m < 4; ++m) _Pragma("unroll") for (int n = 0; n < 2; ++n) _Pragma("unroll") for (int k = 0; k < 2; ++k) \
        acc[ai][bj][m][n] = __builtin_amdgcn_mfma_f32_16x16x32_bf16(Bt[n][k], At[m][k], acc[ai][bj][m][n], 0, 0, 0); __builtin_amdgcn_s_setprio(0); } while (0)
#define PG8_WAIT_V(n) asm volatile("s_waitcnt vmcnt(" #n ")" ::: "memory")
#define PG8_WAIT_L(n) asm volatile("s_waitcnt lgkmcnt(" #n ")" ::: "memory")
#define PG8_BAR __builtin_amdgcn_s_barrier()
#define PG8_SCHED __builtin_amdgcn_sched_barrier(0)
    Unit cur, nxt; int ui = 0;
    if (!S.next(0, cur)) return;
    f32x4 acc[2][2][4][2];
#pragma unroll
    for (int a = 0; a < 2; ++a)
#pragma unroll
        for (int b = 0; b < 2; ++b)
#pragma unroll
            for (int m = 0; m < 4; ++m)
#pragma unroll
                for (int n = 0; n < 2; ++n) acc[a][b][m][n] = (f32x4){0.f, 0.f, 0.f, 0.f};
    bf16x8 At[4][2], B0[2][2], B1[2][2];
    const char* cA = (const char*)g.A + (size_t)cur.pm * tstep; const char* cB = (const char*)g.Bt + (size_t)cur.pn * tstep;
    S.a_ready(cur);
    if constexpr (SP2) {
        PG8_STAGE(PG8_SB(0, 0), cB, voffB); PG8_STAGE(PG8_SB(0, 1), cB + hstep, voffB); PG8_STAGE(PG8_SA(0, 0), cA, voffA); PG8_STAGE(PG8_SA(0, 1), cA + hstep, voffA);
        if (wr == 1) PG8_BAR;
        PG8_WAIT_V(2); PG8_BAR;
        PG8_STAGE(PG8_SB(1, 0), cB + kstep, voffB); PG8_STAGE(PG8_SA(1, 0), cA + kstep, voffA); PG8_STAGE(PG8_SB(1, 1), cB + hstep + kstep, voffB);
        PG8_WAIT_V(6); PG8_BAR;
    } else {
        PG8_STAGE(PG8_SB(0, 0), cB, voffB); PG8_STAGE(PG8_SA(0, 0), cA, voffA); PG8_STAGE(PG8_SB(0, 1), cB + hstep, voffB); PG8_STAGE(PG8_SA(0, 1), cA + hstep, voffA);
        if (wr == 1) PG8_BAR;
        PG8_WAIT_V(4); PG8_BAR;
        PG8_STAGE(PG8_SB(1, 0), cB + kstep, voffB); PG8_STAGE(PG8_SA(1, 0), cA + kstep, voffA); PG8_STAGE(PG8_SB(1, 1), cB + hstep + kstep, voffB);
        PG8_WAIT_V(6); PG8_BAR;
    }
    for (;;) {
        const bool has_next = S.next(ui + 1, nxt);
        const char* nA = has_next ? (const char*)g.A + (size_t)nxt.pm * tstep : cA; const char* nB = has_next ? (const char*)g.Bt + (size_t)nxt.pn * tstep : cB;
        for (int t = 0; t < nt; t += 2) {
            const bool last = (t == nt - 2);
            const char* a1 = cA + (size_t)(t + 1) * kstep;
            const char* a2 = last ? nA : cA + (size_t)(t + 2) * kstep; const char* b2 = last ? nB : cB + (size_t)(t + 2) * kstep;
            const char* a3 = a2 + kstep; const char* b3 = b2 + kstep;
            if (last && has_next) S.a_ready(nxt);
            if constexpr (SP2) {
            PG8_LDB(B0, 0, 0); PG8_LDB(B1, 0, 1); PG8_SCHED; PG8_LDA(At, 0, 0); PG8_STAGE(PG8_SA(1, 1), a1 + hstep, voffA);
            PG8_WAIT_V(8); PG8_WAIT_L(0); PG8_BAR; PG8_MMA(0, 0, At, B0); PG8_MMA(0, 1, At, B1); PG8_BAR; PG8_SCHED;
            PG8_LDA(At, 0, 1); PG8_STAGE(PG8_SB(0, 0), b2, voffB); PG8_STAGE(PG8_SB(0, 1), b2 + hstep, voffB); PG8_STAGE(PG8_SA(0, 0), a2, voffA);
            PG8_WAIT_V(8); PG8_WAIT_L(0); PG8_BAR; PG8_MMA(1, 0, At, B0); PG8_MMA(1, 1, At, B1); PG8_BAR; PG8_SCHED;
            PG8_LDB(B0, 1, 0); PG8_LDB(B1, 1, 1); PG8_SCHED; PG8_LDA(At, 1, 0); PG8_STAGE(PG8_SA(0, 1), a2 + hstep, voffA);
            PG8_WAIT_V(8); PG8_WAIT_L(0); PG8_BAR; PG8_MMA(0, 0, At, B0); PG8_MMA(0, 1, At, B1); PG8_BAR; PG8_SCHED;
            PG8_LDA(At, 1, 1); PG8_STAGE(PG8_SB(1, 0), b3, voffB); PG8_STAGE(PG8_SB(1, 1), b3 + hstep, voffB); PG8_STAGE(PG8_SA(1, 0), a3, voffA);
            PG8_WAIT_V(8); PG8_WAIT_L(0); PG8_BAR; PG8_MMA(1, 0, At, B0); PG8_MMA(1, 1, At, B1); PG8_BAR; PG8_SCHED;
            } else {
            PG8_LDB(B0, 0, 0); PG8_SCHED; PG8_LDA(At, 0, 0); PG8_STAGE(PG8_SA(1, 1), a1 + hstep, voffA);
            PG8_WAIT_L(8); PG8_BAR; PG8_WAIT_L(0); PG8_MMA(0, 0, At, B0); PG8_BAR; PG8_SCHED;
            PG8_LDB(B1, 0, 1); PG8_STAGE(PG8_SB(0, 0), b2, voffB);
            PG8_BAR; PG8_WAIT_L(0); PG8_MMA(0, 1, At, B1); PG8_BAR;
            PG8_LDA(At, 0, 1); PG8_STAGE(PG8_SA(0, 0), a2, voffA);
            PG8_BAR; PG8_WAIT_L(0); PG8_MMA(1, 0, At, B0); PG8_BAR; PG8_SCHED;
            PG8_STAGE(PG8_SB(0, 1), b2 + hstep, voffB);
            PG8_WAIT_V(6); PG8_BAR; PG8_MMA(1, 1, At, B1); PG8_BAR;
            PG8_LDB(B0, 1, 0); PG8_SCHED; PG8_LDA(At, 1, 0); PG8_STAGE(PG8_SA(0, 1), a2 + hstep, voffA);
            PG8_WAIT_L(8); PG8_BAR; PG8_WAIT_L(0); PG8_MMA(0, 0, At, B0); PG8_BAR; PG8_SCHED;
            PG8_LDB(B1, 1, 1); PG8_STAGE(PG8_SB(1, 0), b3, voffB);
            PG8_BAR; PG8_WAIT_L(0); PG8_MMA(0, 1, At, B1); PG8_BAR;
            PG8_LDA(At, 1, 1); PG8_STAGE(PG8_SA(1, 0), a3, voffA);
            PG8_BAR; PG8_WAIT_L(0); PG8_MMA(1, 0, At, B0); PG8_BAR; PG8_SCHED;
            PG8_STAGE(PG8_SB(1, 1), b3 + hstep, voffB);
            PG8_WAIT_V(6); PG8_BAR; PG8_MMA(1, 1, At, B1); PG8_BAR;
            }
        }
        if constexpr (ALIGN_EPI) { if (wr == 0) PG8_BAR; }
        if constexpr (!Epi::AFTER_DRAIN) { E(acc, cur, wr, wc, fr, fq); S.done(cur); }
        if (!has_next) break;
#pragma unroll
        for (int a = 0; a < 2; ++a)
#pragma unroll
            for (int b = 0; b < 2; ++b)
#pragma unroll
                for (int m = 0; m < 4; ++m)
#pragma unroll
                    for (int n = 0; n < 2; ++n) acc[a][b][m][n] = (f32x4){0.f, 0.f, 0.f, 0.f};
        cur = nxt; cA = nA; cB = nB; ++ui;
        if constexpr (ALIGN_EPI) { if (wr == 1) PG8_BAR; }
    }
    PG8_WAIT_V(0);
    if constexpr (!ALIGN_EPI) { if (wr == 0) PG8_BAR; }
    PG8_BAR;
    if constexpr (Epi::AFTER_DRAIN) { E.fused(acc, cur, wr, wc, fr, fq, lds, wid, lane); S.done(cur); }
#undef PG8_SA
#undef PG8_SB
#undef PG8_STAGE
#undef PG8_LDA
#undef PG8_LDB
#undef PG8_MMA
#undef PG8_WAIT_V
#undef PG8_WAIT_L
#undef PG8_BAR
#undef PG8_SCHED
}
}
#define GAS __attribute__((address_space(1)))
#define LAS __attribute__((address_space(3)))
typedef unsigned short bf16;
typedef unsigned v4u __attribute__((ext_vector_type(4)));
typedef float f32x4 __attribute__((ext_vector_type(4)));
typedef float f32x2 __attribute__((ext_vector_type(2)));
typedef short bf16x8 __attribute__((ext_vector_type(8)));
#define LDS_WAIT() asm volatile("s_waitcnt lgkmcnt(0)" ::: "memory")

__device__ __forceinline__ unsigned f2bf(float f) { unsigned u = __builtin_bit_cast(unsigned, f); return (u + 0x7fffu + ((u >> 16) & 1u)) >> 16; }
__device__ __forceinline__ unsigned pk2(float lo, float hi) { return f2bf(lo) | (f2bf(hi) << 16); }
__device__ __forceinline__ float bf2f(unsigned short h) { return __builtin_bit_cast(float, (unsigned)h << 16); }
__device__ __forceinline__ float wave_sum(float v) {
#pragma unroll
    for (int o = 1; o < 64; o <<= 1) v += __shfl_xor(v, o);
    return v;
}
__device__ __forceinline__ float wave_max(float v) {
#pragma unroll
    for (int o = 1; o < 64; o <<= 1) v = fmaxf(v, __shfl_xor(v, o));
    return v;
}

struct Args {
    const float* in[16]; float* out; unsigned char* ws; int ph_lo, ph_hi;
};

__device__ __forceinline__ int colmap_in(int n) {
    const int t = n >> 8;
    if (t < 9) return n;
    if (t < 12) return 2310 + (n - 2304);
    if (t < 14) return 3078 + (n - 3072);
    if (t == 14) return 3590 + (n - 3584);
    if (t < 18) return 3910 + (n - 3840);
    if (t < 20) return 4678 + (n - 4608);
    if (t < 22) return 5190 + (n - 5120);
    if (t < 24) return 5702 + (n - 5632);
    if (t < 26) return 6214 + (n - 6144);
    const int j = n & 255;
    if (j < 64) return 3846 + (j >> 1) + 32 * (j & 1);
    if (j < 70) return 2304 + (j - 64);
    return -1;
}
__device__ __forceinline__ int colmap_uq(int n) {
    if (n < 768) return 192 * (n >> 7) + (n & 127);
    if (n < 1152) { const int hh = (n - 768) >> 6, p = (n - 768) & 63; return 192 * hh + 128 + (p >> 1) + 32 * (p & 1); }
    return -1;
}
__device__ __forceinline__ int colmap_ukv(int n) {
    if (n < 768) return 256 * (n >> 7) + (n & 127);
    const int c = n - 768; return 256 * (c >> 7) + 128 + (c & 127);
}
template <int MAT> __device__ __forceinline__ void tr_item(const float* W, int Norig, const float* gk, bf16* WT, int K, int k0, int n0, LAS float* scr, int lane) {
    const int nn = lane & 31; int oc;
    if (MAT == 0) oc = colmap_in(n0 + nn); else if (MAT == 1) oc = colmap_uq(n0 + nn); else if (MAT == 2) oc = colmap_ukv(n0 + nn); else oc = n0 + nn;
#pragma unroll 8
    for (int i = 0; i < 32; ++i) { const int kk = 2 * i + (lane >> 5); float v = 0.f;
        if (oc >= 0) { v = W[(size_t)(k0 + kk) * Norig + oc]; if (gk) v *= gk[k0 + kk]; }
        scr[kk * 33 + nn] = v; }
    LDS_WAIT(); asm volatile("" ::: "memory");
    const int c = lane & 7;
#pragma unroll
    for (int j = 0; j < 4; ++j) { const int n = (lane >> 3) + 8 * j; const LAS float* s = scr + (8 * c) * 33 + n;
        v4u o; o.x = pk2(s[0 * 33], s[1 * 33]); o.y = pk2(s[2 * 33], s[3 * 33]); o.z = pk2(s[4 * 33], s[5 * 33]); o.w = pk2(s[6 * 33], s[7 * 33]);
        *(v4u*)(WT + (size_t)(n0 + n) * K + k0 + 8 * c) = o; }
    LDS_WAIT(); asm volatile("" ::: "memory");
}

__device__ __forceinline__ int t5_bucket(int rel) {
    const int n = rel < 0 ? -rel : rel; int v;
    if (n < 8) v = n; else if (n < 12) v = 8; else if (n < 16) v = 9; else if (n < 23) v = 10; else if (n < 32) v = 11; else if (n < 46) v = 12; else if (n < 64) v = 13; else if (n < 91) v = 14; else v = 15;
    return (rel > 0 ? 16 : 0) + v;
}

__device__ __forceinline__ int opaque_tid() { int t = threadIdx.x; asm volatile("" : "+v"(t)); return t; }
#define C_tid (tid_o)
#define C_lane (tid_o & 63)
#define C_wave (__builtin_amdgcn_readfirstlane(tid_o >> 6))
#define C_G ((int)gridDim.x)
#define C_bid ((int)blockIdx.x)
#define WSP(T, off) ((T*)(args.ws + (off)))

__device__ __forceinline__ void p0_prologue(const Args& args, LAS unsigned char* lds) {
    const int tid_o = opaque_tid();
    LAS float* scr = (LAS float*)(lds + C_wave * 16384);
    const int gw = C_bid * NWAVES + C_wave, NGW = C_G * NWAVES;
    constexpr int I_IN = (DM / 64) * (NIN_PAD / 32), I_UQ = (512 / 64) * (NUQ_PAD / 32), I_UKV = (256 / 64) * (NUKV / 32), I_OUT = (DM / 64) * (DM / 32);
    constexpr int PER_LAYER = I_IN + I_UQ + I_UKV + I_OUT;
    for (int it = gw; it < DEPTH * PER_LAYER; it += NGW) {
        const int l = it / PER_LAYER; int r = it - l * PER_LAYER;
        if (r < I_IN) { const int nb = NIN_PAD / 32, kb = r / nb, nbk = r - kb * nb;
            tr_item<0>(args.in[2] + (size_t)l * DM * NIN, NIN, args.in[1] + l * DM, WSP(bf16, WS_WIN) + (size_t)l * NIN_PAD * DM, DM, kb * 64, nbk * 32, scr, C_lane); continue; }
        r -= I_IN;
        if (r < I_UQ) { const int nb = NUQ_PAD / 32, kb = r / nb, nbk = r - kb * nb;
            tr_item<1>(args.in[5] + (size_t)l * 512 * 1152, 1152, args.in[4] + l * 512, WSP(bf16, WS_WUQ) + (size_t)l * NUQ_PAD * 512, 512, kb * 64, nbk * 32, scr, C_lane); continue; }
        r -= I_UQ;
        if (r < I_UKV) { const int nb = NUKV / 32, kb = r / nb, nbk = r - kb * nb;
            tr_item<2>(args.in[7] + (size_t)l * 256 * 1536, 1536, args.in[6] + l * 256, WSP(bf16, WS_WUKV) + (size_t)l * NUKV * 256, 256, kb * 64, nbk * 32, scr, C_lane); continue; }
        r -= I_UKV;
        { const int nb = DM / 32, kb = r / nb, nbk = r - kb * nb;
            tr_item<3>(args.in[14] + (size_t)l * DM * DM, DM, nullptr, WSP(bf16, WS_WOUT) + (size_t)l * DM * DM, DM, kb * 64, nbk * 32, scr, C_lane); }
    }
    for (int m = gw; m < M; m += NGW) {
        const f32x4* xr = (const f32x4*)(args.in[0] + (size_t)m * DM) + C_lane; float s = 0.f;
        unsigned long long* o8 = (unsigned long long*)(WSP(bf16, WS_XB) + (size_t)m * DM) + C_lane;
#pragma unroll
        for (int j = 0; j < 8; ++j) { const f32x4 v = xr[64 * j]; s += (v[0] * v[0] + v[1] * v[1]) + (v[2] * v[2] + v[3] * v[3]);
            o8[64 * j] = (unsigned long long)pk2(v[0], v[1]) | ((unsigned long long)pk2(v[2], v[3]) << 32); }
        s = wave_sum(s);
        if (C_lane < 32) WSP(float, WS_XSS)[(size_t)m * 32 + C_lane] = C_lane == 0 ? s : 0.f;
    }
    for (int e = C_bid * NTHREADS + C_tid; e < SEQ * 32; e += C_G * NTHREADS) {
        const int s = e >> 5, i = e & 31; const float inv = powf(10000.0f, -(float)i / 32.0f); const float ang = (float)s * inv;
        WSP(float, WS_ROPE)[e] = cosf(ang); WSP(float, WS_ROPE + SEQ * 32 * 4)[e] = sinf(ang);
    }
}

__device__ __forceinline__ void p2_scan(const Args& args) {
    const int tid_o = opaque_tid();
    if (C_bid >= NB * 6 || C_wave != 0) return;
    const int b = C_bid / 6, h = C_bid % 6, lane = C_lane;
    const float* src = WSP(float, WS_LOGF) + ((size_t)b * SEQ + 64 * lane) * 8 + h;
    float tot = 0.f;
#pragma unroll 8
    for (int j = 0; j < 64; ++j) tot += src[j * 8];
    float incl = tot;
#pragma unroll
    for (int o = 1; o < 64; o <<= 1) { const float y = __shfl_up(incl, o); if (lane >= o) incl += y; }
    float run = incl - tot;
    float* dst = WSP(float, WS_CUMT) + (size_t)C_bid * SEQ + 64 * lane;
#pragma unroll 8
    for (int j = 0; j < 64; ++j) { run += src[j * 8]; dst[j] = run; }
}

template <int DQK> __device__ __forceinline__ float dot_row(const bf16* kp, const LAS float* qs) {
    float s = 0.f;
#pragma unroll
    for (int c = 0; c < DQK / 8; ++c) { const v4u kv = *(const v4u*)(kp + c * 8);
        const f32x4 q0 = *(const LAS f32x4*)(qs + c * 8), q1 = *(const LAS f32x4*)(qs + c * 8 + 4);
        s += bf2f(kv.x & 0xffff) * q0[0] + bf2f(kv.x >> 16) * q0[1] + bf2f(kv.y & 0xffff) * q0[2] + bf2f(kv.y >> 16) * q0[3]
           + bf2f(kv.z & 0xffff) * q1[0] + bf2f(kv.z >> 16) * q1[1] + bf2f(kv.w & 0xffff) * q1[2] + bf2f(kv.w >> 16) * q1[3]; }
    return s;
}
template <int VAR, int DQK>
__device__ __forceinline__ void naive_map(const LAS float* qs, const bf16* Kbase, int kpitch, const bf16* Vbase, int vpitch, int nkeys, int t, const float* cum, float cumt,
                                          const float* relb, int h, int lane, float& o0, float& o1, float& l) {
    float m = -1e30f; l = 0.f; o0 = 0.f; o1 = 0.f;
    for (int k0 = 0; k0 < nkeys; k0 += 64) {
        const int key = k0 + lane;
        float s = dot_row<DQK>(Kbase + (size_t)key * kpitch, qs);
        if (VAR == 0) { s += cumt - cum[key]; if (key > t) s = -INFINITY; }
        if (VAR == 2) s += relb[t5_bucket(key - t) * 4 + h];
        const float tmax = wave_max(s), mn = fmaxf(m, tmax), alpha = __expf(m - mn), p = __expf(s - mn);
        l = l * alpha + wave_sum(p); o0 *= alpha; o1 *= alpha; m = mn;
        const bf16* vp = Vbase + (size_t)k0 * vpitch + 2 * lane;
#pragma unroll 8
        for (int kk = 0; kk < 64; ++kk) { const float pk = __shfl(p, kk); const unsigned vv = *(const unsigned*)(vp + (size_t)kk * vpitch);
            o0 += pk * bf2f(vv & 0xffff); o1 += pk * bf2f(vv >> 16); }
    }
}
__device__ __forceinline__ void p3_naive(const Args& args, int layer, LAS unsigned char* lds) {
    const int tid_o = opaque_tid();
    LAS float* qs = (LAS float*)(lds + C_wave * 1024);
    const int gw = C_bid * NWAVES + C_wave, NGW = C_G * NWAVES, lane = C_lane;
    const float lam_init = 0.8f - 0.6f * expf(-0.3f * (float)layer);
    const float d1 = wave_sum(args.in[8][layer * 64 + lane] * args.in[9][layer * 64 + lane]), d2 = wave_sum(args.in[10][layer * 64 + lane] * args.in[11][layer * 64 + lane]);
    const float lam = expf(d1) - expf(d2) + lam_init;
    for (int u = gw; u < M * 16; u += NGW) {
        const int row = u >> 4, hh = u & 15, b = row >> 12, t = row & 4095; const size_t rb = (size_t)b * SEQ;
        float o0, o1, l;
        if (hh < 6) {
            const int h = hh; const bf16* q = WSP(bf16, WS_AQ) + (size_t)row * 768 + 128 * h;
            qs[lane] = bf2f(q[lane]) * 0.08838834764831845f; qs[lane + 64] = bf2f(q[lane + 64]) * 0.08838834764831845f; LDS_WAIT();
            const float* cum = WSP(float, WS_CUMT) + (size_t)(b * 6 + h) * SEQ;
            naive_map<0, 128>(qs, WSP(bf16, WS_AK) + rb * 768 + 128 * h, 768, WSP(bf16, WS_AV) + rb * 768 + 128 * h, 768, t + 1, t, cum, cum[t], nullptr, h, lane, o0, o1, l);
            bf16* g = WSP(bf16, WS_G) + (size_t)row * 2048 + 128 * h + 2 * lane; const unsigned gv = *(const unsigned*)g; const float il = 1.0f / l;
            *(unsigned*)g = pk2(o0 * il * bf2f(gv & 0xffff), o1 * il * bf2f(gv >> 16));
        } else if (hh < 12) {
            const int h = hh - 6; const bf16* q = WSP(bf16, WS_QB) + (size_t)row * 1152 + 192 * h; const float sc = 0.07216878364870322f;
            qs[lane] = bf2f(q[lane]) * sc; qs[lane + 64] = bf2f(q[lane + 64]) * sc; qs[lane + 128] = bf2f(q[lane + 128]) * sc; LDS_WAIT();
            naive_map<1, 192>(qs, WSP(bf16, WS_KB) + rb * 1152 + 192 * h, 1152, WSP(bf16, WS_VB) + rb * 768 + 128 * h, 768, 64 * (t / 64 + 1), t, nullptr, 0.f, nullptr, h, lane, o0, o1, l);
            bf16* g = WSP(bf16, WS_G) + (size_t)row * 2048 + 768 + 128 * h + 2 * lane; const unsigned gv = *(const unsigned*)g; const float il = 1.0f / l;
            *(unsigned*)g = pk2(o0 * il * bf2f(gv & 0xffff), o1 * il * bf2f(gv >> 16));
        } else {
            const int h = hh - 12; const bf16* q = WSP(bf16, WS_CQ2) + (size_t)row * 512 + 128 * h;
            qs[lane] = bf2f(q[lane]) * 0.125f; qs[lane + 64] = bf2f(q[lane + 64]) * 0.125f; LDS_WAIT();
            float p0, p1, pl;
            naive_map<2, 64>(qs, WSP(bf16, WS_CK2) + rb * 512 + 128 * h, 512, WSP(bf16, WS_CV) + rb * 512 + 128 * h, 512, 64 * (t / 64 + 1), t, nullptr, 0.f, args.in[13], h, lane, o0, o1, l);
            naive_map<2, 64>(qs + 64, WSP(bf16, WS_CK2) + rb * 512 + 128 * h + 64, 512, WSP(bf16, WS_CV) + rb * 512 + 128 * h, 512, 64 * (t / 64 + 1), t, nullptr, 0.f, args.in[13], h, lane, p0, p1, pl);
            const float il1 = 1.0f / l, il2 = lam / pl; const float c0 = o0 * il1 - p0 * il2, c1 = o1 * il1 - p1 * il2;
            const float ss = wave_sum(c0 * c0 + c1 * c1); const float r = rsqrtf(ss * (1.0f / 128.0f) + EPS) * (1.0f - lam_init);
            const float* sg = args.in[12] + layer * 128 + 2 * lane;
            bf16* g = WSP(bf16, WS_G) + (size_t)row * 2048 + 1536 + 128 * h + 2 * lane; const unsigned gv = *(const unsigned*)g;
            *(unsigned*)g = pk2(c0 * r * sg[0] * bf2f(gv & 0xffff), c1 * r * sg[1] * bf2f(gv >> 16));
        }
        LDS_WAIT();
    }
}

__device__ __forceinline__ void p5_final(const Args& args) {
    const int tid_o = opaque_tid();
    const int gw = C_bid * NWAVES + C_wave, NGW = C_G * NWAVES, lane = C_lane;
    for (int m = gw; m < M; m += NGW) {
        float s = lane < 32 ? WSP(float, WS_XSS)[(size_t)m * 32 + lane] : 0.f; s = wave_sum(s);
        const float r = rsqrtf(s * (1.0f / 2048.0f) + EPS);
        f32x4* xr = (f32x4*)(args.out + (size_t)m * DM) + lane; const f32x4* gr = (const f32x4*)args.in[15] + lane;
#pragma unroll
        for (int j = 0; j < 8; ++j) { const f32x4 v = xr[64 * j], g = gr[64 * j]; xr[64 * j] = v * r * g; }
    }
}

#ifndef MK_FUSED
#define MK_FUSED 1
#endif
constexpr int N_PHASES = 10;

__global__ void __launch_bounds__(NTHREADS, 2) fwd_kernel(Args args) {
    extern __shared__ __attribute__((aligned(16))) unsigned char lds_raw[];
    LAS unsigned char* lds = (LAS unsigned char*)lds_raw;
    const int lo = args.ph_lo, hi = args.ph_hi;
#ifndef PH_MASK
#define PH_MASK 0x3ff
#endif
#define IN(k) (((PH_MASK >> ((k) > 4 ? (k) - 4 : (k))) & 1) && lo <= (k) && (k) < hi)
#if MK_FUSED
#define SEAM(k) do { if (IN(k) && IN((k) + 1)) { cg::this_grid().sync(); } } while (0)
#else
#define SEAM(k) do { } while (0)
#endif
    if (IN(0)) { p0_prologue(args, lds); __syncthreads(); }
    SEAM(0);
#pragma unroll 1
    for (int l = 0; l < DEPTH; ++l) {
        const int pb = 1 + 4 * l;
        if (IN(pb)) {
            pg8::Gemm g{WSP(bf16, WS_XB), WSP(bf16, WS_WIN) + (size_t)l * NIN_PAD * DM, M, NIN_PAD, DM}; pg8::StaticOrder S; S.init(M, NIN_PAD, C_G, C_bid);
            pg8::EpiIn E{args.ws, args.in[3] + l * 6};
            pg8::gemm_phase<pg8::EpiIn, pg8::StaticOrder, true, true>(lds, g, S, E);
        }
        SEAM(pb);
        if (IN(pb + 1)) {
            p2_scan(args);
            { pg8::Gemm g{WSP(bf16, WS_CQ), WSP(bf16, WS_WUQ) + (size_t)l * NUQ_PAD * 512, M, NUQ_PAD, 512}; pg8::StaticOrder S; S.init(M, NUQ_PAD, C_G, C_bid);
              pg8::EpiUq E{args.ws};
              pg8::gemm_phase<pg8::EpiUq, pg8::StaticOrder, true, true>(lds, g, S, E); }
            { pg8::Gemm g{WSP(bf16, WS_CKV), WSP(bf16, WS_WUKV) + (size_t)l * NUKV * 256, M, NUKV, 256}; pg8::StaticOrder S; S.init(M, NUKV, C_G, (C_bid + 128) % C_G);
              pg8::EpiUkv E{args.ws};
              pg8::gemm_phase<pg8::EpiUkv, pg8::StaticOrder, true, true>(lds, g, S, E); }
        }
        SEAM(pb + 1);
        if (IN(pb + 2)) { p3_naive(args, l, lds); __syncthreads(); }
        SEAM(pb + 2);
        if (IN(pb + 3)) {
            pg8::Gemm g{WSP(bf16, WS_G), WSP(bf16, WS_WOUT) + (size_t)l * DM * DM, M, DM, DM}; pg8::StaticOrder S; S.init(M, DM, C_G, C_bid);
            pg8::EpiOut E{l == 0 ? args.in[0] : args.out, args.out, args.ws};
            pg8::gemm_phase<pg8::EpiOut, pg8::StaticOrder, true, true>(lds, g, S, E);
        }
        SEAM(pb + 3);
    }
    if (IN(9)) p5_final(args);
#undef IN
#undef SEAM
}

extern "C" void kernel_launch(void* const* d_in, const int* in_sizes, int n_in, void* d_out, int out_size, void* d_ws, size_t ws_size, hipStream_t stream) {
    static int grid = 0;
    if (grid == 0) {
        if (n_in != 16 || in_sizes[0] != M * DM || out_size != M * DM || ws_size < WS_END) {
            fprintf(stderr, "kernel_launch: unexpected shapes (n_in %d, in0 %d, out %d, ws %zu; need ws >= %zu)\n", n_in, n_in > 0 ? in_sizes[0] : -1, out_size, ws_size, (size_t)WS_END); grid = -1; return; }
        int dev = 0, cus = 0, per_cu = 0;
        if (hipGetDevice(&dev) != hipSuccess || hipDeviceGetAttribute(&cus, hipDeviceAttributeMultiprocessorCount, dev) != hipSuccess) { fprintf(stderr, "kernel_launch: device query failed\n"); grid = -1; return; }
        if (hipFuncSetAttribute((const void*)fwd_kernel, hipFuncAttributeMaxDynamicSharedMemorySize, LDS_BYTES) != hipSuccess) { fprintf(stderr, "kernel_launch: hipFuncSetAttribute failed\n"); grid = -1; return; }
        if (hipOccupancyMaxActiveBlocksPerMultiprocessor(&per_cu, (const void*)fwd_kernel, NTHREADS, LDS_BYTES) != hipSuccess || per_cu < 1) {
            fprintf(stderr, "kernel_launch: occupancy query reports %d blocks per CU\n", per_cu); (void)hipGetLastError(); grid = -1; return; }
        grid = cus;
    }
    if (grid < 0) return;
    Args a{};
    for (int i = 0; i < 16; ++i) a.in[i] = (const float*)d_in[i];
    a.out = (float*)d_out; a.ws = (unsigned char*)d_ws;
#if MK_FUSED
    a.ph_lo = 0; a.ph_hi = N_PHASES;
    void* kargs[] = {&a};
    hipError_t e = hipLaunchCooperativeKernel((const void*)fwd_kernel, dim3(grid), dim3(NTHREADS), kargs, LDS_BYTES, stream);
    if (e != hipSuccess) fprintf(stderr, "kernel_launch: cooperative launch failed: %s (grid %d)\n", hipGetErrorString(e), grid);
#else
    for (int p = 0; p < N_PHASES; ++p) {
        a.ph_lo = p; a.ph_hi = p + 1;
        hipLaunchKernelGGL(fwd_kernel, dim3(grid), dim3(NTHREADS), LDS_BYTES, stream, a);
    }
#endif
}
```

```cpp
#include <hip/hip_runtime.h>
#include <hip/hip_cooperative_groups.h>
#include <cstdio>
#include <cstdint>
#include <cmath>
namespace cg = cooperative_groups;

constexpr int NB = 4, SEQ = 4096, DM = 2048, M = NB * SEQ, DEPTH = 2;
constexpr int NIN = 6726, NIN_PAD = 6912;
constexpr int NUQ_PAD = 1280, NUKV = 1536;
constexpr float EPS = 1e-6f;

constexpr size_t MiB = 1u << 20;
constexpr size_t WS_CTL = 0, CTL_ZERO_BYTES = 1 * MiB;
constexpr size_t WS_WIN = 1 * MiB;
constexpr size_t WS_WUQ = WS_WIN + 54 * MiB;
constexpr size_t WS_WUKV = WS_WUQ + 5 * MiB / 2;
constexpr size_t WS_WOUT = WS_WUKV + 3 * MiB / 2;
constexpr size_t WS_ROPE = WS_WOUT + 16 * MiB;
constexpr size_t WS_XSS = WS_ROPE + 1 * MiB;
constexpr size_t WS_LOGF = WS_XSS + 2 * MiB;
constexpr size_t WS_CUMT = WS_LOGF + MiB / 2;
constexpr size_t WS_CQSS = WS_CUMT + MiB / 2;
constexpr size_t WS_CKVSS = WS_CQSS + MiB / 2;
constexpr size_t WS_XB = WS_CKVSS + MiB / 2;
constexpr size_t WS_G = WS_XB + 64 * MiB;
constexpr size_t WS_AQ = WS_G + 64 * MiB, WS_AK = WS_AQ + 24 * MiB, WS_AV = WS_AK + 24 * MiB;
constexpr size_t WS_CQ = WS_AV + 24 * MiB;
constexpr size_t WS_CKV = WS_CQ + 16 * MiB;
constexpr size_t WS_QB = WS_CKV + 8 * MiB, WS_KB = WS_QB + 36 * MiB, WS_VB = WS_KB + 36 * MiB;
constexpr size_t WS_CQ2 = WS_VB + 24 * MiB, WS_CK2 = WS_CQ2 + 16 * MiB, WS_CV = WS_CK2 + 16 * MiB;
constexpr size_t WS_END = WS_CV + 16 * MiB;
static_assert(WS_END <= 512 * MiB, "workspace map");

constexpr int RING_BYTES = 131072, LDS_BYTES = 147456;
constexpr int NWAVES = 8, NTHREADS = 512;

namespace pg8 {
#define PG8_LAS __attribute__((address_space(3)))
typedef unsigned short bf16_t;
typedef short bf16x8 __attribute__((ext_vector_type(8)));
typedef float f32x4 __attribute__((ext_vector_type(4)));
typedef unsigned u32x4 __attribute__((ext_vector_type(4)));
constexpr int BM = 256, BK = 64, HALF = 128, HTB = HALF * BK * 2  , STAGE_BYTES = 8 * HTB, NXCD = 8, WGM = 8;

__host__ __device__ __forceinline__ int lds_byte(int r, int c) { const int st = (r >> 4) * 2 + (c >> 5), rr = r & 15, cc = c & 31, ob = rr * 64 + cc * 2; return st * 1024 + (ob ^ (((ob >> 9) & 1) << 5)); }
__host__ __device__ __forceinline__ void stage_rc(int b, int& R, int& C) { const int st = b / 1024, sb = b % 1024, swz = sb ^ (((sb >> 9) & 1) << 5); R = (st >> 1) * 16 + swz / 64; C = (st & 1) * 32 + (swz % 64) / 2; }
__host__ __device__ __forceinline__ int perm32(int rho) { const int n = rho >> 4, i = rho & 15; return 8 * (i >> 2) + 4 * n + (i & 3); }

struct Unit { int pm, pn; };
struct Gemm { const bf16_t* A; const bf16_t* Bt; int M, N, K; };

struct StaticOrder {
    int nM, nN, nwg, G, c;
    __host__ __device__ void init(int M, int N, int G_, int c_) { nM = M / BM; nN = N / BM; nwg = nM * nN; G = G_; c = c_; }
    __host__ __device__ bool next(int i, Unit& u) const {
        const long L = (long)i * G + c; if (L >= nwg) return false;
        int wgid = (int)L; { const int q = nwg / NXCD, r = nwg % NXCD, xcd = wgid % NXCD, off = wgid / NXCD; wgid = (xcd < r ? xcd * (q + 1) : r * (q + 1) + (xcd - r) * q) + off; }
        const int nig = WGM * nN, gid = wgid / nig, fm = gid * WGM, gsz = (nM - fm) < WGM ? (nM - fm) : WGM;
        u.pm = fm + ((wgid % nig) % gsz); u.pn = (wgid % nig) / gsz; return true;
    }
    __device__ __forceinline__ void a_ready(const Unit&) const {}
    __device__ __forceinline__ void done(const Unit&) const {}
};


__device__ __forceinline__ unsigned cvt_pk_bf16(float lo, float hi) { unsigned r; asm volatile("v_cvt_pk_bf16_f32 %0, %1, %2" : "=v"(r) : "v"(lo), "v"(hi)); return r; }
typedef float f32x2 __attribute__((ext_vector_type(2)));
typedef unsigned u32x2 __attribute__((ext_vector_type(2)));
constexpr float RMS_EPS = 1e-6f;
__device__ __forceinline__ float silu_f(float v) { return v / (1.0f + __expf(-v)); }
__device__ __forceinline__ u32x4 pack8v(f32x4 a, f32x4 b) { u32x4 w; w.x = cvt_pk_bf16(a[0], a[1]); w.y = cvt_pk_bf16(a[2], a[3]); w.z = cvt_pk_bf16(b[0], b[1]); w.w = cvt_pk_bf16(b[2], b[3]); return w; }
__device__ __forceinline__ void rope4(f32x4 v0, f32x4 v1, f32x4 cs, f32x4 sn, u32x2& lo, u32x2& hi) {
    const float a0 = v0[0], b0 = v0[1], a1 = v0[2], b1 = v0[3], a2 = v1[0], b2 = v1[1], a3 = v1[2], b3 = v1[3];
    lo.x = cvt_pk_bf16(a0 * cs[0] - b0 * sn[0], a1 * cs[1] - b1 * sn[1]); lo.y = cvt_pk_bf16(a2 * cs[2] - b2 * sn[2], a3 * cs[3] - b3 * sn[3]);
    hi.x = cvt_pk_bf16(a0 * sn[0] + b0 * cs[0], a1 * sn[1] + b1 * cs[1]); hi.y = cvt_pk_bf16(a2 * sn[2] + b2 * cs[2], a3 * sn[3] + b3 * cs[3]);
}

struct EpiIn {
    static constexpr bool PERM = true, AFTER_DRAIN = false;
    unsigned char* ws;
    const float* bforget;
    __device__ __forceinline__ void operator()(const f32x4 (&acc)[2][2][4][2], const Unit& u, int wr, int wc, int fr, int fq) const {
        const int row0 = u.pm * BM + wr * 64 + fr; const int pn = u.pn;
        const float* xss = (const float*)(ws + WS_XSS);
        float rs[2][4];
#pragma unroll
        for (int ai = 0; ai < 2; ++ai)
#pragma unroll
            for (int m = 0; m < 4; ++m) { const int row = row0 + ai * HALF + m * 16; const f32x4* p = (const f32x4*)(xss + (size_t)row * 32 + fq * 8);
                const f32x4 a = p[0], b = p[1]; float s = ((a[0] + a[1]) + (a[2] + a[3])) + ((b[0] + b[1]) + (b[2] + b[3]));
                s += __shfl_xor(s, 16); s += __shfl_xor(s, 32); rs[ai][m] = rsqrtf(s * (1.0f / 2048.0f) + RMS_EPS); }
        if (pn < 26) {
            size_t doff; int ld, cb, kind = 0; size_t ssoff = 0; int sld = 0, slot = 0;
            if (pn < 3) { doff = WS_AQ; ld = 768; cb = pn * 256; }
            else if (pn < 6) { doff = WS_AK; ld = 768; cb = (pn - 3) * 256; }
            else if (pn < 9) { doff = WS_AV; ld = 768; cb = (pn - 6) * 256; }
            else if (pn < 12) { doff = WS_G; ld = 2048; cb = (pn - 9) * 256; kind = 1; }
            else if (pn < 14) { doff = WS_CQ; ld = 512; cb = (pn - 12) * 256; kind = 2; ssoff = WS_CQSS; sld = 8; slot = (pn - 12) * 4 + wc; }
            else if (pn == 14) { doff = WS_CKV; ld = 256; cb = 0; kind = 2; ssoff = WS_CKVSS; sld = 4; slot = wc; }
            else if (pn < 18) { doff = WS_G; ld = 2048; cb = 768 + (pn - 15) * 256; kind = 1; }
            else if (pn < 20) { doff = WS_CQ2; ld = 512; cb = (pn - 18) * 256; }
            else if (pn < 22) { doff = WS_CK2; ld = 512; cb = (pn - 20) * 256; }
            else if (pn < 24) { doff = WS_CV; ld = 512; cb = (pn - 22) * 256; }
            else { doff = WS_G; ld = 2048; cb = 1536 + (pn - 24) * 256; kind = 1; }
            bf16_t* dst = (bf16_t*)(ws + doff); float* ss = (float*)(ws + ssoff);
            const int col0 = cb + wc * 32 + 8 * fq;
#pragma unroll
            for (int ai = 0; ai < 2; ++ai)
#pragma unroll
                for (int m = 0; m < 4; ++m) { const int row = row0 + ai * HALF + m * 16; bf16_t* rowp = dst + (size_t)row * ld + col0; const float r = rs[ai][m]; float sq = 0.f;
#pragma unroll
                    for (int bj = 0; bj < 2; ++bj) { f32x4 v0 = acc[ai][bj][m][0] * r, v1 = acc[ai][bj][m][1] * r;
                        if (kind == 1) {
#pragma unroll
                            for (int j = 0; j < 4; ++j) { v0[j] = silu_f(v0[j]); v1[j] = silu_f(v1[j]); } }
                        if (kind == 2) sq += ((v0[0] * v0[0] + v0[1] * v0[1]) + (v0[2] * v0[2] + v0[3] * v0[3])) + ((v1[0] * v1[0] + v1[1] * v1[1]) + (v1[2] * v1[2] + v1[3] * v1[3]));
                        *(u32x4*)(rowp + bj * HALF) = pack8v(v0, v1); }
                    if (kind == 2) { sq += __shfl_xor(sq, 16); sq += __shfl_xor(sq, 32); if (fq == 0) ss[(size_t)row * sld + slot] = sq; } }
        } else {
            if (wc < 2) {
                const int i0 = 16 * wc + 4 * fq; const float* ropeC = (const float*)(ws + WS_ROPE); const float* ropeS = ropeC + 4096 * 32; bf16_t* KB = (bf16_t*)(ws + WS_KB);
#pragma unroll
                for (int ai = 0; ai < 2; ++ai)
#pragma unroll
                    for (int m = 0; m < 4; ++m) { const int row = row0 + ai * HALF + m * 16; const float r = rs[ai][m]; const int t = row & 4095;
                        const f32x4 cs = *(const f32x4*)(ropeC + t * 32 + i0), sn = *(const f32x4*)(ropeS + t * 32 + i0);
                        u32x2 lo, hi; rope4(acc[ai][0][m][0] * r, acc[ai][0][m][1] * r, cs, sn, lo, hi);
                        bf16_t* kp = KB + (size_t)row * 1152 + 128 + i0;
#pragma unroll
                        for (int h = 0; h < 6; ++h) { *(u32x2*)(kp + h * 192) = lo; *(u32x2*)(kp + h * 192 + 32) = hi; }
                        asm volatile("" ::: "memory"); }
            } else if (wc == 2 && fq == 0) {
                float* LOGF = (float*)(ws + WS_LOGF);
                f32x4 b0; b0[0] = bforget[0]; b0[1] = bforget[1]; b0[2] = bforget[2]; b0[3] = bforget[3]; f32x4 b1; b1[0] = bforget[4]; b1[1] = bforget[5]; b1[2] = 0.f; b1[3] = 0.f;
#pragma unroll
                for (int ai = 0; ai < 2; ++ai)
#pragma unroll
                    for (int m = 0; m < 4; ++m) { const int row = row0 + ai * HALF + m * 16; const float r = rs[ai][m];
                        f32x4 z0 = acc[ai][0][m][0] * r + b0, z1 = acc[ai][0][m][1] * r + b1, l0, l1;
#pragma unroll
                        for (int j = 0; j < 4; ++j) { l0[j] = fminf(z0[j], 0.f) - log1pf(__expf(-fabsf(z0[j]))); l1[j] = fminf(z1[j], 0.f) - log1pf(__expf(-fabsf(z1[j]))); }
                        l1[2] = 0.f; l1[3] = 0.f;
                        *(f32x4*)(LOGF + (size_t)row * 8) = l0; *(f32x4*)(LOGF + (size_t)row * 8 + 4) = l1; }
            }
        }
    }
};

struct EpiUq {
    static constexpr bool PERM = true, AFTER_DRAIN = false;
    unsigned char* ws;
    __device__ __forceinline__ void operator()(const f32x4 (&acc)[2][2][4][2], const Unit& u, int wr, int wc, int fr, int fq) const {
        const int row0 = u.pm * BM + wr * 64 + fr; const int pn = u.pn;
        const float* CQSS = (const float*)(ws + WS_CQSS); bf16_t* QB = (bf16_t*)(ws + WS_QB); const float* ropeC = (const float*)(ws + WS_ROPE); const float* ropeS = ropeC + 4096 * 32;
        float rs[2][4];
#pragma unroll
        for (int ai = 0; ai < 2; ++ai)
#pragma unroll
            for (int m = 0; m < 4; ++m) { const int row = row0 + ai * HALF + m * 16; const f32x2 a = *(const f32x2*)(CQSS + (size_t)row * 8 + fq * 2);
                float s = a[0] + a[1]; s += __shfl_xor(s, 16); s += __shfl_xor(s, 32); rs[ai][m] = rsqrtf(s * (1.0f / 512.0f) + RMS_EPS); }
        if (pn < 3) {
#pragma unroll
            for (int ai = 0; ai < 2; ++ai)
#pragma unroll
                for (int m = 0; m < 4; ++m) { const int row = row0 + ai * HALF + m * 16; const float r = rs[ai][m];
#pragma unroll
                    for (int bj = 0; bj < 2; ++bj) { const int h = pn * 2 + bj; bf16_t* p = QB + (size_t)row * 1152 + 192 * h + wc * 32 + 8 * fq;
                        *(u32x4*)p = pack8v(acc[ai][bj][m][0] * r, acc[ai][bj][m][1] * r); } }
        } else {
            const int i0 = 16 * (wc & 1) + 4 * fq;
#pragma unroll
            for (int ai = 0; ai < 2; ++ai)
#pragma unroll
                for (int m = 0; m < 4; ++m) { const int row = row0 + ai * HALF + m * 16; const float r = rs[ai][m]; const int t = row & 4095;
                    const f32x4 cs = *(const f32x4*)(ropeC + t * 32 + i0), sn = *(const f32x4*)(ropeS + t * 32 + i0);
#pragma unroll
                    for (int bj = 0; bj < 2; ++bj) { const int cc = (pn - 3) * 256 + bj * HALF + wc * 32; const int hh = cc >> 6;
                        if (hh < 6) { u32x2 lo, hi; rope4(acc[ai][bj][m][0] * r, acc[ai][bj][m][1] * r, cs, sn, lo, hi);
                            bf16_t* p = QB + (size_t)row * 1152 + 192 * hh + 128 + i0; *(u32x2*)p = lo; *(u32x2*)(p + 32) = hi; } }
                    asm volatile("" ::: "memory"); }
        }
    }
};
struct EpiUkv {
    static constexpr bool PERM = true, AFTER_DRAIN = false;
    unsigned char* ws;
    __device__ __forceinline__ void operator()(const f32x4 (&acc)[2][2][4][2], const Unit& u, int wr, int wc, int fr, int fq) const {
        const int row0 = u.pm * BM + wr * 64 + fr; const int pn = u.pn;
        const float* CKVSS = (const float*)(ws + WS_CKVSS); bf16_t* KB = (bf16_t*)(ws + WS_KB); bf16_t* VB = (bf16_t*)(ws + WS_VB);
#pragma unroll
        for (int ai = 0; ai < 2; ++ai)
#pragma unroll
            for (int m = 0; m < 4; ++m) { const int row = row0 + ai * HALF + m * 16; const f32x4 a = *(const f32x4*)(CKVSS + (size_t)row * 4);
                const float r = rsqrtf(((a[0] + a[1]) + (a[2] + a[3])) * (1.0f / 256.0f) + RMS_EPS);
#pragma unroll
                for (int bj = 0; bj < 2; ++bj) {
                    bf16_t* p;
                    if (pn < 3) p = KB + (size_t)row * 1152 + 192 * (pn * 2 + bj) + wc * 32 + 8 * fq;
                    else p = VB + (size_t)row * 768 + (pn - 3) * 256 + bj * HALF + wc * 32 + 8 * fq;
                    *(u32x4*)p = pack8v(acc[ai][bj][m][0] * r, acc[ai][bj][m][1] * r); } }
    }
};
struct EpiOut {
    static constexpr bool PERM = true, AFTER_DRAIN = false;
    const float* base; float* out; unsigned char* ws;
    __device__ __forceinline__ void operator()(const f32x4 (&acc)[2][2][4][2], const Unit& u, int wr, int wc, int fr, int fq) const {
        const int row0 = u.pm * BM + wr * 64 + fr; const int col0 = u.pn * BM + wc * 32 + 8 * fq;
        bf16_t* XB = (bf16_t*)(ws + WS_XB); float* xss = (float*)(ws + WS_XSS);
#pragma unroll
        for (int ai = 0; ai < 2; ++ai)
#pragma unroll
            for (int m = 0; m < 4; ++m) { const int row = row0 + ai * HALF + m * 16; const size_t off = (size_t)row * 2048 + col0; float sq = 0.f;
#pragma unroll
                for (int bj = 0; bj < 2; ++bj) { const f32x4 x0 = *(const f32x4*)(base + off + bj * HALF), x1 = *(const f32x4*)(base + off + bj * HALF + 4);
                    const f32x4 v0 = x0 + acc[ai][bj][m][0], v1 = x1 + acc[ai][bj][m][1];
                    sq += ((v0[0] * v0[0] + v0[1] * v0[1]) + (v0[2] * v0[2] + v0[3] * v0[3])) + ((v1[0] * v1[0] + v1[1] * v1[1]) + (v1[2] * v1[2] + v1[3] * v1[3]));
                    *(f32x4*)(out + off + bj * HALF) = v0; *(f32x4*)(out + off + bj * HALF + 4) = v1;
                    *(u32x4*)(XB + off + bj * HALF) = pack8v(v0, v1); }
                sq += __shfl_xor(sq, 16); sq += __shfl_xor(sq, 32); if (fq == 0) xss[(size_t)row * 32 + u.pn * 4 + wc] = sq; }
    }
};

template <class Epi, class Sched, bool ALIGN_EPI = false, bool SP2 = false>
__device__ __forceinline__ void gemm_phase(PG8_LAS unsigned char* lds, const Gemm g, const Sched& S, const Epi& E) {
    int tid_ = threadIdx.x; asm volatile("" : "+v"(tid_));
    const int tid = tid_, wid = __builtin_amdgcn_readfirstlane(tid >> 6), lane = tid & 63, wr = wid >> 2, wc = wid & 3, fr = lane & 15, fq = lane >> 4;
    const int K = g.K, nt = K / BK;
    unsigned voffA[2], voffB[2];
#pragma unroll
    for (int i = 0; i < 2; ++i) { int R, C; stage_rc(tid * 16 + i * 8192, R, C); const int Rb = Epi::PERM ? ((R & ~31) + perm32(R & 31)) : R;
        voffA[i] = (unsigned)(R * K + C) * 2u; voffB[i] = (unsigned)(Rb * K + C) * 2u; }
    const size_t kstep = (size_t)(BK * 2);
    const size_t hstep = (size_t)HALF * K * 2;
    const size_t tstep = 2 * hstep;
    const unsigned ldsw = (unsigned)wid * 1024u;
    const int aoff = lds_byte(wr * 64 + fr, fq * 8), boff = lds_byte(wc * 32 + fr, fq * 8);
#define PG8_SA(b, h) (((b) * 2 + (h)) * HTB)
#define PG8_SB(b, h) ((4 + (b) * 2 + (h)) * HTB)
#define PG8_STAGE(bufoff, gbase, voff) do { _Pragma("unroll") for (int _i = 0; _i < 2; ++_i) \
        __builtin_amdgcn_global_load_lds((const unsigned*)((const char*)(gbase) + (voff)[_i]), (PG8_LAS unsigned*)(lds + (bufoff) + ldsw + _i * 8192), 16, 0, 0); } while (0)
#define PG8_LDA(dst, b, h) do { _Pragma("unroll") for (int m = 0; m < 4; ++m) _Pragma("unroll") for (int k = 0; k < 2; ++k) dst[m][k] = *(const PG8_LAS bf16x8*)(lds + PG8_SA(b, h) + aoff + m * 2048 + k * 1024); } while (0)
#define PG8_LDB(dst, b, h) do { _Pragma("unroll") for (int n = 0; n < 2; ++n) _Pragma("unroll") for (int k = 0; k < 2; ++k) dst[n][k] = *(const PG8_LAS bf16x8*)(lds + PG8_SB(b, h) + boff + n * 2048 + k * 1024); } while (0)
#define PG8_MMA(ai, bj, At, Bt) do { __builtin_amdgcn_s_setprio(1); _Pragma("unroll") for (int m = 0; m < 4; ++m) _Pragma("unroll") for (int n = 0; n < 2; ++n) _Pragma("unroll") for (int k = 0; k < 2; ++k) \
        acc[ai][bj][m][n] = __builtin_amdgcn_mfma_f32_16x16x32_bf16(Bt[n][k], At[m][k], acc[ai][bj][m][n], 0, 0, 0); __builtin_amdgcn_s_setprio(0); } while (0)
#define PG8_WAIT_V(n) asm volatile("s_waitcnt vmcnt(" #n ")" ::: "memory")
#define PG8_WAIT_L(n) asm volatile("s_waitcnt lgkmcnt(" #n ")" ::: "memory")
#define PG8_BAR __builtin_amdgcn_s_barrier()
#define PG8_SCHED __builtin_amdgcn_sched_barrier(0)
    Unit cur, nxt; int ui = 0;
    if (!S.next(0, cur)) return;
    f32x4 acc[2][2][4][2];
#pragma unroll
    for (int a = 0; a < 2; ++a)
#pragma unroll
        for (int b = 0; b < 2; ++b)
#pragma unroll
            for (int m = 0; m < 4; ++m)
#pragma unroll
                for (int n = 0; n < 2; ++n) acc[a][b][m][n] = (f32x4){0.f, 0.f, 0.f, 0.f};
    bf16x8 At[4][2], B0[2][2], B1[2][2];
    const char* cA = (const char*)g.A + (size_t)cur.pm * tstep; const char* cB = (const char*)g.Bt + (size_t)cur.pn * tstep;
    S.a_ready(cur);
    if constexpr (SP2) {
        PG8_STAGE(PG8_SB(0, 0), cB, voffB); PG8_STAGE(PG8_SB(0, 1), cB + hstep, voffB); PG8_STAGE(PG8_SA(0, 0), cA, voffA); PG8_STAGE(PG8_SA(0, 1), cA + hstep, voffA);
        if (wr == 1) PG8_BAR;
        PG8_WAIT_V(2); PG8_BAR;
        PG8_STAGE(PG8_SB(1, 0), cB + kstep, voffB); PG8_STAGE(PG8_SA(1, 0), cA + kstep, voffA); PG8_STAGE(PG8_SB(1, 1), cB + hstep + kstep, voffB);
        PG8_WAIT_V(6); PG8_BAR;
    } else {
        PG8_STAGE(PG8_SB(0, 0), cB, voffB); PG8_STAGE(PG8_SA(0, 0), cA, voffA); PG8_STAGE(PG8_SB(0, 1), cB + hstep, voffB); PG8_STAGE(PG8_SA(0, 1), cA + hstep, voffA);
        if (wr == 1) PG8_BAR;
        PG8_WAIT_V(4); PG8_BAR;
        PG8_STAGE(PG8_SB(1, 0), cB + kstep, voffB); PG8_STAGE(PG8_SA(1, 0), cA + kstep, voffA); PG8_STAGE(PG8_SB(1, 1), cB + hstep + kstep, voffB);
        PG8_WAIT_V(6); PG8_BAR;
    }
    for (;;) {
        const bool has_next = S.next(ui + 1, nxt);
        const char* nA = has_next ? (const char*)g.A + (size_t)nxt.pm * tstep : cA; const char* nB = has_next ? (const char*)g.Bt + (size_t)nxt.pn * tstep : cB;
        for (int t = 0; t < nt; t += 2) {
            const bool last = (t == nt - 2);
            const char* a1 = cA + (size_t)(t + 1) * kstep;
            const char* a2 = last ? nA : cA + (size_t)(t + 2) * kstep; const char* b2 = last ? nB : cB + (size_t)(t + 2) * kstep;
            const char* a3 = a2 + kstep; const char* b3 = b2 + kstep;
            if (last && has_next) S.a_ready(nxt);
            if constexpr (SP2) {
            PG8_LDB(B0, 0, 0); PG8_LDB(B1, 0, 1); PG8_SCHED; PG8_LDA(At, 0, 0); PG8_STAGE(PG8_SA(1, 1), a1 + hstep, voffA);
            PG8_WAIT_V(8); PG8_WAIT_L(0); PG8_BAR; PG8_MMA(0, 0, At, B0); PG8_MMA(0, 1, At, B1); PG8_BAR; PG8_SCHED;
            PG8_LDA(At, 0, 1); PG8_STAGE(PG8_SB(0, 0), b2, voffB); PG8_STAGE(PG8_SB(0, 1), b2 + hstep, voffB); PG8_STAGE(PG8_SA(0, 0), a2, voffA);
            PG8_WAIT_V(8); PG8_WAIT_L(0); PG8_BAR; PG8_MMA(1, 0, At, B0); PG8_MMA(1, 1, At, B1); PG8_BAR; PG8_SCHED;
            PG8_LDB(B0, 1, 0); PG8_LDB(B1, 1, 1); PG8_SCHED; PG8_LDA(At, 1, 0); PG8_STAGE(PG8_SA(0, 1), a2 + hstep, voffA);
            PG8_WAIT_V(8); PG8_WAIT_L(0); PG8_BAR; PG8_MMA(0, 0, At, B0); PG8_MMA(0, 1, At, B1); PG8_BAR; PG8_SCHED;
            PG8_LDA(At, 1, 1); PG8_STAGE(PG8_SB(1, 0), b3, voffB); PG8_STAGE(PG8_SB(1, 1), b3 + hstep, voffB); PG8_STAGE(PG8_SA(1, 0), a3, voffA);
            PG8_WAIT_V(8); PG8_WAIT_L(0); PG8_BAR; PG8_MMA(1, 0, At, B0); PG8_MMA(1, 1, At, B1); PG8_BAR; PG8_SCHED;
            } else {
            PG8_LDB(B0, 0, 0); PG8_SCHED; PG8_LDA(At, 0, 0); PG8_STAGE(PG8_SA(1, 1), a1 + hstep, voffA);
            PG8_WAIT_L(8); PG8_BAR; PG8_WAIT_L(0); PG8_MMA(0, 0, At, B0); PG8_BAR; PG8_SCHED;
            PG8_LDB(B1, 0, 1); PG8_STAGE(PG8_SB(0, 0), b2, voffB);
            PG8_BAR; PG8_WAIT_L(0); PG8_MMA(0, 1, At, B1); PG8_BAR;
            PG8_LDA(At, 0, 1); PG8_STAGE(PG8_SA(0, 0), a2, voffA);
            PG8_BAR; PG8_WAIT_L(0); PG8_MMA(1, 0, At, B0); PG8_BAR; PG8_SCHED;
            PG8_STAGE(PG8_SB(0, 1), b2 + hstep, voffB);
            PG8_WAIT_V(6); PG8_BAR; PG8_MMA(1, 1, At, B1); PG8_BAR;
            PG8_LDB(B0, 1, 0); PG8_SCHED; PG8_LDA(At, 1, 0); PG8_STAGE(PG8_SA(0, 1), a2 + hstep, voffA);
            PG8_WAIT_L(8); PG8_BAR; PG8_WAIT_L(0); PG8_MMA(0, 0, At, B0); PG8_BAR; PG8_SCHED;
            PG8_LDB(B1, 1, 1); PG8_STAGE(PG8_SB(1, 0), b3, voffB);
            PG8_BAR; PG8_WAIT_L(0); PG8_MMA(0, 1, At, B1); PG8_BAR;
            PG8_LDA(At, 1, 1); PG8_STAGE(PG8_SA(1, 0), a3, voffA);
            PG8_BAR; PG8_WAIT_L(0); PG8_MMA(1, 0, At, B0); PG8_BAR; PG8_SCHED;
            PG8_STAGE(PG8_SB(1, 1), b3 + hstep, voffB);
            PG8_WAIT_V(6); PG8_BAR; PG8_MMA(1, 1, At, B1); PG8_BAR;
            }
        }
        if constexpr (ALIGN_EPI) { if (wr == 0) PG8_BAR; }
        if constexpr (!Epi::AFTER_DRAIN) { E(acc, cur, wr, wc, fr, fq); S.done(cur); }
        if (!has_next) break;
#pragma unroll
        for (int a = 0; a < 2; ++a)
#pragma unroll
            for (int b = 0; b < 2; ++b)
#pragma unroll
                for (int m = 0; m < 4; ++m)
#pragma unroll
                    for (int n = 0; n < 2; ++n) acc[a][b][m][n] = (f32x4){0.f, 0.f, 0.f, 0.f};
        cur = nxt; cA = nA; cB = nB; ++ui;
        if constexpr (ALIGN_EPI) { if (wr == 1) PG8_BAR; }
    }
    PG8_WAIT_V(0);
    if constexpr (!ALIGN_EPI) { if (wr == 0) PG8_BAR; }
    PG8_BAR;
    if constexpr (Epi::AFTER_DRAIN) { E.fused(acc, cur, wr, wc, fr, fq, lds, wid, lane); S.done(cur); }
#undef PG8_SA
#undef PG8_SB
#undef PG8_STAGE
#undef PG8_LDA
#undef PG8_LDB
#undef PG8_MMA
#undef PG8_WAIT_V
#undef PG8_WAIT_L
#undef PG8_BAR
#undef PG8_SCHED
}
}
#define GAS __attribute__((address_space(1)))
#define LAS __attribute__((address_space(3)))
typedef unsigned short bf16;
typedef unsigned v4u __attribute__((ext_vector_type(4)));
typedef float f32x4 __attribute__((ext_vector_type(4)));
typedef float f32x2 __attribute__((ext_vector_type(2)));
typedef short bf16x8 __attribute__((ext_vector_type(8)));
#define LDS_WAIT() asm volatile("s_waitcnt lgkmcnt(0)" ::: "memory")

__device__ __forceinline__ unsigned f2bf(float f) { unsigned u = __builtin_bit_cast(unsigned, f); return (u + 0x7fffu + ((u >> 16) & 1u)) >> 16; }
__device__ __forceinline__ unsigned pk2(float lo, float hi) { return f2bf(lo) | (f2bf(hi) << 16); }
__device__ __forceinline__ float bf2f(unsigned short h) { return __builtin_bit_cast(float, (unsigned)h << 16); }
__device__ __forceinline__ float wave_sum(float v) {
#pragma unroll
    for (int o = 1; o < 64; o <<= 1) v += __shfl_xor(v, o);
    return v;
}
__device__ __forceinline__ float wave_max(float v) {
#pragma unroll
    for (int o = 1; o < 64; o <<= 1) v = fmaxf(v, __shfl_xor(v, o));
    return v;
}

struct Args {
    const float* in[16]; float* out; unsigned char* ws; int ph_lo, ph_hi;
};

__device__ __forceinline__ int colmap_in(int n) {
    const int t = n >> 8;
    if (t < 9) return n;
    if (t < 12) return 2310 + (n - 2304);
    if (t < 14) return 3078 + (n - 3072);
    if (t == 14) return 3590 + (n - 3584);
    if (t < 18) return 3910 + (n - 3840);
    if (t < 20) return 4678 + (n - 4608);
    if (t < 22) return 5190 + (n - 5120);
    if (t < 24) return 5702 + (n - 5632);
    if (t < 26) return 6214 + (n - 6144);
    const int j = n & 255;
    if (j < 64) return 3846 + (j >> 1) + 32 * (j & 1);
    if (j < 70) return 2304 + (j - 64);
    return -1;
}
__device__ __forceinline__ int colmap_uq(int n) {
    if (n < 768) return 192 * (n >> 7) + (n & 127);
    if (n < 1152) { const int hh = (n - 768) >> 6, p = (n - 768) & 63; return 192 * hh + 128 + (p >> 1) + 32 * (p & 1); }
    return -1;
}
__device__ __forceinline__ int colmap_ukv(int n) {
    if (n < 768) return 256 * (n >> 7) + (n & 127);
    const int c = n - 768; return 256 * (c >> 7) + 128 + (c & 127);
}
template <int MAT> __device__ __forceinline__ void tr_item(const float* W, int Norig, const float* gk, bf16* WT, int K, int k0, int n0, LAS float* scr, int lane) {
    const int nn = lane & 31; int oc;
    if (MAT == 0) oc = colmap_in(n0 + nn); else if (MAT == 1) oc = colmap_uq(n0 + nn); else if (MAT == 2) oc = colmap_ukv(n0 + nn); else oc = n0 + nn;
#pragma unroll 8
    for (int i = 0; i < 32; ++i) { const int kk = 2 * i + (lane >> 5); float v = 0.f;
        if (oc >= 0) { v = W[(size_t)(k0 + kk) * Norig + oc]; if (gk) v *= gk[k0 + kk]; }
        scr[kk * 33 + nn] = v; }
    LDS_WAIT(); asm volatile("" ::: "memory");
    const int c = lane & 7;
#pragma unroll
    for (int j = 0; j < 4; ++j) { const int n = (lane >> 3) + 8 * j; const LAS float* s = scr + (8 * c) * 33 + n;
        v4u o; o.x = pk2(s[0 * 33], s[1 * 33]); o.y = pk2(s[2 * 33], s[3 * 33]); o.z = pk2(s[4 * 33], s[5 * 33]); o.w = pk2(s[6 * 33], s[7 * 33]);
        *(v4u*)(WT + (size_t)(n0 + n) * K + k0 + 8 * c) = o; }
    LDS_WAIT(); asm volatile("" ::: "memory");
}

__device__ __forceinline__ int t5_bucket(int rel) {
    const int n = rel < 0 ? -rel : rel; int v;
    if (n < 8) v = n; else if (n < 12) v = 8; else if (n < 16) v = 9; else if (n < 23) v = 10; else if (n < 32) v = 11; else if (n < 46) v = 12; else if (n < 64) v = 13; else if (n < 91) v = 14; else v = 15;
    return (rel > 0 ? 16 : 0) + v;
}

__device__ __forceinline__ int opaque_tid() { int t = threadIdx.x; asm volatile("" : "+v"(t)); return t; }
#define C_tid (tid_o)
#define C_lane (tid_o & 63)
#define C_wave (__builtin_amdgcn_readfirstlane(tid_o >> 6))
#define C_G ((int)gridDim.x)
#define C_bid ((int)blockIdx.x)
#define WSP(T, off) ((T*)(args.ws + (off)))

__device__ __forceinline__ void p0_prologue(const Args& args, LAS unsigned char* lds) {
    const int tid_o = opaque_tid();
    LAS float* scr = (LAS float*)(lds + C_wave * 16384);
    const int gw = C_bid * NWAVES + C_wave, NGW = C_G * NWAVES;
    constexpr int I_IN = (DM / 64) * (NIN_PAD / 32), I_UQ = (512 / 64) * (NUQ_PAD / 32), I_UKV = (256 / 64) * (NUKV / 32), I_OUT = (DM / 64) * (DM / 32);
    constexpr int PER_LAYER = I_IN + I_UQ + I_UKV + I_OUT;
    for (int it = gw; it < DEPTH * PER_LAYER; it += NGW) {
        const int l = it / PER_LAYER; int r = it - l * PER_LAYER;
        if (r < I_IN) { const int nb = NIN_PAD / 32, kb = r / nb, nbk = r - kb * nb;
            tr_item<0>(args.in[2] + (size_t)l * DM * NIN, NIN, args.in[1] + l * DM, WSP(bf16, WS_WIN) + (size_t)l * NIN_PAD * DM, DM, kb * 64, nbk * 32, scr, C_lane); continue; }
        r -= I_IN;
        if (r < I_UQ) { const int nb = NUQ_PAD / 32, kb = r / nb, nbk = r - kb * nb;
            tr_item<1>(args.in[5] + (size_t)l * 512 * 1152, 1152, args.in[4] + l * 512, WSP(bf16, WS_WUQ) + (size_t)l * NUQ_PAD * 512, 512, kb * 64, nbk * 32, scr, C_lane); continue; }
        r -= I_UQ;
        if (r < I_UKV) { const int nb = NUKV / 32, kb = r / nb, nbk = r - kb * nb;
            tr_item<2>(args.in[7] + (size_t)l * 256 * 1536, 1536, args.in[6] + l * 256, WSP(bf16, WS_WUKV) + (size_t)l * NUKV * 256, 256, kb * 64, nbk * 32, scr, C_lane); continue; }
        r -= I_UKV;
        { const int nb = DM / 32, kb = r / nb, nbk = r - kb * nb;
            tr_item<3>(args.in[14] + (size_t)l * DM * DM, DM, nullptr, WSP(bf16, WS_WOUT) + (size_t)l * DM * DM, DM, kb * 64, nbk * 32, scr, C_lane); }
    }
    for (int m = gw; m < M; m += NGW) {
        const f32x4* xr = (const f32x4*)(args.in[0] + (size_t)m * DM) + C_lane; float s = 0.f;
        unsigned long long* o8 = (unsigned long long*)(WSP(bf16, WS_XB) + (size_t)m * DM) + C_lane;
#pragma unroll
        for (int j = 0; j < 8; ++j) { const f32x4 v = xr[64 * j]; s += (v[0] * v[0] + v[1] * v[1]) + (v[2] * v[2] + v[3] * v[3]);
            o8[64 * j] = (unsigned long long)pk2(v[0], v[1]) | ((unsigned long long)pk2(v[2], v[3]) << 32); }
        s = wave_sum(s);
        if (C_lane < 32) WSP(float, WS_XSS)[(size_t)m * 32 + C_lane] = C_lane == 0 ? s : 0.f;
    }
    for (int e = C_bid * NTHREADS + C_tid; e < SEQ * 32; e += C_G * NTHREADS) {
        const int s = e >> 5, i = e & 31; const float inv = powf(10000.0f, -(float)i / 32.0f); const float ang = (float)s * inv;
        WSP(float, WS_ROPE)[e] = cosf(ang); WSP(float, WS_ROPE + SEQ * 32 * 4)[e] = sinf(ang);
    }
}

__device__ __forceinline__ void p2_scan(const Args& args) {
    const int tid_o = opaque_tid();
    if (C_bid >= NB * 6 || C_wave != 0) return;
    const int b = C_bid / 6, h = C_bid % 6, lane = C_lane;
    const float* src = WSP(float, WS_LOGF) + ((size_t)b * SEQ + 64 * lane) * 8 + h;
    float tot = 0.f;
#pragma unroll 8
    for (int j = 0; j < 64; ++j) tot += src[j * 8];
    float incl = tot;
#pragma unroll
    for (int o = 1; o < 64; o <<= 1) { const float y = __shfl_up(incl, o); if (lane >= o) incl += y; }
    float run = incl - tot;
    float* dst = WSP(float, WS_CUMT) + (size_t)C_bid * SEQ + 64 * lane;
#pragma unroll 8
    for (int j = 0; j < 64; ++j) { run += src[j * 8]; dst[j] = run; }
}

template <int DQK> __device__ __forceinline__ float dot_row(const bf16* kp, const LAS float* qs) {
    float s = 0.f;
#pragma unroll
    for (int c = 0; c < DQK / 8; ++c) { const v4u kv = *(const v4u*)(kp + c * 8);
        const f32x4 q0 = *(const LAS f32x4*)(qs + c * 8), q1 = *(const LAS f32x4*)(qs + c * 8 + 4);
        s += bf2f(kv.x & 0xffff) * q0[0] + bf2f(kv.x >> 16) * q0[1] + bf2f(kv.y & 0xffff) * q0[2] + bf2f(kv.y >> 16) * q0[3]
           + bf2f(kv.z & 0xffff) * q1[0] + bf2f(kv.z >> 16) * q1[1] + bf2f(kv.w & 0xffff) * q1[2] + bf2f(kv.w >> 16) * q1[3]; }
    return s;
}
template <int VAR, int DQK>
__device__ __forceinline__ void naive_map(const LAS float* qs, const bf16* Kbase, int kpitch, const bf16* Vbase, int vpitch, int nkeys, int t, const float* cum, float cumt,
                                          const float* relb, int h, int lane, float& o0, float& o1, float& l) {
    float m = -1e30f; l = 0.f; o0 = 0.f; o1 = 0.f;
    for (int k0 = 0; k0 < nkeys; k0 += 64) {
        const int key = k0 + lane;
        float s = dot_row<DQK>(Kbase + (size_t)key * kpitch, qs);
        if (VAR == 0) { s += cumt - cum[key]; if (key > t) s = -INFINITY; }
        if (VAR == 2) s += relb[t5_bucket(key - t) * 4 + h];
        const float tmax = wave_max(s), mn = fmaxf(m, tmax), alpha = __expf(m - mn), p = __expf(s - mn);
        l = l * alpha + wave_sum(p); o0 *= alpha; o1 *= alpha; m = mn;
        const bf16* vp = Vbase + (size_t)k0 * vpitch + 2 * lane;
#pragma unroll 8
        for (int kk = 0; kk < 64; ++kk) { const float pk = __shfl(p, kk); const unsigned vv = *(const unsigned*)(vp + (size_t)kk * vpitch);
            o0 += pk * bf2f(vv & 0xffff); o1 += pk * bf2f(vv >> 16); }
    }
}
__device__ __forceinline__ void p3_naive(const Args& args, int layer, LAS unsigned char* lds) {
    const int tid_o = opaque_tid();
    LAS float* qs = (LAS float*)(lds + C_wave * 1024);
    const int gw = C_bid * NWAVES + C_wave, NGW = C_G * NWAVES, lane = C_lane;
    const float lam_init = 0.8f - 0.6f * expf(-0.3f * (float)layer);
    const float d1 = wave_sum(args.in[8][layer * 64 + lane] * args.in[9][layer * 64 + lane]), d2 = wave_sum(args.in[10][layer * 64 + lane] * args.in[11][layer * 64 + lane]);
    const float lam = expf(d1) - expf(d2) + lam_init;
    for (int u = gw; u < M * 16; u += NGW) {
        const int row = u >> 4, hh = u & 15, b = row >> 12, t = row & 4095; const size_t rb = (size_t)b * SEQ;
        float o0, o1, l;
        if (hh < 6) {
            const int h = hh; const bf16* q = WSP(bf16, WS_AQ) + (size_t)row * 768 + 128 * h;
            qs[lane] = bf2f(q[lane]) * 0.08838834764831845f; qs[lane + 64] = bf2f(q[lane + 64]) * 0.08838834764831845f; LDS_WAIT();
            const float* cum = WSP(float, WS_CUMT) + (size_t)(b * 6 + h) * SEQ;
            naive_map<0, 128>(qs, WSP(bf16, WS_AK) + rb * 768 + 128 * h, 768, WSP(bf16, WS_AV) + rb * 768 + 128 * h, 768, t + 1, t, cum, cum[t], nullptr, h, lane, o0, o1, l);
            bf16* g = WSP(bf16, WS_G) + (size_t)row * 2048 + 128 * h + 2 * lane; const unsigned gv = *(const unsigned*)g; const float il = 1.0f / l;
            *(unsigned*)g = pk2(o0 * il * bf2f(gv & 0xffff), o1 * il * bf2f(gv >> 16));
        } else if (hh < 12) {
            const int h = hh - 6; const bf16* q = WSP(bf16, WS_QB) + (size_t)row * 1152 + 192 * h; const float sc = 0.07216878364870322f;
            qs[lane] = bf2f(q[lane]) * sc; qs[lane + 64] = bf2f(q[lane + 64]) * sc; qs[lane + 128] = bf2f(q[lane + 128]) * sc; LDS_WAIT();
            naive_map<1, 192>(qs, WSP(bf16, WS_KB) + rb * 1152 + 192 * h, 1152, WSP(bf16, WS_VB) + rb * 768 + 128 * h, 768, 64 * (t / 64 + 1), t, nullptr, 0.f, nullptr, h, lane, o0, o1, l);
            bf16* g = WSP(bf16, WS_G) + (size_t)row * 2048 + 768 + 128 * h + 2 * lane; const unsigned gv = *(const unsigned*)g; const float il = 1.0f / l;
            *(unsigned*)g = pk2(o0 * il * bf2f(gv & 0xffff), o1 * il * bf2f(gv >> 16));
        } else {
            const int h = hh - 12; const bf16* q = WSP(bf16, WS_CQ2) + (size_t)row * 512 + 128 * h;
            qs[lane] = bf2f(q[lane]) * 0.125f; qs[lane + 64] = bf2f(q[lane + 64]) * 0.125f; LDS_WAIT();
            float p0, p1, pl;
            naive_map<2, 64>(qs, WSP(bf16, WS_CK2) + rb * 512 + 128 * h, 512, WSP(bf16, WS_CV) + rb * 512 + 128 * h, 512, 64 * (t / 64 + 1), t, nullptr, 0.f, args.in[13], h, lane, o0, o1, l);
            naive_map<2, 64>(qs + 64, WSP(bf16, WS_CK2) + rb * 512 + 128 * h + 64, 512, WSP(bf16, WS_CV) + rb * 512 + 128 * h, 512, 64 * (t / 64 + 1), t, nullptr, 0.f, args.in[13], h, lane, p0, p1, pl);
            const float il1 = 1.0f / l, il2 = lam / pl; const float c0 = o0 * il1 - p0 * il2, c1 = o1 * il1 - p1 * il2;
            const float ss = wave_sum(c0 * c0 + c1 * c1); const float r = rsqrtf(ss * (1.0f / 128.0f) + EPS) * (1.0f - lam_init);
            const float* sg = args.in[12] + layer * 128 + 2 * lane;
            bf16* g = WSP(bf16, WS_G) + (size_t)row * 2048 + 1536 + 128 * h + 2 * lane; const unsigned gv = *(const unsigned*)g;
            *(unsigned*)g = pk2(c0 * r * sg[0] * bf2f(gv & 0xffff), c1 * r * sg[1] * bf2f(gv >> 16));
        }
        LDS_WAIT();
    }
}


namespace att {
typedef short s16x4 __attribute__((ext_vector_type(4)));
typedef float f32x16 __attribute__((ext_vector_type(16)));
typedef unsigned u32x4 __attribute__((ext_vector_type(4)));
constexpr int KVBLK = 64, SHM_V = 16384, SHM_K = 16384, SHM_KR = 8192;
constexpr int L_V = 0, L_K = 32768, L_KR = 65536, L_WS = 81920, L_KB = 83968, L_T5 = 84480, L_QR = 86016, L_FLAG = 118784, L_CMB = 0;
#define KSWZ(row, colB) ((row) * 256 + ((colB) ^ (((row) & 7) << 4)))
#define SBAR() __builtin_amdgcn_sched_barrier(0)
__device__ __forceinline__ int v_st(int k, int c) { const int kk = (k & ~0xC) | ((k & 4) << 1) | ((k & 8) >> 1); return ((kk >> 3) * 4 + (c >> 5)) * 512 + ((kk & 7) * 32 + (c & 31)) * 2; }
__device__ __forceinline__ int v_rd_base(int lane) { return ((lane & 3) << 3) | (((lane >> 2) & 3) << 6) | (((lane >> 4) & 1) << 5) | (((lane >> 5) & 1) << 8); }
constexpr int v_rd_off(int d0, int ks, int half) { return d0 * 512 + ks * 4096 + half * 2048; }
__device__ __forceinline__ int crow(int r, int hi) { return (r & 3) + 8 * (r >> 2) + 4 * hi; }
__device__ __forceinline__ unsigned cvtpk(float lo, float hi) { unsigned r; asm volatile("v_cvt_pk_bf16_f32 %0, %1, %2" : "=v"(r) : "v"(lo), "v"(hi)); return r; }

template <int VAR> struct VT;
template <> struct VT<0> { static constexpr float SCALE = 0.08838834764831845f; static constexpr int PQ = 768, PK = 768, PV = 768, NQ = 8, QROWS = 256; };
template <> struct VT<1> { static constexpr float SCALE = 0.07216878364870322f; static constexpr int PQ = 1152, PK = 1152, PV = 768, NQ = 8, QROWS = 256; };
template <> struct VT<2> { static constexpr float SCALE = 0.125f; static constexpr int PQ = 512, PK = 512, PV = 512, NQ = 4, QROWS = 128; };

__device__ __forceinline__ void mask_causal(f32x16& p0, f32x16& p1, int dq) {
    const float NEG = -__builtin_inff();
#pragma unroll
    for (int r = 0; r < 16; ++r) { const int c = (r & 3) + 8 * (r >> 2); if (dq - c < 0) p0[r] = NEG; if (dq - c - 32 < 0) p1[r] = NEG; }
}
template <int VAR>
__device__ __forceinline__ void partialSM(f32x16& p0, f32x16& p1, float& m_reg, float& mn, float& alpha) {
    constexpr float SCALE = VT<VAR>::SCALE, C2 = 1.4426950408889634f * SCALE, THR = 8.f;
    float pmax = p0[0];
#pragma unroll
    for (int r = 1; r < 16; ++r) pmax = fmaxf(pmax, p0[r]);
#pragma unroll
    for (int r = 0; r < 16; ++r) pmax = fmaxf(pmax, p1[r]);
    { auto rr = __builtin_amdgcn_permlane32_swap(__float_as_uint(pmax), __float_as_uint(pmax), false, false);
      pmax = fmaxf(__uint_as_float(rr[0]), __uint_as_float(rr[1])); }
    if (__builtin_expect(__all((pmax - m_reg) * SCALE <= THR), 1)) { mn = m_reg; alpha = 1.f; }
    else { mn = fmaxf(m_reg, pmax); alpha = __builtin_amdgcn_exp2f((m_reg - mn) * C2); m_reg = mn; }
    const float mnL = -mn * C2;
#pragma unroll
    for (int r = 0; r < 16; ++r) p0[r] = fmaf(p0[r], C2, mnL);
#pragma unroll
    for (int r = 0; r < 16; ++r) p1[r] = fmaf(p1[r], C2, mnL);
#pragma unroll
    for (int r = 0; r < 16; ++r) p0[r] = __builtin_amdgcn_exp2f(p0[r]);
}
__device__ __forceinline__ void finishSM(f32x16& p0, f32x16& p1, float alpha, float& l_reg, bf16x8& pa0, bf16x8& pa1, bf16x8& pa2, bf16x8& pa3) {
#pragma unroll
    for (int r = 0; r < 16; ++r) p1[r] = __builtin_amdgcn_exp2f(p1[r]);
    float ps = 0;
#pragma unroll
    for (int r = 0; r < 16; ++r) ps += p0[r];
#pragma unroll
    for (int r = 0; r < 16; ++r) ps += p1[r];
    { auto rr = __builtin_amdgcn_permlane32_swap(__float_as_uint(ps), __float_as_uint(ps), false, false);
      ps = __uint_as_float(rr[0]) + __uint_as_float(rr[1]); }
    l_reg = l_reg * alpha + ps;
#define PK4(P, B_, OUT) do { unsigned a0 = cvtpk(P[B_+0], P[B_+1]), a1 = cvtpk(P[B_+2], P[B_+3]);                          \
        unsigned b0 = cvtpk(P[B_+4], P[B_+5]), b1 = cvtpk(P[B_+6], P[B_+7]);                                             \
        auto r0 = __builtin_amdgcn_permlane32_swap(a0, b0, false, false); auto r1 = __builtin_amdgcn_permlane32_swap(a1, b1, false, false); \
        u32x4 w = {r0[0], r1[0], r0[1], r1[1]}; OUT = *reinterpret_cast<bf16x8*>(&w); } while (0)
    PK4(p0, 0, pa0); PK4(p0, 8, pa1); PK4(p1, 0, pa2); PK4(p1, 8, pa3);
#undef PK4
}
template <int VAR, int KB>
__device__ __forceinline__ void qkt(f32x16& p0, f32x16& p1, const LAS unsigned char* lds, int r32, int hi, int lane, int wid, int map, const bf16x8* qr) {
    if (VAR == 0) {
        const LAS float* kb = (const LAS float*)(lds + L_KB) + KB * 64 + 4 * hi;
#pragma unroll
        for (int g = 0; g < 4; ++g) { const f32x4 a = *(const LAS f32x4*)(kb + 8 * g), b = *(const LAS f32x4*)(kb + 32 + 8 * g);
            p0[4 * g] = a[0]; p0[4 * g + 1] = a[1]; p0[4 * g + 2] = a[2]; p0[4 * g + 3] = a[3]; p1[4 * g] = b[0]; p1[4 * g + 1] = b[1]; p1[4 * g + 2] = b[2]; p1[4 * g + 3] = b[3]; }
    } else { p0 = f32x16{}; p1 = f32x16{}; }
    const LAS unsigned char* kbp[4];
#pragma unroll
    for (int dd = 0; dd < 4; ++dd) kbp[dd] = lds + L_K + KB * SHM_K + KSWZ(r32, (dd * 16 + hi * 8) * 2) + (VAR == 2 ? map * 128 : 0);
#pragma unroll
    for (int d0 = 0; d0 < VT<VAR>::NQ; ++d0) { const LAS unsigned char* a = kbp[d0 & 3] + (d0 >> 2) * 128;
        const bf16x8 b0 = *(const LAS bf16x8*)a, b1 = *(const LAS bf16x8*)(a + 32 * 256);
        p0 = __builtin_amdgcn_mfma_f32_32x32x16_bf16(b0, qr[d0], p0, 0, 0, 0);
        p1 = __builtin_amdgcn_mfma_f32_32x32x16_bf16(b1, qr[d0], p1, 0, 0, 0); }
    if (VAR == 1) {
        const int s = (r32 >> 1) & 7;
#pragma unroll
        for (int d0 = 0; d0 < 4; ++d0) { const LAS unsigned char* a = lds + L_KR + KB * SHM_KR + r32 * 128 + (((2 * d0 + hi) ^ s) << 4);
            const bf16x8 b0 = *(const LAS bf16x8*)a, b1 = *(const LAS bf16x8*)(a + 32 * 128);
            const bf16x8 q = *(const LAS bf16x8*)(lds + L_QR + wid * 4096 + d0 * 1024 + lane * 16);
            p0 = __builtin_amdgcn_mfma_f32_32x32x16_bf16(b0, q, p0, 0, 0, 0);
            p1 = __builtin_amdgcn_mfma_f32_32x32x16_bf16(b1, q, p1, 0, 0, 0); }
    }
}
template <int VB>
__device__ __forceinline__ void pv_tile(f32x16* o, int vb0, bf16x8 pa0, bf16x8 pa1, bf16x8 pa2, bf16x8 pa3) {
#define TRRD(dst, off) asm volatile("ds_read_b64_tr_b16 %0, %1 offset:%2" : "=&v"(dst) : "v"(vb0), "i"(off) : "memory")
#define PV_D0(d0) do { s16x4 l0, l1, l2, l3, h0, h1, h2, h3; constexpr int b_ = VB * SHM_V + v_rd_off(d0, 0, 0); \
        TRRD(l0, b_); TRRD(h0, b_ + 2048); TRRD(l1, b_ + 4096); TRRD(h1, b_ + 6144); TRRD(l2, b_ + 8192); TRRD(h2, b_ + 10240); TRRD(l3, b_ + 12288); TRRD(h3, b_ + 14336); \
        asm volatile("s_waitcnt lgkmcnt(0)" ::: "memory"); SBAR();   \
        o[d0] = __builtin_amdgcn_mfma_f32_32x32x16_bf16(pa0, (bf16x8){l0[0], l0[1], l0[2], l0[3], h0[0], h0[1], h0[2], h0[3]}, o[d0], 0, 0, 0);   \
        o[d0] = __builtin_amdgcn_mfma_f32_32x32x16_bf16(pa1, (bf16x8){l1[0], l1[1], l1[2], l1[3], h1[0], h1[1], h1[2], h1[3]}, o[d0], 0, 0, 0);   \
        o[d0] = __builtin_amdgcn_mfma_f32_32x32x16_bf16(pa2, (bf16x8){l2[0], l2[1], l2[2], l2[3], h2[0], h2[1], h2[2], h2[3]}, o[d0], 0, 0, 0);   \
        o[d0] = __builtin_amdgcn_mfma_f32_32x32x16_bf16(pa3, (bf16x8){l3[0], l3[1], l3[2], l3[3], h3[0], h3[1], h3[2], h3[3]}, o[d0], 0, 0, 0); } while (0)
    PV_D0(0); PV_D0(1); PV_D0(2); PV_D0(3);
#undef PV_D0
#undef TRRD
}

template <int VAR>
__device__ __forceinline__ void attn_unit(unsigned char* ws, const float* relb, const float* subg, float lam, float lam1m, int b, int h, int qb, LAS unsigned char* lds) {
    typedef VT<VAR> T; constexpr float SCALE = T::SCALE;
    int tid_ = threadIdx.x; asm volatile("" : "+v"(tid_));
    const int tid = tid_, wid = __builtin_amdgcn_readfirstlane(tid >> 6), lane = tid & 63, r32 = lane & 31, hi = lane >> 5;
    const int wq = VAR == 2 ? (wid & 3) : wid, map = VAR == 2 ? (wid >> 2) : 0;
    const int P0 = qb * T::QROWS, qlo = P0 + wq * 32, NT = (P0 + T::QROWS) / KVBLK;
    const size_t rowb = (size_t)b * SEQ;
    const bf16* Qp; const bf16* Kp; const bf16* Vp; int gcol;
    if (VAR == 0) { Qp = (const bf16*)(ws + WS_AQ) + (rowb + qlo + r32) * 768 + 128 * h; Kp = (const bf16*)(ws + WS_AK) + rowb * 768 + 128 * h; Vp = (const bf16*)(ws + WS_AV) + rowb * 768 + 128 * h; gcol = 128 * h; }
    else if (VAR == 1) { Qp = (const bf16*)(ws + WS_QB) + (rowb + qlo + r32) * 1152 + 192 * h; Kp = (const bf16*)(ws + WS_KB) + rowb * 1152 + 192 * h; Vp = (const bf16*)(ws + WS_VB) + rowb * 768 + 128 * h; gcol = 768 + 128 * h; }
    else { Qp = (const bf16*)(ws + WS_CQ2) + (rowb + qlo + r32) * 512 + 128 * h + 64 * map; Kp = (const bf16*)(ws + WS_CK2) + rowb * 512 + 128 * h; Vp = (const bf16*)(ws + WS_CV) + rowb * 512 + 128 * h; gcol = 1536 + 128 * h; }
    const float* cum = (const float*)(ws + WS_CUMT) + (size_t)(b * 6 + h) * SEQ;
    LAS unsigned char* V_lds = lds + L_V; LAS unsigned char* K_lds = lds + L_K;
    LAS float* wsf = (LAS float*)(lds + L_WS) + wid * 64; LAS float* li_l = wsf; LAS float* al_l = wsf + 32;
    float m_reg = -1e30f, l_reg = 0; f32x16 o[4] = {};
    const int sr = tid >> 4, sc = (tid & 15) * 8, vst0 = v_st(sr, sc), vst1 = v_st(32 + sr, sc), kws = KSWZ(sr, sc * 2);
    const int krr = tid >> 3, krc = tid & 7, krw = krr * 128 + ((krc ^ ((krr >> 1) & 7)) << 4);
    const int vb0 = (int)(uintptr_t)V_lds + v_rd_base(lane);
    bf16x8 qr[T::NQ];
#pragma unroll
    for (int d0 = 0; d0 < T::NQ; ++d0) qr[d0] = *(const bf16x8*)(Qp + d0 * 16 + hi * 8);
    if (VAR == 1) {
#pragma unroll
        for (int d0 = 0; d0 < 4; ++d0) *(LAS bf16x8*)(lds + L_QR + wid * 4096 + d0 * 1024 + lane * 16) = *(const bf16x8*)(Qp + 128 + d0 * 16 + hi * 8);
    }
    if (VAR == 2) { if (tid < 320) { const int rel = tid - 255; ((LAS float*)(lds + L_T5))[tid] = relb[t5_bucket(rel) * 4 + h] * (1.0f / SCALE); } }
    bf16x8 st_v0, st_v1, st_k0, st_k1, st_kr; float st_kb = 0.f;
#define ROWP(p, pitch, k0, rr) ((p) + (size_t)((k0) + (rr)) * (pitch) + sc)
#define VMW() asm volatile("s_waitcnt vmcnt(0)" ::: "memory")
#define SLOAD(k0) do { st_v0 = *(const bf16x8*)ROWP(Vp, T::PV, k0, sr); st_v1 = *(const bf16x8*)ROWP(Vp, T::PV, k0, 32 + sr);              \
                       st_k0 = *(const bf16x8*)ROWP(Kp, T::PK, k0, sr); st_k1 = *(const bf16x8*)ROWP(Kp, T::PK, k0, 32 + sr);              \
                       if (VAR == 1) st_kr = *(const bf16x8*)(Kp + (size_t)((k0) + krr) * 1152 + 128 + krc * 8);                            \
                       if (VAR == 0) { if (tid < 64) st_kb = cum[(k0) + tid]; } } while (0)
#define SWRITE(bf) do { *(LAS bf16x8*)(V_lds + (bf) * SHM_V + vst0) = st_v0; *(LAS bf16x8*)(V_lds + (bf) * SHM_V + vst1) = st_v1;         \
                        *(LAS bf16x8*)(K_lds + (bf) * SHM_K + kws) = st_k0; *(LAS bf16x8*)(K_lds + (bf) * SHM_K + kws + 32 * 256) = st_k1; \
                        if (VAR == 1) *(LAS bf16x8*)(lds + L_KR + (bf) * SHM_KR + krw) = st_kr;                                             \
                        if (VAR == 0) { if (tid < 64) ((LAS float*)(lds + L_KB))[(bf) * 64 + tid] = -st_kb * (1.0f / SCALE); } } while (0)
#define RESC(a) do { if (__any((a) < 1.f)) { if (hi == 0) al_l[r32] = (a); asm volatile("s_waitcnt lgkmcnt(0)" ::: "memory");              \
                     _Pragma("unroll") for (int d_ = 0; d_ < 4; ++d_) _Pragma("unroll") for (int r = 0; r < 16; ++r) o[d_][r] *= al_l[crow(r, hi)]; } } while (0)
#define KBASE(t) ((t) * KVBLK)
    const int qm = qlo + r32 - 4 * hi;
    const int t5b = (-qlo - r32 + 4 * hi + 255) * 4;
    const float b15 = VAR == 2 ? relb[15 * 4 + h] * (1.0f / SCALE) : 0.f;
#define MODIFY(P0_, P1_, t) do { const int kb_ = KBASE(t);                                                                               \
        if (VAR == 0) { if (kb_ + KVBLK - 1 > qlo) mask_causal(P0_, P1_, qm - kb_); }                                                   \
        else { if (kb_ > (qlo & ~63)) { _Pragma("unroll") for (int r = 0; r < 16; ++r) { P0_[r] = -__builtin_inff(); P1_[r] = -__builtin_inff(); } }   \
               else if (VAR == 2) { if (kb_ + 63 - qlo > -91) { const LAS unsigned char* tp = lds + L_T5 + t5b + kb_ * 4;                               \
                       _Pragma("unroll") for (int r = 0; r < 16; ++r) { const int c = (r & 3) + 8 * (r >> 2); P0_[r] += *(const LAS float*)(tp + c * 4); P1_[r] += *(const LAS float*)(tp + (c + 32) * 4); } } \
                   else { _Pragma("unroll") for (int r = 0; r < 16; ++r) { P0_[r] += b15; P1_[r] += b15; } } } } } while (0)
    f32x16 pA0, pA1, pB0, pB1; float mnA, mnB, alA, alB; bf16x8 pa0, pa1, pa2, pa3;
    SLOAD(0); VMW(); SWRITE(0);
    __syncthreads();
    SLOAD(KBASE(1));
    SBAR(); qkt<VAR, 0>(pA0, pA1, lds, r32, hi, lane, wid, map, qr);
    MODIFY(pA0, pA1, 0); partialSM<VAR>(pA0, pA1, m_reg, mnA, alA);
    VMW(); SWRITE(1);
    __syncthreads();
#define HALF_STEP(PX0, PX1, mnX, alX, PY0, PY1, alY, t, KB, VB, SB) do {                                                      \
        SBAR(); qkt<VAR, KB>(PX0, PX1, lds, r32, hi, lane, wid, map, qr);                                                     \
        finishSM(PY0, PY1, alY, l_reg, pa0, pa1, pa2, pa3); SBAR();                                                           \
        SLOAD(KBASE((t) + 1)); SBAR();                                                                                        \
        pv_tile<VB>(o, vb0, pa0, pa1, pa2, pa3); MODIFY(PX0, PX1, (t)); partialSM<VAR>(PX0, PX1, m_reg, mnX, alX);            \
        __syncthreads();                                                                                                      \
        VMW(); SWRITE(SB);                                                                                                    \
        RESC(alX); __syncthreads(); } while (0)
    for (int t = 1; t + 1 < NT; t += 2) {
        HALF_STEP(pB0, pB1, mnB, alB, pA0, pA1, alA, t, 1, 0, 0);
        HALF_STEP(pA0, pA1, mnA, alA, pB0, pB1, alB, t + 1, 0, 1, 1);
    }
    SBAR(); qkt<VAR, 1>(pB0, pB1, lds, r32, hi, lane, wid, map, qr); SBAR();
    finishSM(pA0, pA1, alA, l_reg, pa0, pa1, pa2, pa3); SBAR();
    pv_tile<0>(o, vb0, pa0, pa1, pa2, pa3);
    MODIFY(pB0, pB1, NT - 1); partialSM<VAR>(pB0, pB1, m_reg, mnB, alB); __syncthreads(); RESC(alB);
    finishSM(pB0, pB1, alB, l_reg, pa0, pa1, pa2, pa3); SBAR(); pv_tile<1>(o, vb0, pa0, pa1, pa2, pa3);
    if (hi == 0) li_l[r32] = l_reg; asm volatile("s_waitcnt lgkmcnt(0)" ::: "memory");
    float rli[16];
#pragma unroll
    for (int r = 0; r < 16; ++r) rli[r] = __builtin_amdgcn_rcpf(li_l[crow(r, hi)]);
    bf16* Gw = (bf16*)(ws + WS_G) + (rowb + qlo) * 2048 + gcol;
    if (VAR != 2) {
#pragma unroll
        for (int r = 0; r < 16; ++r) { const int orow = crow(r, hi);
#pragma unroll
            for (int d0 = 0; d0 < 4; ++d0) { const float v = o[d0][r] * rli[r]; const float vn = __shfl_xor(v, 1);
                if ((r32 & 1) == 0) { unsigned* gp = (unsigned*)(Gw + (size_t)orow * 2048 + d0 * 32 + r32); const unsigned gv = *gp;
                    *gp = cvtpk(v * bf2f(gv & 0xffff), vn * bf2f(gv >> 16)); } } }
        __syncthreads();
    } else {
        LAS float* cmb = (LAS float*)(lds + L_CMB) + wq * 4096;
        __syncthreads();
        if (map == 1) {
#pragma unroll
            for (int r = 0; r < 16; ++r) { const int orow = crow(r, hi); const float f = rli[r] * lam;
#pragma unroll
                for (int d0 = 0; d0 < 4; ++d0) cmb[orow * 128 + d0 * 32 + r32] = o[d0][r] * f; }
        }
        __syncthreads();
        if (map == 0) {
            float sg[4];
#pragma unroll
            for (int d0 = 0; d0 < 4; ++d0) sg[d0] = subg[d0 * 32 + r32];
#pragma unroll
            for (int r = 0; r < 16; ++r) { const int orow = crow(r, hi); float c[4]; float s = 0.f;
#pragma unroll
                for (int d0 = 0; d0 < 4; ++d0) { c[d0] = o[d0][r] * rli[r] - cmb[orow * 128 + d0 * 32 + r32]; s += c[d0] * c[d0]; }
#pragma unroll
                for (int x = 1; x < 32; x <<= 1) s += __shfl_xor(s, x);
                const float rn = rsqrtf(s * (1.0f / 128.0f) + EPS) * lam1m;
#pragma unroll
                for (int d0 = 0; d0 < 4; ++d0) { const float v = c[d0] * rn * sg[d0]; const float vn = __shfl_xor(v, 1);
                    if ((r32 & 1) == 0) { unsigned* gp = (unsigned*)(Gw + (size_t)orow * 2048 + d0 * 32 + r32); const unsigned gv = *gp;
                        *gp = cvtpk(v * bf2f(gv & 0xffff), vn * bf2f(gv >> 16)); } } }
        }
        __syncthreads();
    }
#undef ROWP
#undef VMW
#undef SLOAD
#undef SWRITE
#undef RESC
#undef KBASE
#undef MODIFY
#undef HALF_STEP
}

struct OrderTab { unsigned short v[1280]; };
constexpr OrderTab make_order() {
    OrderTab t{}; int n = 0;
    for (int c = 320; c >= 1; --c) {
        if (c % 20 == 0 && c / 20 <= 16) { const int qb = c / 20 - 1; for (int bh = 0; bh < 24; ++bh) t.v[n++] = (unsigned short)(1 | (qb << 2) | (bh << 7)); }
        if (c % 16 == 0 && c / 16 <= 16) { const int qb = c / 16 - 1; for (int bh = 0; bh < 24; ++bh) t.v[n++] = (unsigned short)(0 | (qb << 2) | (bh << 7)); }
        if (c % 7 == 0 && c / 7 <= 32) { const int qb = c / 7 - 1; for (int bh = 0; bh < 16; ++bh) t.v[n++] = (unsigned short)(2 | (qb << 2) | (bh << 7)); }
    }
    return t;
}
__device__ const OrderTab g_order = make_order();
static_assert(make_order().v[1279] != 0 || true, "order table");
}

__device__ __forceinline__ void p3_attention(const Args& args, int layer, LAS unsigned char* lds) {
    const int tid_o = opaque_tid(); const int lane = tid_o & 63;
    const float lam_init = 0.8f - 0.6f * expf(-0.3f * (float)layer);
    const float d1 = wave_sum(args.in[8][layer * 64 + lane] * args.in[9][layer * 64 + lane]), d2 = wave_sum(args.in[10][layer * 64 + lane] * args.in[11][layer * 64 + lane]);
    const float lam = expf(d1) - expf(d2) + lam_init;
    unsigned* ctr = (unsigned*)(args.ws + WS_CTL) + 64 * (1 + layer);
    volatile LAS unsigned* flag = (volatile LAS unsigned*)(lds + att::L_FLAG);
    for (;;) {
        if (tid_o == 0) flag[0] = atomicAdd(ctr, 1u);
        __syncthreads();
        const unsigned idx = flag[0];
        if (idx >= 1280u) break;
        const unsigned code = att::g_order.v[idx]; const int type = code & 3, qb = (code >> 2) & 31, bh = code >> 7;
        if (type == 0) att::attn_unit<0>(args.ws, args.in[13], args.in[12] + layer * 128, lam, 1.0f - lam_init, bh / 6, bh % 6, qb, lds);
        else if (type == 1) att::attn_unit<1>(args.ws, args.in[13], args.in[12] + layer * 128, lam, 1.0f - lam_init, bh / 6, bh % 6, qb, lds);
        else att::attn_unit<2>(args.ws, args.in[13], args.in[12] + layer * 128, lam, 1.0f - lam_init, bh >> 2, bh & 3, qb, lds);
    }
    __syncthreads();
}

__device__ __forceinline__ void p5_final(const Args& args) {
    const int tid_o = opaque_tid();
    const int gw = C_bid * NWAVES + C_wave, NGW = C_G * NWAVES, lane = C_lane;
    for (int m = gw; m < M; m += NGW) {
        float s = lane < 32 ? WSP(float, WS_XSS)[(size_t)m * 32 + lane] : 0.f; s = wave_sum(s);
        const float r = rsqrtf(s * (1.0f / 2048.0f) + EPS);
        f32x4* xr = (f32x4*)(args.out + (size_t)m * DM) + lane; const f32x4* gr = (const f32x4*)args.in[15] + lane;
#pragma unroll
        for (int j = 0; j < 8; ++j) { const f32x4 v = xr[64 * j], g = gr[64 * j]; xr[64 * j] = v * r * g; }
    }
}

#ifndef MK_NAIVE_ATTN
#define MK_NAIVE_ATTN 0
#endif
#ifndef MK_FUSED
#define MK_FUSED 1
#endif
constexpr int N_PHASES = 10;

__global__ void __launch_bounds__(NTHREADS, 2) fwd_kernel(Args args) {
    extern __shared__ __attribute__((aligned(16))) unsigned char lds_raw[];
    LAS unsigned char* lds = (LAS unsigned char*)lds_raw;
    const int lo = args.ph_lo, hi = args.ph_hi;
#ifndef PH_MASK
#define PH_MASK 0x3ff
#endif
#define IN(k) (((PH_MASK >> ((k) > 4 ? (k) - 4 : (k))) & 1) && lo <= (k) && (k) < hi)
#if MK_FUSED
#define SEAM(k) do { if (IN(k) && IN((k) + 1)) { cg::this_grid().sync(); } } while (0)
#else
#define SEAM(k) do { } while (0)
#endif
    if (IN(0)) { p0_prologue(args, lds); __syncthreads(); }
    SEAM(0);
#pragma unroll 1
    for (int l = 0; l < DEPTH; ++l) {
        const int pb = 1 + 4 * l;
        if (IN(pb)) {
            pg8::Gemm g{WSP(bf16, WS_XB), WSP(bf16, WS_WIN) + (size_t)l * NIN_PAD * DM, M, NIN_PAD, DM}; pg8::StaticOrder S; S.init(M, NIN_PAD, C_G, C_bid);
            pg8::EpiIn E{args.ws, args.in[3] + l * 6};
            pg8::gemm_phase<pg8::EpiIn, pg8::StaticOrder, true, true>(lds, g, S, E);
        }
        SEAM(pb);
        if (IN(pb + 1)) {
            p2_scan(args);
            { pg8::Gemm g{WSP(bf16, WS_CQ), WSP(bf16, WS_WUQ) + (size_t)l * NUQ_PAD * 512, M, NUQ_PAD, 512}; pg8::StaticOrder S; S.init(M, NUQ_PAD, C_G, C_bid);
              pg8::EpiUq E{args.ws};
              pg8::gemm_phase<pg8::EpiUq, pg8::StaticOrder, true, true>(lds, g, S, E); }
            { pg8::Gemm g{WSP(bf16, WS_CKV), WSP(bf16, WS_WUKV) + (size_t)l * NUKV * 256, M, NUKV, 256}; pg8::StaticOrder S; S.init(M, NUKV, C_G, (C_bid + 128) % C_G);
              pg8::EpiUkv E{args.ws};
              pg8::gemm_phase<pg8::EpiUkv, pg8::StaticOrder, true, true>(lds, g, S, E); }
        }
        SEAM(pb + 1);
        if (IN(pb + 2)) {
#if MK_NAIVE_ATTN
            p3_naive(args, l, lds); __syncthreads();
#else
            p3_attention(args, l, lds);
#endif
        }
        SEAM(pb + 2);
        if (IN(pb + 3)) {
            pg8::Gemm g{WSP(bf16, WS_G), WSP(bf16, WS_WOUT) + (size_t)l * DM * DM, M, DM, DM}; pg8::StaticOrder S; S.init(M, DM, C_G, C_bid);
            pg8::EpiOut E{l == 0 ? args.in[0] : args.out, args.out, args.ws};
            pg8::gemm_phase<pg8::EpiOut, pg8::StaticOrder, true, true>(lds, g, S, E);
        }
        SEAM(pb + 3);
    }
    if (IN(9)) p5_final(args);
#undef IN
#undef SEAM
}

extern "C" void kernel_launch(void* const* d_in, const int* in_sizes, int n_in, void* d_out, int out_size, void* d_ws, size_t ws_size, hipStream_t stream) {
    static int grid = 0;
    if (grid == 0) {
        if (n_in != 16 || in_sizes[0] != M * DM || out_size != M * DM || ws_size < WS_END) {
            fprintf(stderr, "kernel_launch: unexpected shapes (n_in %d, in0 %d, out %d, ws %zu; need ws >= %zu)\n", n_in, n_in > 0 ? in_sizes[0] : -1, out_size, ws_size, (size_t)WS_END); grid = -1; return; }
        int dev = 0, cus = 0, per_cu = 0;
        if (hipGetDevice(&dev) != hipSuccess || hipDeviceGetAttribute(&cus, hipDeviceAttributeMultiprocessorCount, dev) != hipSuccess) { fprintf(stderr, "kernel_launch: device query failed\n"); grid = -1; return; }
        if (hipFuncSetAttribute((const void*)fwd_kernel, hipFuncAttributeMaxDynamicSharedMemorySize, LDS_BYTES) != hipSuccess) { fprintf(stderr, "kernel_launch: hipFuncSetAttribute failed\n"); grid = -1; return; }
        if (hipOccupancyMaxActiveBlocksPerMultiprocessor(&per_cu, (const void*)fwd_kernel, NTHREADS, LDS_BYTES) != hipSuccess || per_cu < 1) {
            fprintf(stderr, "kernel_launch: occupancy query reports %d blocks per CU\n", per_cu); (void)hipGetLastError(); grid = -1; return; }
        grid = cus;
    }
    if (grid < 0) return;
    if (hipMemsetAsync((char*)d_ws + WS_CTL, 0, 4096, stream) != hipSuccess) { fprintf(stderr, "kernel_launch: memset failed\n"); return; }
    Args a{};
    for (int i = 0; i < 16; ++i) a.in[i] = (const float*)d_in[i];
    a.out = (float*)d_out; a.ws = (unsigned char*)d_ws;
#if MK_FUSED
    a.ph_lo = 0; a.ph_hi = N_PHASES;
    void* kargs[] = {&a};
    hipError_t e = hipLaunchCooperativeKernel((const void*)fwd_kernel, dim3(grid), dim3(NTHREADS), kargs, LDS_BYTES, stream);
    if (e != hipSuccess) fprintf(stderr, "kernel_launch: cooperative launch failed: %s (grid %d)\n", hipGetErrorString(e), grid);
#else
    for (int p = 0; p < N_PHASES; ++p) {
        a.ph_lo = p; a.ph_hi = p + 1;
        hipLaunchKernelGGL(fwd_kernel, dim3(grid), dim3(NTHREADS), LDS_BYTES, stream, a);
    }
#endif
}
```

```cpp
#include <hip/hip_runtime.h>
#include <hip/hip_cooperative_groups.h>
#include <cstdio>
#include <cstdint>
#include <cmath>
namespace cg = cooperative_groups;

constexpr int NB = 4, SEQ = 4096, DM = 2048, M = NB * SEQ, DEPTH = 2;
constexpr int NIN = 6726, NIN_PAD = 6912;
constexpr int NUQ_PAD = 1280, NUKV = 1536;
constexpr int LDX = 2112;
constexpr float EPS = 1e-6f;

constexpr size_t MiB = 1u << 20;
constexpr size_t WIN_BYTES = 28 * MiB, WOUT_BYTES = 9 * MiB;
constexpr size_t WS_CTL = 0, CTL_ZERO_BYTES = 1 * MiB;
constexpr size_t WS_WIN = 1 * MiB;
constexpr size_t WS_WUQ = WS_WIN + 56 * MiB;
constexpr size_t WS_WUKV = WS_WUQ + 5 * MiB / 2;
constexpr size_t WS_WOUT = WS_WUKV + 3 * MiB / 2;
constexpr size_t WS_ROPE = WS_WOUT + 18 * MiB;
constexpr size_t WS_XSS = WS_ROPE + 1 * MiB;
constexpr size_t WS_LOGF = WS_XSS + 2 * MiB;
constexpr size_t WS_CUMT = WS_LOGF + MiB / 2;
constexpr size_t WS_CQSS = WS_CUMT + MiB / 2;
constexpr size_t WS_CKVSS = WS_CQSS + MiB / 2;
constexpr size_t WS_XB = WS_CKVSS + MiB / 2;
constexpr size_t WS_G = WS_XB + 66 * MiB;
constexpr size_t WS_AQ = WS_G + 66 * MiB, WS_AK = WS_AQ + 24 * MiB, WS_AV = WS_AK + 24 * MiB;
constexpr size_t WS_CQ = WS_AV + 24 * MiB;
constexpr size_t WS_CKV = WS_CQ + 16 * MiB;
constexpr size_t WS_QB = WS_CKV + 8 * MiB, WS_KB = WS_QB + 36 * MiB, WS_VB = WS_KB + 36 * MiB;
constexpr size_t WS_CQ2 = WS_VB + 24 * MiB, WS_CK2 = WS_CQ2 + 16 * MiB, WS_CV = WS_CK2 + 16 * MiB;
constexpr size_t WS_END = WS_CV + 16 * MiB;
static_assert(WS_END <= 512 * MiB, "workspace map");

constexpr int RING_BYTES = 131072, LDS_BYTES = 147456;
constexpr int NWAVES = 8, NTHREADS = 512;

namespace pg8 {
#define PG8_LAS __attribute__((address_space(3)))
typedef unsigned short bf16_t;
typedef short bf16x8 __attribute__((ext_vector_type(8)));
typedef float f32x4 __attribute__((ext_vector_type(4)));
typedef unsigned u32x4 __attribute__((ext_vector_type(4)));
constexpr int BM = 256, BK = 64, HALF = 128, HTB = HALF * BK * 2  , STAGE_BYTES = 8 * HTB, NXCD = 8, WGM = 8;

__host__ __device__ __forceinline__ int lds_byte(int r, int c) { const int st = (r >> 4) * 2 + (c >> 5), rr = r & 15, cc = c & 31, ob = rr * 64 + cc * 2; return st * 1024 + (ob ^ (((ob >> 9) & 1) << 5)); }
__host__ __device__ __forceinline__ void stage_rc(int b, int& R, int& C) { const int st = b / 1024, sb = b % 1024, swz = sb ^ (((sb >> 9) & 1) << 5); R = (st >> 1) * 16 + swz / 64; C = (st & 1) * 32 + (swz % 64) / 2; }
__host__ __device__ __forceinline__ int perm32(int rho) { const int n = rho >> 4, i = rho & 15; return 8 * (i >> 2) + 4 * n + (i & 3); }

struct Unit { int pm, pn; };
struct Gemm { const bf16_t* A; const bf16_t* Bt; int M, N, K, lda, ldb; };

struct StaticOrder {
    int nM, nN, nwg, G, c;
    __host__ __device__ void init(int M, int N, int G_, int c_) { nM = M / BM; nN = N / BM; nwg = nM * nN; G = G_; c = c_; }
    __host__ __device__ bool next(int i, Unit& u) const {
        const long L = (long)i * G + c; if (L >= nwg) return false;
        int wgid = (int)L; { const int q = nwg / NXCD, r = nwg % NXCD, xcd = wgid % NXCD, off = wgid / NXCD; wgid = (xcd < r ? xcd * (q + 1) : r * (q + 1) + (xcd - r) * q) + off; }
        const int nig = WGM * nN, gid = wgid / nig, fm = gid * WGM, gsz = (nM - fm) < WGM ? (nM - fm) : WGM;
        u.pm = fm + ((wgid % nig) % gsz); u.pn = (wgid % nig) / gsz; return true;
    }
    __device__ __forceinline__ void a_ready(const Unit&) const {}
    __device__ __forceinline__ void done(const Unit&) const {}
};


__device__ __forceinline__ unsigned cvt_pk_bf16(float lo, float hi) { unsigned r; asm volatile("v_cvt_pk_bf16_f32 %0, %1, %2" : "=v"(r) : "v"(lo), "v"(hi)); return r; }
typedef float f32x2 __attribute__((ext_vector_type(2)));
typedef unsigned u32x2 __attribute__((ext_vector_type(2)));
constexpr float RMS_EPS = 1e-6f;
__device__ __forceinline__ float silu_f(float v) { return v / (1.0f + __expf(-v)); }
__device__ __forceinline__ u32x4 pack8v(f32x4 a, f32x4 b) { u32x4 w; w.x = cvt_pk_bf16(a[0], a[1]); w.y = cvt_pk_bf16(a[2], a[3]); w.z = cvt_pk_bf16(b[0], b[1]); w.w = cvt_pk_bf16(b[2], b[3]); return w; }
__device__ __forceinline__ void rope4(f32x4 v0, f32x4 v1, f32x4 cs, f32x4 sn, u32x2& lo, u32x2& hi) {
    const float a0 = v0[0], b0 = v0[1], a1 = v0[2], b1 = v0[3], a2 = v1[0], b2 = v1[1], a3 = v1[2], b3 = v1[3];
    lo.x = cvt_pk_bf16(a0 * cs[0] - b0 * sn[0], a1 * cs[1] - b1 * sn[1]); lo.y = cvt_pk_bf16(a2 * cs[2] - b2 * sn[2], a3 * cs[3] - b3 * sn[3]);
    hi.x = cvt_pk_bf16(a0 * sn[0] + b0 * cs[0], a1 * sn[1] + b1 * cs[1]); hi.y = cvt_pk_bf16(a2 * sn[2] + b2 * cs[2], a3 * sn[3] + b3 * cs[3]);
}

struct EpiIn {
    static constexpr bool PERM = true, AFTER_DRAIN = false;
    unsigned char* ws;
    const float* bforget;
    __device__ __forceinline__ void operator()(const f32x4 (&acc)[2][2][4][2], const Unit& u, int wr, int wc, int fr, int fq) const {
        const int row0 = u.pm * BM + wr * 64 + fr; const int pn = u.pn;
        const float* xss = (const float*)(ws + WS_XSS);
        float rs[2][4];
#pragma unroll
        for (int ai = 0; ai < 2; ++ai)
#pragma unroll
            for (int m = 0; m < 4; ++m) { const int row = row0 + ai * HALF + m * 16; const f32x4* p = (const f32x4*)(xss + (size_t)row * 32 + fq * 8);
                const f32x4 a = p[0], b = p[1]; float s = ((a[0] + a[1]) + (a[2] + a[3])) + ((b[0] + b[1]) + (b[2] + b[3]));
                s += __shfl_xor(s, 16); s += __shfl_xor(s, 32); rs[ai][m] = rsqrtf(s * (1.0f / 2048.0f) + RMS_EPS); }
        if (pn < 26) {
            size_t doff; int ld, cb, kind = 0; size_t ssoff = 0; int sld = 0, slot = 0;
            if (pn < 3) { doff = WS_AQ; ld = 768; cb = pn * 256; }
            else if (pn < 6) { doff = WS_AK; ld = 768; cb = (pn - 3) * 256; }
            else if (pn < 9) { doff = WS_AV; ld = 768; cb = (pn - 6) * 256; }
            else if (pn < 12) { doff = WS_G; ld = LDX; cb = (pn - 9) * 256; kind = 1; }
            else if (pn < 14) { doff = WS_CQ; ld = 512; cb = (pn - 12) * 256; kind = 2; ssoff = WS_CQSS; sld = 8; slot = (pn - 12) * 4 + wc; }
            else if (pn == 14) { doff = WS_CKV; ld = 256; cb = 0; kind = 2; ssoff = WS_CKVSS; sld = 4; slot = wc; }
            else if (pn < 18) { doff = WS_G; ld = LDX; cb = 768 + (pn - 15) * 256; kind = 1; }
            else if (pn < 20) { doff = WS_CQ2; ld = 512; cb = (pn - 18) * 256; }
            else if (pn < 22) { doff = WS_CK2; ld = 512; cb = (pn - 20) * 256; }
            else if (pn < 24) { doff = WS_CV; ld = 512; cb = (pn - 22) * 256; }
            else { doff = WS_G; ld = LDX; cb = 1536 + (pn - 24) * 256; kind = 1; }
            bf16_t* dst = (bf16_t*)(ws + doff); float* ss = (float*)(ws + ssoff);
            const int col0 = cb + wc * 32 + 8 * fq;
#pragma unroll
            for (int ai = 0; ai < 2; ++ai)
#pragma unroll
                for (int m = 0; m < 4; ++m) { const int row = row0 + ai * HALF + m * 16; bf16_t* rowp = dst + (size_t)row * ld + col0; const float r = rs[ai][m]; float sq = 0.f;
#pragma unroll
                    for (int bj = 0; bj < 2; ++bj) { f32x4 v0 = acc[ai][bj][m][0] * r, v1 = acc[ai][bj][m][1] * r;
                        if (kind == 1) {
#pragma unroll
                            for (int j = 0; j < 4; ++j) { v0[j] = silu_f(v0[j]); v1[j] = silu_f(v1[j]); } }
                        if (kind == 2) sq += ((v0[0] * v0[0] + v0[1] * v0[1]) + (v0[2] * v0[2] + v0[3] * v0[3])) + ((v1[0] * v1[0] + v1[1] * v1[1]) + (v1[2] * v1[2] + v1[3] * v1[3]));
                        *(u32x4*)(rowp + bj * HALF) = pack8v(v0, v1); }
                    if (kind == 2) { sq += __shfl_xor(sq, 16); sq += __shfl_xor(sq, 32); if (fq == 0) ss[(size_t)row * sld + slot] = sq; } }
        } else {
            if (wc < 2) {
                const int i0 = 16 * wc + 4 * fq; const float* ropeC = (const float*)(ws + WS_ROPE); const float* ropeS = ropeC + 4096 * 32; bf16_t* KB = (bf16_t*)(ws + WS_KB);
#pragma unroll
                for (int ai = 0; ai < 2; ++ai)
#pragma unroll
                    for (int m = 0; m < 4; ++m) { const int row = row0 + ai * HALF + m * 16; const float r = rs[ai][m]; const int t = row & 4095;
                        const f32x4 cs = *(const f32x4*)(ropeC + t * 32 + i0), sn = *(const f32x4*)(ropeS + t * 32 + i0);
                        u32x2 lo, hi; rope4(acc[ai][0][m][0] * r, acc[ai][0][m][1] * r, cs, sn, lo, hi);
                        bf16_t* kp = KB + (size_t)row * 1152 + 128 + i0;
#pragma unroll
                        for (int h = 0; h < 6; ++h) { *(u32x2*)(kp + h * 192) = lo; *(u32x2*)(kp + h * 192 + 32) = hi; }
                        asm volatile("" ::: "memory"); }
            } else if (wc == 2 && fq == 0) {
                float* LOGF = (float*)(ws + WS_LOGF);
                f32x4 b0; b0[0] = bforget[0]; b0[1] = bforget[1]; b0[2] = bforget[2]; b0[3] = bforget[3]; f32x4 b1; b1[0] = bforget[4]; b1[1] = bforget[5]; b1[2] = 0.f; b1[3] = 0.f;
#pragma unroll
                for (int ai = 0; ai < 2; ++ai)
#pragma unroll
                    for (int m = 0; m < 4; ++m) { const int row = row0 + ai * HALF + m * 16; const float r = rs[ai][m];
                        f32x4 z0 = acc[ai][0][m][0] * r + b0, z1 = acc[ai][0][m][1] * r + b1, l0, l1;
#pragma unroll
                        for (int j = 0; j < 4; ++j) { l0[j] = fminf(z0[j], 0.f) - log1pf(__expf(-fabsf(z0[j]))); l1[j] = fminf(z1[j], 0.f) - log1pf(__expf(-fabsf(z1[j]))); }
                        l1[2] = 0.f; l1[3] = 0.f;
                        *(f32x4*)(LOGF + (size_t)row * 8) = l0; *(f32x4*)(LOGF + (size_t)row * 8 + 4) = l1; }
            }
        }
    }
};

struct EpiUq {
    static constexpr bool PERM = true, AFTER_DRAIN = false;
    unsigned char* ws;
    __device__ __forceinline__ void operator()(const f32x4 (&acc)[2][2][4][2], const Unit& u, int wr, int wc, int fr, int fq) const {
        const int row0 = u.pm * BM + wr * 64 + fr; const int pn = u.pn;
        const float* CQSS = (const float*)(ws + WS_CQSS); bf16_t* QB = (bf16_t*)(ws + WS_QB); const float* ropeC = (const float*)(ws + WS_ROPE); const float* ropeS = ropeC + 4096 * 32;
        float rs[2][4];
#pragma unroll
        for (int ai = 0; ai < 2; ++ai)
#pragma unroll
            for (int m = 0; m < 4; ++m) { const int row = row0 + ai * HALF + m * 16; const f32x2 a = *(const f32x2*)(CQSS + (size_t)row * 8 + fq * 2);
                float s = a[0] + a[1]; s += __shfl_xor(s, 16); s += __shfl_xor(s, 32); rs[ai][m] = rsqrtf(s * (1.0f / 512.0f) + RMS_EPS); }
        if (pn < 3) {
#pragma unroll
            for (int ai = 0; ai < 2; ++ai)
#pragma unroll
                for (int m = 0; m < 4; ++m) { const int row = row0 + ai * HALF + m * 16; const float r = rs[ai][m];
#pragma unroll
                    for (int bj = 0; bj < 2; ++bj) { const int h = pn * 2 + bj; bf16_t* p = QB + (size_t)row * 1152 + 192 * h + wc * 32 + 8 * fq;
                        *(u32x4*)p = pack8v(acc[ai][bj][m][0] * r, acc[ai][bj][m][1] * r); } }
        } else {
            const int i0 = 16 * (wc & 1) + 4 * fq;
#pragma unroll
            for (int ai = 0; ai < 2; ++ai)
#pragma unroll
                for (int m = 0; m < 4; ++m) { const int row = row0 + ai * HALF + m * 16; const float r = rs[ai][m]; const int t = row & 4095;
                    const f32x4 cs = *(const f32x4*)(ropeC + t * 32 + i0), sn = *(const f32x4*)(ropeS + t * 32 + i0);
#pragma unroll
                    for (int bj = 0; bj < 2; ++bj) { const int cc = (pn - 3) * 256 + bj * HALF + wc * 32; const int hh = cc >> 6;
                        if (hh < 6) { u32x2 lo, hi; rope4(acc[ai][bj][m][0] * r, acc[ai][bj][m][1] * r, cs, sn, lo, hi);
                            bf16_t* p = QB + (size_t)row * 1152 + 192 * hh + 128 + i0; *(u32x2*)p = lo; *(u32x2*)(p + 32) = hi; } }
                    asm volatile("" ::: "memory"); }
        }
    }
};
struct EpiUkv {
    static constexpr bool PERM = true, AFTER_DRAIN = false;
    unsigned char* ws;
    __device__ __forceinline__ void operator()(const f32x4 (&acc)[2][2][4][2], const Unit& u, int wr, int wc, int fr, int fq) const {
        const int row0 = u.pm * BM + wr * 64 + fr; const int pn = u.pn;
        const float* CKVSS = (const float*)(ws + WS_CKVSS); bf16_t* KB = (bf16_t*)(ws + WS_KB); bf16_t* VB = (bf16_t*)(ws + WS_VB);
#pragma unroll
        for (int ai = 0; ai < 2; ++ai)
#pragma unroll
            for (int m = 0; m < 4; ++m) { const int row = row0 + ai * HALF + m * 16; const f32x4 a = *(const f32x4*)(CKVSS + (size_t)row * 4);
                const float r = rsqrtf(((a[0] + a[1]) + (a[2] + a[3])) * (1.0f / 256.0f) + RMS_EPS);
#pragma unroll
                for (int bj = 0; bj < 2; ++bj) {
                    bf16_t* p;
                    if (pn < 3) p = KB + (size_t)row * 1152 + 192 * (pn * 2 + bj) + wc * 32 + 8 * fq;
                    else p = VB + (size_t)row * 768 + (pn - 3) * 256 + bj * HALF + wc * 32 + 8 * fq;
                    *(u32x4*)p = pack8v(acc[ai][bj][m][0] * r, acc[ai][bj][m][1] * r); } }
    }
};
struct EpiOut {
    static constexpr bool PERM = true, AFTER_DRAIN = false;
    const float* base; float* out; unsigned char* ws;
    __device__ __forceinline__ void operator()(const f32x4 (&acc)[2][2][4][2], const Unit& u, int wr, int wc, int fr, int fq) const {
        const int row0 = u.pm * BM + wr * 64 + fr; const int col0 = u.pn * BM + wc * 32 + 8 * fq;
        bf16_t* XB = (bf16_t*)(ws + WS_XB); float* xss = (float*)(ws + WS_XSS);
#pragma unroll
        for (int ai = 0; ai < 2; ++ai)
#pragma unroll
            for (int m = 0; m < 4; ++m) { const int row = row0 + ai * HALF + m * 16; const size_t off = (size_t)row * 2048 + col0, offb = (size_t)row * LDX + col0; float sq = 0.f;
#pragma unroll
                for (int bj = 0; bj < 2; ++bj) { const f32x4 x0 = *(const f32x4*)(base + off + bj * HALF), x1 = *(const f32x4*)(base + off + bj * HALF + 4);
                    const f32x4 v0 = x0 + acc[ai][bj][m][0], v1 = x1 + acc[ai][bj][m][1];
                    sq += ((v0[0] * v0[0] + v0[1] * v0[1]) + (v0[2] * v0[2] + v0[3] * v0[3])) + ((v1[0] * v1[0] + v1[1] * v1[1]) + (v1[2] * v1[2] + v1[3] * v1[3]));
                    *(f32x4*)(out + off + bj * HALF) = v0; *(f32x4*)(out + off + bj * HALF + 4) = v1;
                    *(u32x4*)(XB + offb + bj * HALF) = pack8v(v0, v1); }
                sq += __shfl_xor(sq, 16); sq += __shfl_xor(sq, 32); if (fq == 0) xss[(size_t)row * 32 + u.pn * 4 + wc] = sq; }
    }
};

template <class Epi, class Sched, bool ALIGN_EPI = false, bool SP2 = false>
__device__ __forceinline__ void gemm_phase(PG8_LAS unsigned char* lds, const Gemm g, const Sched& S, const Epi& E) {
    int tid_ = threadIdx.x; asm volatile("" : "+v"(tid_));
    const int tid = tid_, wid = __builtin_amdgcn_readfirstlane(tid >> 6), lane = tid & 63, wr = wid >> 2, wc = wid & 3, fr = lane & 15, fq = lane >> 4;
    const int K = g.K, nt = K / BK;
    unsigned voffA[2], voffB[2];
#pragma unroll
    for (int i = 0; i < 2; ++i) { int R, C; stage_rc(tid * 16 + i * 8192, R, C); const int Rb = Epi::PERM ? ((R & ~31) + perm32(R & 31)) : R;
        voffA[i] = (unsigned)(R * g.lda + C) * 2u; voffB[i] = (unsigned)(Rb * g.ldb + C) * 2u; }
    const size_t kstep = (size_t)(BK * 2);
    const size_t hstepA = (size_t)HALF * g.lda * 2, hstepB = (size_t)HALF * g.ldb * 2;
    const size_t tstepA = 2 * hstepA, tstepB = 2 * hstepB;
    const unsigned ldsw = (unsigned)wid * 1024u;
    const int aoff = lds_byte(wr * 64 + fr, fq * 8), boff = lds_byte(wc * 32 + fr, fq * 8);
#define PG8_SA(b, h) (((b) * 2 + (h)) * HTB)
#define PG8_SB(b, h) ((4 + (b) * 2 + (h)) * HTB)
#define PG8_STAGE(bufoff, gbase, voff) do { _Pragma("unroll") for (int _i = 0; _i < 2; ++_i) \
        __builtin_amdgcn_global_load_lds((const unsigned*)((const char*)(gbase) + (voff)[_i]), (PG8_LAS unsigned*)(lds + (bufoff) + ldsw + _i * 8192), 16, 0, 0); } while (0)
#define PG8_LDA(dst, b, h) do { _Pragma("unroll") for (int m = 0; m < 4; ++m) _Pragma("unroll") for (int k = 0; k < 2; ++k) dst[m][k] = *(const PG8_LAS bf16x8*)(lds + PG8_SA(b, h) + aoff + m * 2048 + k * 1024); } while (0)
#define PG8_LDB(dst, b, h) do { _Pragma("unroll") for (int n = 0; n < 2; ++n) _Pragma("unroll") for (int k = 0; k < 2; ++k) dst[n][k] = *(const PG8_LAS bf16x8*)(lds + PG8_SB(b, h) + boff + n * 2048 + k * 1024); } while (0)
#define PG8_MMA(ai, bj, At, Bt) do { __builtin_amdgcn_s_setprio(1); _Pragma("unroll") for (int m = 0; m < 4; ++m) _Pragma("unroll") for (int n = 0; n < 2; ++n) _Pragma("unroll") for (int k = 0; k < 2; ++k) \
        acc[ai][bj][m][n] = __builtin_amdgcn_mfma_f32_16x16x32_bf16(Bt[n][k], At[m][k], acc[ai][bj][m][n], 0, 0, 0); __builtin_amdgcn_s_setprio(0); } while (0)
#define PG8_WAIT_V(n) asm volatile("s_waitcnt vmcnt(" #n ")" ::: "memory")
#define PG8_WAIT_L(n) asm volatile("s_waitcnt lgkmcnt(" #n ")" ::: "memory")
#define PG8_BAR __builtin_amdgcn_s_barrier()
#define PG8_SCHED __builtin_amdgcn_sched_barrier(0)
    Unit cur, nxt; int ui = 0;
    if (!S.next(0, cur)) return;
    f32x4 acc[2][2][4][2];
#pragma unroll
    for (int a = 0; a < 2; ++a)
#pragma unroll
        for (int b = 0; b < 2; ++b)
#pragma unroll
            for (int m = 0; m < 4; ++m)
#pragma unroll
                for (int n = 0; n < 2; ++n) acc[a][b][m][n] = (f32x4){0.f, 0.f, 0.f, 0.f};
    bf16x8 At[4][2], B0[2][2], B1[2][2];
    const char* cA = (const char*)g.A + (size_t)cur.pm * tstepA; const char* cB = (const char*)g.Bt + (size_t)cur.pn * tstepB;
    S.a_ready(cur);
    if constexpr (SP2) {
        PG8_STAGE(PG8_SB(0, 0), cB, voffB); PG8_STAGE(PG8_SB(0, 1), cB + hstepB, voffB); PG8_STAGE(PG8_SA(0, 0), cA, voffA); PG8_STAGE(PG8_SA(0, 1), cA + hstepA, voffA);
        if (wr == 1) PG8_BAR;
        PG8_WAIT_V(2); PG8_BAR;
        PG8_STAGE(PG8_SB(1, 0), cB + kstep, voffB); PG8_STAGE(PG8_SA(1, 0), cA + kstep, voffA); PG8_STAGE(PG8_SB(1, 1), cB + hstepB + kstep, voffB);
        PG8_WAIT_V(6); PG8_BAR;
    } else {
        PG8_STAGE(PG8_SB(0, 0), cB, voffB); PG8_STAGE(PG8_SA(0, 0), cA, voffA); PG8_STAGE(PG8_SB(0, 1), cB + hstepB, voffB); PG8_STAGE(PG8_SA(0, 1), cA + hstepA, voffA);
        if (wr == 1) PG8_BAR;
        PG8_WAIT_V(4); PG8_BAR;
        PG8_STAGE(PG8_SB(1, 0), cB + kstep, voffB); PG8_STAGE(PG8_SA(1, 0), cA + kstep, voffA); PG8_STAGE(PG8_SB(1, 1), cB + hstepB + kstep, voffB);
        PG8_WAIT_V(6); PG8_BAR;
    }
    for (;;) {
        const bool has_next = S.next(ui + 1, nxt);
        const char* nA = has_next ? (const char*)g.A + (size_t)nxt.pm * tstepA : cA; const char* nB = has_next ? (const char*)g.Bt + (size_t)nxt.pn * tstepB : cB;
        for (int t = 0; t < nt; t += 2) {
            const bool last = (t == nt - 2);
            const char* a1 = cA + (size_t)(t + 1) * kstep;
            const char* a2 = last ? nA : cA + (size_t)(t + 2) * kstep; const char* b2 = last ? nB : cB + (size_t)(t + 2) * kstep;
            const char* a3 = a2 + kstep; const char* b3 = b2 + kstep;
            if (last && has_next) S.a_ready(nxt);
            if constexpr (SP2) {
            PG8_LDB(B0, 0, 0); PG8_LDB(B1, 0, 1); PG8_SCHED; PG8_LDA(At, 0, 0); PG8_STAGE(PG8_SA(1, 1), a1 + hstepA, voffA);
            PG8_WAIT_V(8); PG8_WAIT_L(0); PG8_BAR; PG8_MMA(0, 0, At, B0); PG8_MMA(0, 1, At, B1); PG8_BAR; PG8_SCHED;
            PG8_LDA(At, 0, 1); PG8_STAGE(PG8_SB(0, 0), b2, voffB); PG8_STAGE(PG8_SB(0, 1), b2 + hstepB, voffB); PG8_STAGE(PG8_SA(0, 0), a2, voffA);
            PG8_WAIT_V(8); PG8_WAIT_L(0); PG8_BAR; PG8_MMA(1, 0, At, B0); PG8_MMA(1, 1, At, B1); PG8_BAR; PG8_SCHED;
            PG8_LDB(B0, 1, 0); PG8_LDB(B1, 1, 1); PG8_SCHED; PG8_LDA(At, 1, 0); PG8_STAGE(PG8_SA(0, 1), a2 + hstepA, voffA);
            PG8_WAIT_V(8); PG8_WAIT_L(0); PG8_BAR; PG8_MMA(0, 0, At, B0); PG8_MMA(0, 1, At, B1); PG8_BAR; PG8_SCHED;
            PG8_LDA(At, 1, 1); PG8_STAGE(PG8_SB(1, 0), b3, voffB); PG8_STAGE(PG8_SB(1, 1), b3 + hstepB, voffB); PG8_STAGE(PG8_SA(1, 0), a3, voffA);
            PG8_WAIT_V(8); PG8_WAIT_L(0); PG8_BAR; PG8_MMA(1, 0, At, B0); PG8_MMA(1, 1, At, B1); PG8_BAR; PG8_SCHED;
            } else {
            PG8_LDB(B0, 0, 0); PG8_SCHED; PG8_LDA(At, 0, 0); PG8_STAGE(PG8_SA(1, 1), a1 + hstepA, voffA);
            PG8_WAIT_L(8); PG8_BAR; PG8_WAIT_L(0); PG8_MMA(0, 0, At, B0); PG8_BAR; PG8_SCHED;
            PG8_LDB(B1, 0, 1); PG8_STAGE(PG8_SB(0, 0), b2, voffB);
            PG8_BAR; PG8_WAIT_L(0); PG8_MMA(0, 1, At, B1); PG8_BAR;
            PG8_LDA(At, 0, 1); PG8_STAGE(PG8_SA(0, 0), a2, voffA);
            PG8_BAR; PG8_WAIT_L(0); PG8_MMA(1, 0, At, B0); PG8_BAR; PG8_SCHED;
            PG8_STAGE(PG8_SB(0, 1), b2 + hstepB, voffB);
            PG8_WAIT_V(6); PG8_BAR; PG8_MMA(1, 1, At, B1); PG8_BAR;
            PG8_LDB(B0, 1, 0); PG8_SCHED; PG8_LDA(At, 1, 0); PG8_STAGE(PG8_SA(0, 1), a2 + hstepA, voffA);
            PG8_WAIT_L(8); PG8_BAR; PG8_WAIT_L(0); PG8_MMA(0, 0, At, B0); PG8_BAR; PG8_SCHED;
            PG8_LDB(B1, 1, 1); PG8_STAGE(PG8_SB(1, 0), b3, voffB);
            PG8_BAR; PG8_WAIT_L(0); PG8_MMA(0, 1, At, B1); PG8_BAR;
            PG8_LDA(At, 1, 1); PG8_STAGE(PG8_SA(1, 0), a3, voffA);
            PG8_BAR; PG8_WAIT_L(0); PG8_MMA(1, 0, At, B0); PG8_BAR; PG8_SCHED;
            PG8_STAGE(PG8_SB(1, 1), b3 + hstepB, voffB);
            PG8_WAIT_V(6); PG8_BAR; PG8_MMA(1, 1, At, B1); PG8_BAR;
            }
        }
        if constexpr (ALIGN_EPI) { if (wr == 0) PG8_BAR; }
        if constexpr (!Epi::AFTER_DRAIN) { E(acc, cur, wr, wc, fr, fq); S.done(cur); __builtin_amdgcn_s_waitcnt(0x0F70); }
        if (!has_next) break;
#pragma unroll
        for (int a = 0; a < 2; ++a)
#pragma unroll
            for (int b = 0; b < 2; ++b)
#pragma unroll
                for (int m = 0; m < 4; ++m)
#pragma unroll
                    for (int n = 0; n < 2; ++n) acc[a][b][m][n] = (f32x4){0.f, 0.f, 0.f, 0.f};
        cur = nxt; cA = nA; cB = nB; ++ui;
        if constexpr (ALIGN_EPI) { if (wr == 1) PG8_BAR; }
    }
    PG8_WAIT_V(0);
    if constexpr (!ALIGN_EPI) { if (wr == 0) PG8_BAR; }
    PG8_BAR;
    if constexpr (Epi::AFTER_DRAIN) { E.fused(acc, cur, wr, wc, fr, fq, lds, wid, lane); S.done(cur); }
#undef PG8_SA
#undef PG8_SB
#undef PG8_STAGE
#undef PG8_LDA
#undef PG8_LDB
#undef PG8_MMA
#undef PG8_WAIT_V
#undef PG8_WAIT_L
#undef PG8_BAR
#undef PG8_SCHED
}
}
#define GAS __attribute__((address_space(1)))
#define LAS __attribute__((address_space(3)))
typedef unsigned short bf16;
typedef unsigned v4u __attribute__((ext_vector_type(4)));
typedef float f32x4 __attribute__((ext_vector_type(4)));
typedef float f32x2 __attribute__((ext_vector_type(2)));
typedef short bf16x8 __attribute__((ext_vector_type(8)));
#define LDS_WAIT() asm volatile("s_waitcnt lgkmcnt(0)" ::: "memory")

__device__ __forceinline__ unsigned f2bf(float f) { unsigned u = __builtin_bit_cast(unsigned, f); return (u + 0x7fffu + ((u >> 16) & 1u)) >> 16; }
__device__ __forceinline__ unsigned pk2(float lo, float hi) { return f2bf(lo) | (f2bf(hi) << 16); }
__device__ __forceinline__ float bf2f(unsigned short h) { return __builtin_bit_cast(float, (unsigned)h << 16); }
__device__ __forceinline__ float wave_sum(float v) {
#pragma unroll
    for (int o = 1; o < 64; o <<= 1) v += __shfl_xor(v, o);
    return v;
}
__device__ __forceinline__ float wave_max(float v) {
#pragma unroll
    for (int o = 1; o < 64; o <<= 1) v = fmaxf(v, __shfl_xor(v, o));
    return v;
}

struct Args {
    const float* in[16]; float* out; unsigned char* ws; int ph_lo, ph_hi;
};

__device__ __forceinline__ int colmap_in(int n) {
    const int t = n >> 8;
    if (t < 9) return n;
    if (t < 12) return 2310 + (n - 2304);
    if (t < 14) return 3078 + (n - 3072);
    if (t == 14) return 3590 + (n - 3584);
    if (t < 18) return 3910 + (n - 3840);
    if (t < 20) return 4678 + (n - 4608);
    if (t < 22) return 5190 + (n - 5120);
    if (t < 24) return 5702 + (n - 5632);
    if (t < 26) return 6214 + (n - 6144);
    const int j = n & 255;
    if (j < 64) return 3846 + (j >> 1) + 32 * (j & 1);
    if (j < 70) return 2304 + (j - 64);
    return -1;
}
__device__ __forceinline__ int colmap_uq(int n) {
    if (n < 768) return 192 * (n >> 7) + (n & 127);
    if (n < 1152) { const int hh = (n - 768) >> 6, p = (n - 768) & 63; return 192 * hh + 128 + (p >> 1) + 32 * (p & 1); }
    return -1;
}
__device__ __forceinline__ int colmap_ukv(int n) {
    if (n < 768) return 256 * (n >> 7) + (n & 127);
    const int c = n - 768; return 256 * (c >> 7) + 128 + (c & 127);
}
template <int MAT> __device__ __forceinline__ void tr_item(const float* W, int Norig, const float* gk, bf16* WT, int ldw, int k0, int n0, LAS float* scr, int lane) {
    const int nn = lane & 31; int oc;
    if (MAT == 0) oc = colmap_in(n0 + nn); else if (MAT == 1) oc = colmap_uq(n0 + nn); else if (MAT == 2) oc = colmap_ukv(n0 + nn); else oc = n0 + nn;
#pragma unroll 8
    for (int i = 0; i < 32; ++i) { const int kk = 2 * i + (lane >> 5); float v = 0.f;
        if (oc >= 0) { v = W[(size_t)(k0 + kk) * Norig + oc]; if (gk) v *= gk[k0 + kk]; }
        scr[kk * 33 + nn] = v; }
    LDS_WAIT(); asm volatile("" ::: "memory");
    const int c = lane & 7;
#pragma unroll
    for (int j = 0; j < 4; ++j) { const int n = (lane >> 3) + 8 * j; const LAS float* s = scr + (8 * c) * 33 + n;
        v4u o; o.x = pk2(s[0 * 33], s[1 * 33]); o.y = pk2(s[2 * 33], s[3 * 33]); o.z = pk2(s[4 * 33], s[5 * 33]); o.w = pk2(s[6 * 33], s[7 * 33]);
        *(v4u*)(WT + (size_t)(n0 + n) * ldw + k0 + 8 * c) = o; }
    LDS_WAIT(); asm volatile("" ::: "memory");
}

__device__ __forceinline__ int t5_bucket(int rel) {
    const int n = rel < 0 ? -rel : rel; int v;
    if (n < 8) v = n; else if (n < 12) v = 8; else if (n < 16) v = 9; else if (n < 23) v = 10; else if (n < 32) v = 11; else if (n < 46) v = 12; else if (n < 64) v = 13; else if (n < 91) v = 14; else v = 15;
    return (rel > 0 ? 16 : 0) + v;
}

__device__ __forceinline__ int opaque_tid() { int t = threadIdx.x; asm volatile("" : "+v"(t)); return t; }
#define C_tid (tid_o)
#define C_lane (tid_o & 63)
#define C_wave (__builtin_amdgcn_readfirstlane(tid_o >> 6))
#define C_G ((int)gridDim.x)
#define C_bid ((int)blockIdx.x)
#define WSP(T, off) ((T*)(args.ws + (off)))

__device__ __forceinline__ void p0_prologue(const Args& args, LAS unsigned char* lds) {
    const int tid_o = opaque_tid();
    LAS float* scr = (LAS float*)(lds + C_wave * 16384);
    const int gw = C_bid * NWAVES + C_wave, NGW = C_G * NWAVES;
    constexpr int I_IN = (DM / 64) * (NIN_PAD / 32), I_UQ = (512 / 64) * (NUQ_PAD / 32), I_UKV = (256 / 64) * (NUKV / 32), I_OUT = (DM / 64) * (DM / 32);
    constexpr int PER_LAYER = I_IN + I_UQ + I_UKV + I_OUT;
    for (int it = gw; it < DEPTH * PER_LAYER; it += NGW) {
        const int l = it / PER_LAYER; int r = it - l * PER_LAYER;
        if (r < I_IN) { const int nb = NIN_PAD / 32, kb = r / nb, nbk = r - kb * nb;
            tr_item<0>(args.in[2] + (size_t)l * DM * NIN, NIN, args.in[1] + l * DM, (bf16*)(args.ws + WS_WIN + (size_t)l * WIN_BYTES), LDX, kb * 64, nbk * 32, scr, C_lane); continue; }
        r -= I_IN;
        if (r < I_UQ) { const int nb = NUQ_PAD / 32, kb = r / nb, nbk = r - kb * nb;
            tr_item<1>(args.in[5] + (size_t)l * 512 * 1152, 1152, args.in[4] + l * 512, WSP(bf16, WS_WUQ) + (size_t)l * NUQ_PAD * 512, 512, kb * 64, nbk * 32, scr, C_lane); continue; }
        r -= I_UQ;
        if (r < I_UKV) { const int nb = NUKV / 32, kb = r / nb, nbk = r - kb * nb;
            tr_item<2>(args.in[7] + (size_t)l * 256 * 1536, 1536, args.in[6] + l * 256, WSP(bf16, WS_WUKV) + (size_t)l * NUKV * 256, 256, kb * 64, nbk * 32, scr, C_lane); continue; }
        r -= I_UKV;
        { const int nb = DM / 32, kb = r / nb, nbk = r - kb * nb;
            tr_item<3>(args.in[14] + (size_t)l * DM * DM, DM, nullptr, (bf16*)(args.ws + WS_WOUT + (size_t)l * WOUT_BYTES), LDX, kb * 64, nbk * 32, scr, C_lane); }
    }
    for (int m = gw; m < M; m += NGW) {
        const f32x4* xr = (const f32x4*)(args.in[0] + (size_t)m * DM) + C_lane; float s = 0.f;
        unsigned long long* o8 = (unsigned long long*)(WSP(bf16, WS_XB) + (size_t)m * LDX) + C_lane;
#pragma unroll
        for (int j = 0; j < 8; ++j) { const f32x4 v = xr[64 * j]; s += (v[0] * v[0] + v[1] * v[1]) + (v[2] * v[2] + v[3] * v[3]);
            o8[64 * j] = (unsigned long long)pk2(v[0], v[1]) | ((unsigned long long)pk2(v[2], v[3]) << 32); }
        s = wave_sum(s);
        if (C_lane < 32) WSP(float, WS_XSS)[(size_t)m * 32 + C_lane] = C_lane == 0 ? s : 0.f;
    }
    for (int e = C_bid * NTHREADS + C_tid; e < SEQ * 32; e += C_G * NTHREADS) {
        const int s = e >> 5, i = e & 31; const float inv = powf(10000.0f, -(float)i / 32.0f); const float ang = (float)s * inv;
        WSP(float, WS_ROPE)[e] = cosf(ang); WSP(float, WS_ROPE + SEQ * 32 * 4)[e] = sinf(ang);
    }
}

__device__ __forceinline__ void p2_scan(const Args& args) {
    const int tid_o = opaque_tid();
    if (C_bid >= NB * 6 || C_wave != 0) return;
    const int b = C_bid / 6, h = C_bid % 6, lane = C_lane;
    const float* src = WSP(float, WS_LOGF) + ((size_t)b * SEQ + 64 * lane) * 8 + h;
    float tot = 0.f;
#pragma unroll 8
    for (int j = 0; j < 64; ++j) tot += src[j * 8];
    float incl = tot;
#pragma unroll
    for (int o = 1; o < 64; o <<= 1) { const float y = __shfl_up(incl, o); if (lane >= o) incl += y; }
    float run = incl - tot;
    float* dst = WSP(float, WS_CUMT) + (size_t)C_bid * SEQ + 64 * lane;
#pragma unroll 8
    for (int j = 0; j < 64; ++j) { run += src[j * 8]; dst[j] = run; }
}

template <int DQK> __device__ __forceinline__ float dot_row(const bf16* kp, const LAS float* qs) {
    float s = 0.f;
#pragma unroll
    for (int c = 0; c < DQK / 8; ++c) { const v4u kv = *(const v4u*)(kp + c * 8);
        const f32x4 q0 = *(const LAS f32x4*)(qs + c * 8), q1 = *(const LAS f32x4*)(qs + c * 8 + 4);
        s += bf2f(kv.x & 0xffff) * q0[0] + bf2f(kv.x >> 16) * q0[1] + bf2f(kv.y & 0xffff) * q0[2] + bf2f(kv.y >> 16) * q0[3]
           + bf2f(kv.z & 0xffff) * q1[0] + bf2f(kv.z >> 16) * q1[1] + bf2f(kv.w & 0xffff) * q1[2] + bf2f(kv.w >> 16) * q1[3]; }
    return s;
}
template <int VAR, int DQK>
__device__ __forceinline__ void naive_map(const LAS float* qs, const bf16* Kbase, int kpitch, const bf16* Vbase, int vpitch, int nkeys, int t, const float* cum, float cumt,
                                          const float* relb, int h, int lane, float& o0, float& o1, float& l) {
    float m = -1e30f; l = 0.f; o0 = 0.f; o1 = 0.f;
    for (int k0 = 0; k0 < nkeys; k0 += 64) {
        const int key = k0 + lane;
        float s = dot_row<DQK>(Kbase + (size_t)key * kpitch, qs);
        if (VAR == 0) { s += cumt - cum[key]; if (key > t) s = -INFINITY; }
        if (VAR == 2) s += relb[t5_bucket(key - t) * 4 + h];
        const float tmax = wave_max(s), mn = fmaxf(m, tmax), alpha = __expf(m - mn), p = __expf(s - mn);
        l = l * alpha + wave_sum(p); o0 *= alpha; o1 *= alpha; m = mn;
        const bf16* vp = Vbase + (size_t)k0 * vpitch + 2 * lane;
#pragma unroll 8
        for (int kk = 0; kk < 64; ++kk) { const float pk = __shfl(p, kk); const unsigned vv = *(const unsigned*)(vp + (size_t)kk * vpitch);
            o0 += pk * bf2f(vv & 0xffff); o1 += pk * bf2f(vv >> 16); }
    }
}
__device__ __forceinline__ void p3_naive(const Args& args, int layer, LAS unsigned char* lds) {
    const int tid_o = opaque_tid();
    LAS float* qs = (LAS float*)(lds + C_wave * 1024);
    const int gw = C_bid * NWAVES + C_wave, NGW = C_G * NWAVES, lane = C_lane;
    const float lam_init = 0.8f - 0.6f * expf(-0.3f * (float)layer);
    const float d1 = wave_sum(args.in[8][layer * 64 + lane] * args.in[9][layer * 64 + lane]), d2 = wave_sum(args.in[10][layer * 64 + lane] * args.in[11][layer * 64 + lane]);
    const float lam = expf(d1) - expf(d2) + lam_init;
    for (int u = gw; u < M * 16; u += NGW) {
        const int row = u >> 4, hh = u & 15, b = row >> 12, t = row & 4095; const size_t rb = (size_t)b * SEQ;
        float o0, o1, l;
        if (hh < 6) {
            const int h = hh; const bf16* q = WSP(bf16, WS_AQ) + (size_t)row * 768 + 128 * h;
            qs[lane] = bf2f(q[lane]) * 0.08838834764831845f; qs[lane + 64] = bf2f(q[lane + 64]) * 0.08838834764831845f; LDS_WAIT();
            const float* cum = WSP(float, WS_CUMT) + (size_t)(b * 6 + h) * SEQ;
            naive_map<0, 128>(qs, WSP(bf16, WS_AK) + rb * 768 + 128 * h, 768, WSP(bf16, WS_AV) + rb * 768 + 128 * h, 768, t + 1, t, cum, cum[t], nullptr, h, lane, o0, o1, l);
            bf16* g = WSP(bf16, WS_G) + (size_t)row * LDX + 128 * h + 2 * lane; const unsigned gv = *(const unsigned*)g; const float il = 1.0f / l;
            *(unsigned*)g = pk2(o0 * il * bf2f(gv & 0xffff), o1 * il * bf2f(gv >> 16));
        } else if (hh < 12) {
            const int h = hh - 6; const bf16* q = WSP(bf16, WS_QB) + (size_t)row * 1152 + 192 * h; const float sc = 0.07216878364870322f;
            qs[lane] = bf2f(q[lane]) * sc; qs[lane + 64] = bf2f(q[lane + 64]) * sc; qs[lane + 128] = bf2f(q[lane + 128]) * sc; LDS_WAIT();
            naive_map<1, 192>(qs, WSP(bf16, WS_KB) + rb * 1152 + 192 * h, 1152, WSP(bf16, WS_VB) + rb * 768 + 128 * h, 768, 64 * (t / 64 + 1), t, nullptr, 0.f, nullptr, h, lane, o0, o1, l);
            bf16* g = WSP(bf16, WS_G) + (size_t)row * LDX + 768 + 128 * h + 2 * lane; const unsigned gv = *(const unsigned*)g; const float il = 1.0f / l;
            *(unsigned*)g = pk2(o0 * il * bf2f(gv & 0xffff), o1 * il * bf2f(gv >> 16));
        } else {
            const int h = hh - 12; const bf16* q = WSP(bf16, WS_CQ2) + (size_t)row * 512 + 128 * h;
            qs[lane] = bf2f(q[lane]) * 0.125f; qs[lane + 64] = bf2f(q[lane + 64]) * 0.125f; LDS_WAIT();
            float p0, p1, pl;
            naive_map<2, 64>(qs, WSP(bf16, WS_CK2) + rb * 512 + 128 * h, 512, WSP(bf16, WS_CV) + rb * 512 + 128 * h, 512, 64 * (t / 64 + 1), t, nullptr, 0.f, args.in[13], h, lane, o0, o1, l);
            naive_map<2, 64>(qs + 64, WSP(bf16, WS_CK2) + rb * 512 + 128 * h + 64, 512, WSP(bf16, WS_CV) + rb * 512 + 128 * h, 512, 64 * (t / 64 + 1), t, nullptr, 0.f, args.in[13], h, lane, p0, p1, pl);
            const float il1 = 1.0f / l, il2 = lam / pl; const float c0 = o0 * il1 - p0 * il2, c1 = o1 * il1 - p1 * il2;
            const float ss = wave_sum(c0 * c0 + c1 * c1); const float r = rsqrtf(ss * (1.0f / 128.0f) + EPS) * (1.0f - lam_init);
            const float* sg = args.in[12] + layer * 128 + 2 * lane;
            bf16* g = WSP(bf16, WS_G) + (size_t)row * LDX + 1536 + 128 * h + 2 * lane; const unsigned gv = *(const unsigned*)g;
            *(unsigned*)g = pk2(c0 * r * sg[0] * bf2f(gv & 0xffff), c1 * r * sg[1] * bf2f(gv >> 16));
        }
        LDS_WAIT();
    }
}


namespace att {
typedef short s16x4 __attribute__((ext_vector_type(4)));
typedef float f32x16 __attribute__((ext_vector_type(16)));
typedef unsigned u32x4 __attribute__((ext_vector_type(4)));
constexpr int KVBLK = 64, SHM_V = 16384, SHM_K = 16384, SHM_KR = 8192;
constexpr int L_V = 0, L_K = 32768, L_KR = 65536, L_WS = 81920, L_KB = 83968, L_T5 = 84480, L_QR = 86016, L_FLAG = 118784, L_CMB = 0;
#define KSWZ(row, colB) ((row) * 256 + ((colB) ^ (((row) & 7) << 4)))
#define SBAR() __builtin_amdgcn_sched_barrier(0)
__device__ __forceinline__ int v_st(int k, int c) { const int kk = (k & ~0xC) | ((k & 4) << 1) | ((k & 8) >> 1); return ((kk >> 3) * 4 + (c >> 5)) * 512 + ((kk & 7) * 32 + (c & 31)) * 2; }
__device__ __forceinline__ int v_rd_base(int lane) { return ((lane & 3) << 3) | (((lane >> 2) & 3) << 6) | (((lane >> 4) & 1) << 5) | (((lane >> 5) & 1) << 8); }
constexpr int v_rd_off(int d0, int ks, int half) { return d0 * 512 + ks * 4096 + half * 2048; }
__device__ __forceinline__ int crow(int r, int hi) { return (r & 3) + 8 * (r >> 2) + 4 * hi; }
__device__ __forceinline__ unsigned cvtpk(float lo, float hi) { unsigned r; asm volatile("v_cvt_pk_bf16_f32 %0, %1, %2" : "=v"(r) : "v"(lo), "v"(hi)); return r; }

template <int VAR> struct VT;
template <> struct VT<0> { static constexpr float SCALE = 0.08838834764831845f; static constexpr int PQ = 768, PK = 768, PV = 768, NQ = 8, QROWS = 256; };
template <> struct VT<1> { static constexpr float SCALE = 0.07216878364870322f; static constexpr int PQ = 1152, PK = 1152, PV = 768, NQ = 8, QROWS = 256; };
template <> struct VT<2> { static constexpr float SCALE = 0.125f; static constexpr int PQ = 512, PK = 512, PV = 512, NQ = 4, QROWS = 128; };

__device__ __forceinline__ void mask_causal(f32x16& p0, f32x16& p1, int dq) {
    const float NEG = -__builtin_inff();
#pragma unroll
    for (int r = 0; r < 16; ++r) { const int c = (r & 3) + 8 * (r >> 2); if (dq - c < 0) p0[r] = NEG; if (dq - c - 32 < 0) p1[r] = NEG; }
}
template <int VAR>
__device__ __forceinline__ void partialSM(f32x16& p0, f32x16& p1, float& m_reg, float& mn, float& alpha) {
    constexpr float SCALE = VT<VAR>::SCALE, C2 = 1.4426950408889634f * SCALE, THR = 8.f;
    float pmax = p0[0];
#pragma unroll
    for (int r = 1; r < 16; ++r) pmax = fmaxf(pmax, p0[r]);
#pragma unroll
    for (int r = 0; r < 16; ++r) pmax = fmaxf(pmax, p1[r]);
    { auto rr = __builtin_amdgcn_permlane32_swap(__float_as_uint(pmax), __float_as_uint(pmax), false, false);
      pmax = fmaxf(__uint_as_float(rr[0]), __uint_as_float(rr[1])); }
    if (__builtin_expect(__all((pmax - m_reg) * SCALE <= THR), 1)) { mn = m_reg; alpha = 1.f; }
    else { mn = fmaxf(m_reg, pmax); alpha = __builtin_amdgcn_exp2f((m_reg - mn) * C2); m_reg = mn; }
    const float mnL = -mn * C2;
#pragma unroll
    for (int r = 0; r < 16; ++r) p0[r] = fmaf(p0[r], C2, mnL);
#pragma unroll
    for (int r = 0; r < 16; ++r) p1[r] = fmaf(p1[r], C2, mnL);
#pragma unroll
    for (int r = 0; r < 16; ++r) p0[r] = __builtin_amdgcn_exp2f(p0[r]);
}
__device__ __forceinline__ void finishSM(f32x16& p0, f32x16& p1, float alpha, float& l_reg, bf16x8& pa0, bf16x8& pa1, bf16x8& pa2, bf16x8& pa3) {
#pragma unroll
    for (int r = 0; r < 16; ++r) p1[r] = __builtin_amdgcn_exp2f(p1[r]);
    float ps = 0;
#pragma unroll
    for (int r = 0; r < 16; ++r) ps += p0[r];
#pragma unroll
    for (int r = 0; r < 16; ++r) ps += p1[r];
    { auto rr = __builtin_amdgcn_permlane32_swap(__float_as_uint(ps), __float_as_uint(ps), false, false);
      ps = __uint_as_float(rr[0]) + __uint_as_float(rr[1]); }
    l_reg = l_reg * alpha + ps;
#define PK4(P, B_, OUT) do { unsigned a0 = cvtpk(P[B_+0], P[B_+1]), a1 = cvtpk(P[B_+2], P[B_+3]);                          \
        unsigned b0 = cvtpk(P[B_+4], P[B_+5]), b1 = cvtpk(P[B_+6], P[B_+7]);                                             \
        auto r0 = __builtin_amdgcn_permlane32_swap(a0, b0, false, false); auto r1 = __builtin_amdgcn_permlane32_swap(a1, b1, false, false); \
        u32x4 w = {r0[0], r1[0], r0[1], r1[1]}; OUT = *reinterpret_cast<bf16x8*>(&w); } while (0)
    PK4(p0, 0, pa0); PK4(p0, 8, pa1); PK4(p1, 0, pa2); PK4(p1, 8, pa3);
#undef PK4
}
template <int VAR, int KB>
__device__ __forceinline__ void qkt(f32x16& p0, f32x16& p1, const LAS unsigned char* lds, int r32, int hi, int lane, int wid, int map, const bf16x8* qr) {
    if (VAR == 0) {
        const LAS float* kb = (const LAS float*)(lds + L_KB) + KB * 64 + 4 * hi;
#pragma unroll
        for (int g = 0; g < 4; ++g) { const f32x4 a = *(const LAS f32x4*)(kb + 8 * g), b = *(const LAS f32x4*)(kb + 32 + 8 * g);
            p0[4 * g] = a[0]; p0[4 * g + 1] = a[1]; p0[4 * g + 2] = a[2]; p0[4 * g + 3] = a[3]; p1[4 * g] = b[0]; p1[4 * g + 1] = b[1]; p1[4 * g + 2] = b[2]; p1[4 * g + 3] = b[3]; }
    } else { p0 = f32x16{}; p1 = f32x16{}; }
    const LAS unsigned char* kbp[4];
#pragma unroll
    for (int dd = 0; dd < 4; ++dd) kbp[dd] = lds + L_K + KB * SHM_K + KSWZ(r32, (dd * 16 + hi * 8) * 2) + (VAR == 2 ? map * 128 : 0);
#pragma unroll
    for (int d0 = 0; d0 < VT<VAR>::NQ; ++d0) { const LAS unsigned char* a = kbp[d0 & 3] + (d0 >> 2) * 128;
        const bf16x8 b0 = *(const LAS bf16x8*)a, b1 = *(const LAS bf16x8*)(a + 32 * 256);
        p0 = __builtin_amdgcn_mfma_f32_32x32x16_bf16(b0, qr[d0], p0, 0, 0, 0);
        p1 = __builtin_amdgcn_mfma_f32_32x32x16_bf16(b1, qr[d0], p1, 0, 0, 0); }
    if (VAR == 1) {
        const int s = (r32 >> 1) & 7;
#pragma unroll
        for (int d0 = 0; d0 < 4; ++d0) { const LAS unsigned char* a = lds + L_KR + KB * SHM_KR + r32 * 128 + (((2 * d0 + hi) ^ s) << 4);
            const bf16x8 b0 = *(const LAS bf16x8*)a, b1 = *(const LAS bf16x8*)(a + 32 * 128);
            const bf16x8 q = *(const LAS bf16x8*)(lds + L_QR + wid * 4096 + d0 * 1024 + lane * 16);
            p0 = __builtin_amdgcn_mfma_f32_32x32x16_bf16(b0, q, p0, 0, 0, 0);
            p1 = __builtin_amdgcn_mfma_f32_32x32x16_bf16(b1, q, p1, 0, 0, 0); }
    }
}
template <int VB>
__device__ __forceinline__ void pv_tile(f32x16* o, int vb0, bf16x8 pa0, bf16x8 pa1, bf16x8 pa2, bf16x8 pa3) {
#define TRRD(dst, off) asm volatile("ds_read_b64_tr_b16 %0, %1 offset:%2" : "=&v"(dst) : "v"(vb0), "i"(off) : "memory")
#define PV_D0(d0) do { s16x4 l0, l1, l2, l3, h0, h1, h2, h3; constexpr int b_ = VB * SHM_V + v_rd_off(d0, 0, 0); \
        TRRD(l0, b_); TRRD(h0, b_ + 2048); TRRD(l1, b_ + 4096); TRRD(h1, b_ + 6144); TRRD(l2, b_ + 8192); TRRD(h2, b_ + 10240); TRRD(l3, b_ + 12288); TRRD(h3, b_ + 14336); \
        asm volatile("s_waitcnt lgkmcnt(0)" ::: "memory"); SBAR();   \
        o[d0] = __builtin_amdgcn_mfma_f32_32x32x16_bf16(pa0, (bf16x8){l0[0], l0[1], l0[2], l0[3], h0[0], h0[1], h0[2], h0[3]}, o[d0], 0, 0, 0);   \
        o[d0] = __builtin_amdgcn_mfma_f32_32x32x16_bf16(pa1, (bf16x8){l1[0], l1[1], l1[2], l1[3], h1[0], h1[1], h1[2], h1[3]}, o[d0], 0, 0, 0);   \
        o[d0] = __builtin_amdgcn_mfma_f32_32x32x16_bf16(pa2, (bf16x8){l2[0], l2[1], l2[2], l2[3], h2[0], h2[1], h2[2], h2[3]}, o[d0], 0, 0, 0);   \
        o[d0] = __builtin_amdgcn_mfma_f32_32x32x16_bf16(pa3, (bf16x8){l3[0], l3[1], l3[2], l3[3], h3[0], h3[1], h3[2], h3[3]}, o[d0], 0, 0, 0); } while (0)
    PV_D0(0); PV_D0(1); PV_D0(2); PV_D0(3);
#undef PV_D0
#undef TRRD
}

template <int VAR>
__device__ __forceinline__ void attn_unit(unsigned char* ws, const float* relb, const float* subg, float lam, float lam1m, int b, int h, int qb, LAS unsigned char* lds) {
    typedef VT<VAR> T; constexpr float SCALE = T::SCALE;
    int tid_ = threadIdx.x; asm volatile("" : "+v"(tid_));
    const int tid = tid_, wid = __builtin_amdgcn_readfirstlane(tid >> 6), lane = tid & 63, r32 = lane & 31, hi = lane >> 5;
    const int wq = VAR == 2 ? (wid & 3) : wid, map = VAR == 2 ? (wid >> 2) : 0;
    const int P0 = qb * T::QROWS, qlo = P0 + wq * 32, NT = (P0 + T::QROWS) / KVBLK;
    const size_t rowb = (size_t)b * SEQ;
    const bf16* Qp; const bf16* Kp; const bf16* Vp; int gcol;
    if (VAR == 0) { Qp = (const bf16*)(ws + WS_AQ) + (rowb + qlo + r32) * 768 + 128 * h; Kp = (const bf16*)(ws + WS_AK) + rowb * 768 + 128 * h; Vp = (const bf16*)(ws + WS_AV) + rowb * 768 + 128 * h; gcol = 128 * h; }
    else if (VAR == 1) { Qp = (const bf16*)(ws + WS_QB) + (rowb + qlo + r32) * 1152 + 192 * h; Kp = (const bf16*)(ws + WS_KB) + rowb * 1152 + 192 * h; Vp = (const bf16*)(ws + WS_VB) + rowb * 768 + 128 * h; gcol = 768 + 128 * h; }
    else { Qp = (const bf16*)(ws + WS_CQ2) + (rowb + qlo + r32) * 512 + 128 * h + 64 * map; Kp = (const bf16*)(ws + WS_CK2) + rowb * 512 + 128 * h; Vp = (const bf16*)(ws + WS_CV) + rowb * 512 + 128 * h; gcol = 1536 + 128 * h; }
    const float* cum = (const float*)(ws + WS_CUMT) + (size_t)(b * 6 + h) * SEQ;
    LAS unsigned char* V_lds = lds + L_V; LAS unsigned char* K_lds = lds + L_K;
    LAS float* wsf = (LAS float*)(lds + L_WS) + wid * 64; LAS float* li_l = wsf; LAS float* al_l = wsf + 32;
    float m_reg = -1e30f, l_reg = 0; f32x16 o[4] = {};
    const int sr = tid >> 4, sc = (tid & 15) * 8, vst0 = v_st(sr, sc), vst1 = v_st(32 + sr, sc), kws = KSWZ(sr, sc * 2);
    const int krr = tid >> 3, krc = tid & 7, krw = krr * 128 + ((krc ^ ((krr >> 1) & 7)) << 4);
    const int vb0 = (int)(uintptr_t)V_lds + v_rd_base(lane);
    bf16x8 qr[T::NQ];
#pragma unroll
    for (int d0 = 0; d0 < T::NQ; ++d0) qr[d0] = *(const bf16x8*)(Qp + d0 * 16 + hi * 8);
    if (VAR == 1) {
#pragma unroll
        for (int d0 = 0; d0 < 4; ++d0) *(LAS bf16x8*)(lds + L_QR + wid * 4096 + d0 * 1024 + lane * 16) = *(const bf16x8*)(Qp + 128 + d0 * 16 + hi * 8);
    }
    if (VAR == 2) { if (tid < 320) { const int rel = tid - 255; ((LAS float*)(lds + L_T5))[tid] = relb[t5_bucket(rel) * 4 + h] * (1.0f / SCALE); } }
    bf16x8 st_v0, st_v1, st_k0, st_k1, st_kr; float st_kb = 0.f;
#define ROWP(p, pitch, k0, rr) ((p) + (size_t)((k0) + (rr)) * (pitch) + sc)
#define VMW() asm volatile("s_waitcnt vmcnt(0)" ::: "memory")
#define SLOAD(k0) do { st_v0 = *(const bf16x8*)ROWP(Vp, T::PV, k0, sr); st_v1 = *(const bf16x8*)ROWP(Vp, T::PV, k0, 32 + sr);              \
                       st_k0 = *(const bf16x8*)ROWP(Kp, T::PK, k0, sr); st_k1 = *(const bf16x8*)ROWP(Kp, T::PK, k0, 32 + sr);              \
                       if (VAR == 1) st_kr = *(const bf16x8*)(Kp + (size_t)((k0) + krr) * 1152 + 128 + krc * 8);                            \
                       if (VAR == 0) { if (tid < 64) st_kb = cum[(k0) + tid]; } } while (0)
#define SWRITE(bf) do { *(LAS bf16x8*)(V_lds + (bf) * SHM_V + vst0) = st_v0; *(LAS bf16x8*)(V_lds + (bf) * SHM_V + vst1) = st_v1;         \
                        *(LAS bf16x8*)(K_lds + (bf) * SHM_K + kws) = st_k0; *(LAS bf16x8*)(K_lds + (bf) * SHM_K + kws + 32 * 256) = st_k1; \
                        if (VAR == 1) *(LAS bf16x8*)(lds + L_KR + (bf) * SHM_KR + krw) = st_kr;                                             \
                        if (VAR == 0) { if (tid < 64) ((LAS float*)(lds + L_KB))[(bf) * 64 + tid] = -st_kb * (1.0f / SCALE); } } while (0)
#define RESC(a) do { if (__any((a) < 1.f)) { if (hi == 0) al_l[r32] = (a); asm volatile("s_waitcnt lgkmcnt(0)" ::: "memory");              \
                     _Pragma("unroll") for (int d_ = 0; d_ < 4; ++d_) _Pragma("unroll") for (int r = 0; r < 16; ++r) o[d_][r] *= al_l[crow(r, hi)]; } } while (0)
#define KBASE(t) ((t) * KVBLK)
    const int qm = qlo + r32 - 4 * hi;
    const int t5b = (-qlo - r32 + 4 * hi + 255) * 4;
    const float b15 = VAR == 2 ? relb[15 * 4 + h] * (1.0f / SCALE) : 0.f;
#define MODIFY(P0_, P1_, t) do { const int kb_ = KBASE(t);                                                                               \
        if (VAR == 0) { if (kb_ + KVBLK - 1 > qlo) mask_causal(P0_, P1_, qm - kb_); }                                                   \
        else { if (kb_ > (qlo & ~63)) { _Pragma("unroll") for (int r = 0; r < 16; ++r) { P0_[r] = -__builtin_inff(); P1_[r] = -__builtin_inff(); } }   \
               else if (VAR == 2) { if (kb_ + 63 - qlo > -91) { const LAS unsigned char* tp = lds + L_T5 + t5b + kb_ * 4;                               \
                       _Pragma("unroll") for (int r = 0; r < 16; ++r) { const int c = (r & 3) + 8 * (r >> 2); P0_[r] += *(const LAS float*)(tp + c * 4); P1_[r] += *(const LAS float*)(tp + (c + 32) * 4); } } \
                   else { _Pragma("unroll") for (int r = 0; r < 16; ++r) { P0_[r] += b15; P1_[r] += b15; } } } } } while (0)
    f32x16 pA0, pA1, pB0, pB1; float mnA, mnB, alA, alB; bf16x8 pa0, pa1, pa2, pa3;
    SLOAD(0); VMW(); SWRITE(0);
    __syncthreads();
    SLOAD(KBASE(1));
    SBAR(); qkt<VAR, 0>(pA0, pA1, lds, r32, hi, lane, wid, map, qr);
    MODIFY(pA0, pA1, 0); partialSM<VAR>(pA0, pA1, m_reg, mnA, alA);
    VMW(); SWRITE(1);
    __syncthreads();
#define HALF_STEP(PX0, PX1, mnX, alX, PY0, PY1, alY, t, KB, VB, SB) do {                                                      \
        SBAR(); qkt<VAR, KB>(PX0, PX1, lds, r32, hi, lane, wid, map, qr);                                                     \
        finishSM(PY0, PY1, alY, l_reg, pa0, pa1, pa2, pa3); SBAR();                                                           \
        SLOAD(KBASE((t) + 1)); SBAR();                                                                                        \
        pv_tile<VB>(o, vb0, pa0, pa1, pa2, pa3); MODIFY(PX0, PX1, (t)); partialSM<VAR>(PX0, PX1, m_reg, mnX, alX);            \
        __syncthreads();                                                                                                      \
        VMW(); SWRITE(SB);                                                                                                    \
        RESC(alX); __syncthreads(); } while (0)
    for (int t = 1; t + 1 < NT; t += 2) {
        HALF_STEP(pB0, pB1, mnB, alB, pA0, pA1, alA, t, 1, 0, 0);
        HALF_STEP(pA0, pA1, mnA, alA, pB0, pB1, alB, t + 1, 0, 1, 1);
    }
    SBAR(); qkt<VAR, 1>(pB0, pB1, lds, r32, hi, lane, wid, map, qr); SBAR();
    finishSM(pA0, pA1, alA, l_reg, pa0, pa1, pa2, pa3); SBAR();
    pv_tile<0>(o, vb0, pa0, pa1, pa2, pa3);
    MODIFY(pB0, pB1, NT - 1); partialSM<VAR>(pB0, pB1, m_reg, mnB, alB); __syncthreads(); RESC(alB);
    finishSM(pB0, pB1, alB, l_reg, pa0, pa1, pa2, pa3); SBAR(); pv_tile<1>(o, vb0, pa0, pa1, pa2, pa3);
    if (hi == 0) li_l[r32] = l_reg; asm volatile("s_waitcnt lgkmcnt(0)" ::: "memory");
    float rli[16];
#pragma unroll
    for (int r = 0; r < 16; ++r) rli[r] = __builtin_amdgcn_rcpf(li_l[crow(r, hi)]);
    bf16* Gw = (bf16*)(ws + WS_G) + (rowb + qlo) * LDX + gcol;
    if (VAR != 2) {
#pragma unroll
        for (int r = 0; r < 16; ++r) { const int orow = crow(r, hi);
#pragma unroll
            for (int d0 = 0; d0 < 4; ++d0) { const float v = o[d0][r] * rli[r]; const float vn = __shfl_xor(v, 1);
                if ((r32 & 1) == 0) { unsigned* gp = (unsigned*)(Gw + (size_t)orow * LDX + d0 * 32 + r32); const unsigned gv = *gp;
                    *gp = cvtpk(v * bf2f(gv & 0xffff), vn * bf2f(gv >> 16)); } } }
        __syncthreads();
    } else {
        LAS float* cmb = (LAS float*)(lds + L_CMB) + wq * 4096;
        __syncthreads();
        if (map == 1) {
#pragma unroll
            for (int r = 0; r < 16; ++r) { const int orow = crow(r, hi); const float f = rli[r] * lam;
#pragma unroll
                for (int d0 = 0; d0 < 4; ++d0) cmb[orow * 128 + d0 * 32 + r32] = o[d0][r] * f; }
        }
        __syncthreads();
        if (map == 0) {
            float sg[4];
#pragma unroll
            for (int d0 = 0; d0 < 4; ++d0) sg[d0] = subg[d0 * 32 + r32];
#pragma unroll
            for (int r = 0; r < 16; ++r) { const int orow = crow(r, hi); float c[4]; float s = 0.f;
#pragma unroll
                for (int d0 = 0; d0 < 4; ++d0) { c[d0] = o[d0][r] * rli[r] - cmb[orow * 128 + d0 * 32 + r32]; s += c[d0] * c[d0]; }
#pragma unroll
                for (int x = 1; x < 32; x <<= 1) s += __shfl_xor(s, x);
                const float rn = rsqrtf(s * (1.0f / 128.0f) + EPS) * lam1m;
#pragma unroll
                for (int d0 = 0; d0 < 4; ++d0) { const float v = c[d0] * rn * sg[d0]; const float vn = __shfl_xor(v, 1);
                    if ((r32 & 1) == 0) { unsigned* gp = (unsigned*)(Gw + (size_t)orow * LDX + d0 * 32 + r32); const unsigned gv = *gp;
                        *gp = cvtpk(v * bf2f(gv & 0xffff), vn * bf2f(gv >> 16)); } } }
        }
        __syncthreads();
    }
#undef ROWP
#undef VMW
#undef SLOAD
#undef SWRITE
#undef RESC
#undef KBASE
#undef MODIFY
#undef HALF_STEP
}

struct OrderTab { unsigned short v[1280]; };
constexpr OrderTab make_order() {
    OrderTab t{}; int n = 0;
    for (int c = 320; c >= 1; --c) {
        if (c % 20 == 0 && c / 20 <= 16) { const int qb = c / 20 - 1; for (int bh = 0; bh < 24; ++bh) t.v[n++] = (unsigned short)(1 | (qb << 2) | (bh << 7)); }
        if (c % 16 == 0 && c / 16 <= 16) { const int qb = c / 16 - 1; for (int bh = 0; bh < 24; ++bh) t.v[n++] = (unsigned short)(0 | (qb << 2) | (bh << 7)); }
        if (c % 7 == 0 && c / 7 <= 32) { const int qb = c / 7 - 1; for (int bh = 0; bh < 16; ++bh) t.v[n++] = (unsigned short)(2 | (qb << 2) | (bh << 7)); }
    }
    return t;
}
__device__ const OrderTab g_order = make_order();
static_assert(make_order().v[1279] != 0 || true, "order table");
}

__device__ __forceinline__ void p3_attention(const Args& args, int layer, LAS unsigned char* lds) {
    const int tid_o = opaque_tid(); const int lane = tid_o & 63;
    const float lam_init = 0.8f - 0.6f * expf(-0.3f * (float)layer);
    const float d1 = wave_sum(args.in[8][layer * 64 + lane] * args.in[9][layer * 64 + lane]), d2 = wave_sum(args.in[10][layer * 64 + lane] * args.in[11][layer * 64 + lane]);
    const float lam = expf(d1) - expf(d2) + lam_init;
    unsigned* ctr = (unsigned*)(args.ws + WS_CTL) + 64 * (1 + layer);
    volatile LAS unsigned* flag = (volatile LAS unsigned*)(lds + att::L_FLAG);
    for (;;) {
        if (tid_o == 0) flag[0] = atomicAdd(ctr, 1u);
        __syncthreads();
        const unsigned idx = flag[0];
        if (idx >= 1280u) break;
        const unsigned code = att::g_order.v[idx]; const int type = code & 3, qb = (code >> 2) & 31, bh = code >> 7;
        if (type == 0) att::attn_unit<0>(args.ws, args.in[13], args.in[12] + layer * 128, lam, 1.0f - lam_init, bh / 6, bh % 6, qb, lds);
        else if (type == 1) att::attn_unit<1>(args.ws, args.in[13], args.in[12] + layer * 128, lam, 1.0f - lam_init, bh / 6, bh % 6, qb, lds);
        else att::attn_unit<2>(args.ws, args.in[13], args.in[12] + layer * 128, lam, 1.0f - lam_init, bh >> 2, bh & 3, qb, lds);
    }
    __syncthreads();
}

__device__ __forceinline__ void p5_final(const Args& args) {
    const int tid_o = opaque_tid();
    const int gw = C_bid * NWAVES + C_wave, NGW = C_G * NWAVES, lane = C_lane;
    for (int m = gw; m < M; m += NGW) {
        float s = lane < 32 ? WSP(float, WS_XSS)[(size_t)m * 32 + lane] : 0.f; s = wave_sum(s);
        const float r = rsqrtf(s * (1.0f / 2048.0f) + EPS);
        f32x4* xr = (f32x4*)(args.out + (size_t)m * DM) + lane; const f32x4* gr = (const f32x4*)args.in[15] + lane;
#pragma unroll
        for (int j = 0; j < 8; ++j) { const f32x4 v = xr[64 * j], g = gr[64 * j]; xr[64 * j] = v * r * g; }
    }
}

typedef GAS unsigned gu32;
#define RLX_AGENT __ATOMIC_RELAXED, __HIP_MEMORY_SCOPE_AGENT
constexpr int CW_BAR = 4096;
constexpr int LDS_BARST = RING_BYTES;
#define XB_TMO      128
#define XB_XCNT(j)  (256  + 64 * (j))
#define XB_XSUB(j)  (1280 + 64 * (j))
#define XB_XGEN(j)  (2304 + 64 * (j))
#define XB_TOP      3328
#define XB_TOPGEN   3392
#define XCD_BAR_WORDS 3456
#define XB_SPIN_CAP (1u << 18)

__device__ __forceinline__ unsigned xb_ld(unsigned* p)              { return __hip_atomic_load(p, __ATOMIC_RELAXED, __HIP_MEMORY_SCOPE_AGENT); }
__device__ __forceinline__ unsigned xb_add(unsigned* p, unsigned v) { return __hip_atomic_fetch_add(p, v, __ATOMIC_RELAXED, __HIP_MEMORY_SCOPE_AGENT); }
__device__ __forceinline__ unsigned xb_xcc_id() { return (unsigned)__builtin_amdgcn_s_getreg((3 << 11) | 20) & 0xFu; }
#define XB_SPIN(cond, bar) do { unsigned _sp = 0; while (cond) { __builtin_amdgcn_s_sleep(1); \
    if ((++_sp & 255u) == 0u) { if (xb_ld(&(bar)[XB_TMO])) break; if (_sp > XB_SPIN_CAP) { atomicAdd(&(bar)[XB_TMO], 1u); break; } } } } while (0)

struct XcdBarrier {
    unsigned* bar; unsigned x;
    volatile LAS unsigned* st;
};

__device__ __forceinline__ XcdBarrier xcd_barrier_post(unsigned* bar, volatile LAS unsigned* st) {
    XcdBarrier b; b.bar = bar; b.x = xb_xcc_id(); b.st = st;
    if (threadIdx.x == 0) (void)xb_add(&bar[XB_XCNT(b.x)], 1u);
    return b;
}
__device__ __forceinline__ void xcd_barrier_complete(unsigned* bar, unsigned x, unsigned& nloc, unsigned& nx) {
    const unsigned G = gridDim.x * gridDim.y * gridDim.z;
    unsigned sum, cnt, mine, sp = 0u;
    for (;;) {
        sum = 0u; cnt = 0u; mine = 0u;
#pragma unroll
        for (unsigned j = 0; j < 16; ++j) { const unsigned c = xb_ld(&bar[XB_XCNT(j)]); sum += c; cnt += (c > 0u) ? 1u : 0u; mine = (j == x) ? c : mine; }
        if (sum == G) break;
        __builtin_amdgcn_s_sleep(1);
        if ((++sp & 255u) == 0u) { if (xb_ld(&bar[XB_TMO])) break; if (sp > XB_SPIN_CAP) { atomicAdd(&bar[XB_TMO], 1u); break; } }
    }
    nloc = mine > 0u ? mine : 1u; nx = cnt > 0u ? cnt : 1u;
}

__device__ __forceinline__ void xcd_barrier(const XcdBarrier& b) {
    asm volatile("s_waitcnt vmcnt(0)" ::: "memory");
    __syncthreads();
    if (threadIdx.x == 0) {
        unsigned* bar = b.bar;
        __builtin_amdgcn_s_waitcnt(0);
        unsigned nloc = b.st[0], nx = b.st[1];
        if (nloc == 0u) { xcd_barrier_complete(bar, b.x, nloc, nx); b.st[0] = nloc; b.st[1] = nx; }
        const unsigned old = xb_add(&bar[XB_XSUB(b.x)], 1u);
        const unsigned gen = old / nloc;
        if (old + 1u == (gen + 1u) * nloc) {
            __builtin_amdgcn_fence(__ATOMIC_RELEASE, "agent");
            asm volatile("s_waitcnt vmcnt(0)" ::: "memory");
            const unsigned og = xb_add(&bar[XB_TOP], 1u);
            const unsigned tg = og / nx;
            if (og + 1u == (tg + 1u) * nx) xb_add(&bar[XB_TOPGEN], 1u);
            else XB_SPIN(xb_ld(&bar[XB_TOPGEN]) == tg, bar);
            __builtin_amdgcn_fence(__ATOMIC_ACQUIRE, "agent");
            xb_add(&bar[XB_XGEN(b.x)], 1u);
            asm volatile("s_waitcnt vmcnt(0)" ::: "memory");
        } else {
            XB_SPIN(xb_ld(&bar[XB_XGEN(b.x)]) == gen, bar);
            __builtin_amdgcn_fence(__ATOMIC_ACQUIRE, "agent");
            asm volatile("s_waitcnt vmcnt(0)" ::: "memory");
        }
    }
    __syncthreads();
}

#ifndef PROBE_REP1
#define PROBE_REP1 0
#endif
#ifndef PROBE_REP4
#define PROBE_REP4 0
#endif
#ifndef MK_NAIVE_ATTN
#define MK_NAIVE_ATTN 0
#endif
#ifndef MK_FUSED
#define MK_FUSED 1
#endif
constexpr int N_PHASES = 10;

__global__ void __launch_bounds__(NTHREADS, 2) fwd_kernel(Args args) {
    extern __shared__ __attribute__((aligned(16))) unsigned char lds_raw[];
    LAS unsigned char* lds = (LAS unsigned char*)lds_raw;
    const int lo = args.ph_lo, hi = args.ph_hi;
#if MK_FUSED
    if (threadIdx.x < 4) ((LAS unsigned*)(lds + LDS_BARST))[threadIdx.x] = 0u;
    __syncthreads();
    XcdBarrier bar = xcd_barrier_post((unsigned*)(args.ws + WS_CTL) + CW_BAR, (volatile LAS unsigned*)(lds + LDS_BARST));
#endif
#ifndef PH_MASK
#define PH_MASK 0x3ff
#endif
#define IN(k) (((PH_MASK >> ((k) > 4 ? (k) - 4 : (k))) & 1) && lo <= (k) && (k) < hi)
#if MK_FUSED
#define SEAM(k) do { if (IN(k) && IN((k) + 1)) { if ((k) == 0) cg::this_grid().sync(); else xcd_barrier(bar); } } while (0)
#else
#define SEAM(k) do { } while (0)
#endif
    if (IN(0)) { p0_prologue(args, lds); __syncthreads(); }
    SEAM(0);
#pragma unroll 1
    for (int l = 0; l < DEPTH; ++l) {
        const int pb = 1 + 4 * l;
        if (IN(pb)) {
            pg8::Gemm g{WSP(bf16, WS_XB), (const bf16*)(args.ws + WS_WIN + (size_t)l * WIN_BYTES), M, NIN_PAD, DM, LDX, LDX}; pg8::StaticOrder S; S.init(M, NIN_PAD, C_G, C_bid);
            pg8::EpiIn E{args.ws, args.in[3] + l * 6};
            pg8::gemm_phase<pg8::EpiIn, pg8::StaticOrder, true, true>(lds, g, S, E);
#if PROBE_REP1
            if (l == 0) { __syncthreads(); pg8::gemm_phase<pg8::EpiIn, pg8::StaticOrder, true, true>(lds, g, S, E); }
#endif
        }
        SEAM(pb);
        if (IN(pb + 1)) {
            p2_scan(args);
            { pg8::Gemm g{WSP(bf16, WS_CQ), WSP(bf16, WS_WUQ) + (size_t)l * NUQ_PAD * 512, M, NUQ_PAD, 512, 512, 512}; pg8::StaticOrder S; S.init(M, NUQ_PAD, C_G, C_bid);
              pg8::EpiUq E{args.ws};
              pg8::gemm_phase<pg8::EpiUq, pg8::StaticOrder, true, true>(lds, g, S, E); }
            { pg8::Gemm g{WSP(bf16, WS_CKV), WSP(bf16, WS_WUKV) + (size_t)l * NUKV * 256, M, NUKV, 256, 256, 256}; pg8::StaticOrder S; S.init(M, NUKV, C_G, (C_bid + 128) % C_G);
              pg8::EpiUkv E{args.ws};
              pg8::gemm_phase<pg8::EpiUkv, pg8::StaticOrder, true, true>(lds, g, S, E); }
        }
        SEAM(pb + 1);
        if (IN(pb + 2)) {
#if MK_NAIVE_ATTN
            p3_naive(args, l, lds); __syncthreads();
#else
            p3_attention(args, l, lds);
#endif
        }
        SEAM(pb + 2);
        if (IN(pb + 3)) {
            pg8::Gemm g{WSP(bf16, WS_G), (const bf16*)(args.ws + WS_WOUT + (size_t)l * WOUT_BYTES), M, DM, DM, LDX, LDX}; pg8::StaticOrder S; S.init(M, DM, C_G, C_bid);
            pg8::EpiOut E{l == 0 ? args.in[0] : args.out, args.out, args.ws};
            pg8::gemm_phase<pg8::EpiOut, pg8::StaticOrder, true, true>(lds, g, S, E);
#if PROBE_REP4
            if (l == 0) { __syncthreads(); pg8::gemm_phase<pg8::EpiOut, pg8::StaticOrder, true, true>(lds, g, S, E); }
#endif
        }
        SEAM(pb + 3);
    }
    if (IN(9)) p5_final(args);
#undef IN
#undef SEAM
}

extern "C" void kernel_launch(void* const* d_in, const int* in_sizes, int n_in, void* d_out, int out_size, void* d_ws, size_t ws_size, hipStream_t stream) {
    static int grid = 0;
    if (grid == 0) {
        if (n_in != 16 || in_sizes[0] != M * DM || out_size != M * DM || ws_size < WS_END) {
            fprintf(stderr, "kernel_launch: unexpected shapes (n_in %d, in0 %d, out %d, ws %zu; need ws >= %zu)\n", n_in, n_in > 0 ? in_sizes[0] : -1, out_size, ws_size, (size_t)WS_END); grid = -1; return; }
        int dev = 0, cus = 0, per_cu = 0;
        if (hipGetDevice(&dev) != hipSuccess || hipDeviceGetAttribute(&cus, hipDeviceAttributeMultiprocessorCount, dev) != hipSuccess) { fprintf(stderr, "kernel_launch: device query failed\n"); grid = -1; return; }
        if (hipFuncSetAttribute((const void*)fwd_kernel, hipFuncAttributeMaxDynamicSharedMemorySize, LDS_BYTES) != hipSuccess) { fprintf(stderr, "kernel_launch: hipFuncSetAttribute failed\n"); grid = -1; return; }
        if (hipOccupancyMaxActiveBlocksPerMultiprocessor(&per_cu, (const void*)fwd_kernel, NTHREADS, LDS_BYTES) != hipSuccess || per_cu < 1) {
            fprintf(stderr, "kernel_launch: occupancy query reports %d blocks per CU\n", per_cu); (void)hipGetLastError(); grid = -1; return; }
        grid = cus;
    }
    if (grid < 0) return;
    if (hipMemsetAsync((char*)d_ws + WS_CTL, 0, 65536, stream) != hipSuccess) { fprintf(stderr, "kernel_launch: memset failed\n"); return; }
    Args a{};
    for (int i = 0; i < 16; ++i) a.in[i] = (const float*)d_in[i];
    a.out = (float*)d_out; a.ws = (unsigned char*)d_ws;
#if MK_FUSED
    a.ph_lo = 0; a.ph_hi = N_PHASES;
    void* kargs[] = {&a};
    hipError_t e = hipLaunchCooperativeKernel((const void*)fwd_kernel, dim3(grid), dim3(NTHREADS), kargs, LDS_BYTES, stream);
    if (e != hipSuccess) fprintf(stderr, "kernel_launch: cooperative launch failed: %s (grid %d)\n", hipGetErrorString(e), grid);
#else
    for (int p = 0; p < N_PHASES; ++p) {
        a.ph_lo = p; a.ph_hi = p + 1;
        hipLaunchKernelGGL(fwd_kernel, dim3(grid), dim3(NTHREADS), LDS_BYTES, stream, a);
    }
#endif
}
```

```cpp
#include <hip/hip_runtime.h>
#include <hip/hip_cooperative_groups.h>
#include <cstdio>
#include <cstdint>
#include <cmath>
namespace cg = cooperative_groups;

constexpr int NB = 4, SEQ = 4096, DM = 2048, M = NB * SEQ, DEPTH = 2;
constexpr int NIN = 6726, NIN_PAD = 6912;
constexpr int NUQ_PAD = 1280, NUKV = 1536;
constexpr int LDX = 2112;
constexpr float EPS = 1e-6f;

constexpr size_t MiB = 1u << 20;
constexpr size_t WIN_BYTES = 28 * MiB, WOUT_BYTES = 9 * MiB;
constexpr size_t WS_CTL = 0, CTL_ZERO_BYTES = 1 * MiB;
constexpr size_t WS_WIN = 1 * MiB;
constexpr size_t WS_WUQ = WS_WIN + 56 * MiB;
constexpr size_t WS_WUKV = WS_WUQ + 5 * MiB / 2;
constexpr size_t WS_WOUT = WS_WUKV + 3 * MiB / 2;
constexpr size_t WS_ROPE = WS_WOUT + 18 * MiB;
constexpr size_t WS_XSS = WS_ROPE + 1 * MiB;
constexpr size_t WS_LOGF = WS_XSS + 2 * MiB;
constexpr size_t WS_CUMT = WS_LOGF + MiB / 2;
constexpr size_t WS_CQSS = WS_CUMT + MiB / 2;
constexpr size_t WS_CKVSS = WS_CQSS + MiB / 2;
constexpr size_t WS_XB = WS_CKVSS + MiB / 2;
constexpr size_t WS_G = WS_XB + 66 * MiB;
constexpr size_t WS_AQ = WS_G + 66 * MiB, WS_AK = WS_AQ + 24 * MiB, WS_AV = WS_AK + 24 * MiB;
constexpr size_t WS_CQ = WS_AV + 24 * MiB;
constexpr size_t WS_CKV = WS_CQ + 16 * MiB;
constexpr size_t WS_QB = WS_CKV + 8 * MiB, WS_KB = WS_QB + 36 * MiB, WS_VB = WS_KB + 36 * MiB;
constexpr size_t WS_CQ2 = WS_VB + 24 * MiB, WS_CK2 = WS_CQ2 + 16 * MiB, WS_CV = WS_CK2 + 16 * MiB;
constexpr size_t WS_END = WS_CV + 16 * MiB;
static_assert(WS_END <= 512 * MiB, "workspace map");

constexpr int RING_BYTES = 131072, LDS_BYTES = 147456;
constexpr int NWAVES = 8, NTHREADS = 512;

namespace pg8 {
#define PG8_LAS __attribute__((address_space(3)))
typedef unsigned short bf16_t;
typedef short bf16x8 __attribute__((ext_vector_type(8)));
typedef float f32x4 __attribute__((ext_vector_type(4)));
typedef unsigned u32x4 __attribute__((ext_vector_type(4)));
constexpr int BM = 256, BK = 64, HALF = 128, HTB = HALF * BK * 2  , STAGE_BYTES = 8 * HTB, NXCD = 8, WGM = 8;

__host__ __device__ __forceinline__ int lds_byte(int r, int c) { const int st = (r >> 4) * 2 + (c >> 5), rr = r & 15, cc = c & 31, ob = rr * 64 + cc * 2; return st * 1024 + (ob ^ (((ob >> 9) & 1) << 5)); }
__host__ __device__ __forceinline__ void stage_rc(int b, int& R, int& C) { const int st = b / 1024, sb = b % 1024, swz = sb ^ (((sb >> 9) & 1) << 5); R = (st >> 1) * 16 + swz / 64; C = (st & 1) * 32 + (swz % 64) / 2; }
__host__ __device__ __forceinline__ int perm32(int rho) { const int n = rho >> 4, i = rho & 15; return 8 * (i >> 2) + 4 * n + (i & 3); }

struct Unit { int pm, pn; };
struct Gemm { const bf16_t* A; const bf16_t* Bt; int M, N, K, lda, ldb; };

struct StaticOrder {
    int nM, nN, nwg, G, c;
    __host__ __device__ void init(int M, int N, int G_, int c_) { nM = M / BM; nN = N / BM; nwg = nM * nN; G = G_; c = c_; }
    __host__ __device__ bool next(int i, Unit& u) const {
        const long L = (long)i * G + c; if (L >= nwg) return false;
        int wgid = (int)L; { const int q = nwg / NXCD, r = nwg % NXCD, xcd = wgid % NXCD, off = wgid / NXCD; wgid = (xcd < r ? xcd * (q + 1) : r * (q + 1) + (xcd - r) * q) + off; }
        const int nig = WGM * nN, gid = wgid / nig, fm = gid * WGM, gsz = (nM - fm) < WGM ? (nM - fm) : WGM;
        u.pm = fm + ((wgid % nig) % gsz); u.pn = (wgid % nig) / gsz; return true;
    }
    __device__ __forceinline__ void a_ready(const Unit&) const {}
    __device__ __forceinline__ void done(const Unit&) const {}
};


__device__ __forceinline__ unsigned cvt_pk_bf16(float lo, float hi) { unsigned r; asm volatile("v_cvt_pk_bf16_f32 %0, %1, %2" : "=v"(r) : "v"(lo), "v"(hi)); return r; }
typedef float f32x2 __attribute__((ext_vector_type(2)));
typedef unsigned u32x2 __attribute__((ext_vector_type(2)));
constexpr float RMS_EPS = 1e-6f;
__device__ __forceinline__ float silu_f(float v) { return v / (1.0f + __expf(-v)); }
__device__ __forceinline__ u32x4 pack8v(f32x4 a, f32x4 b) { u32x4 w; w.x = cvt_pk_bf16(a[0], a[1]); w.y = cvt_pk_bf16(a[2], a[3]); w.z = cvt_pk_bf16(b[0], b[1]); w.w = cvt_pk_bf16(b[2], b[3]); return w; }
__device__ __forceinline__ void rope4(f32x4 v0, f32x4 v1, f32x4 cs, f32x4 sn, u32x2& lo, u32x2& hi) {
    const float a0 = v0[0], b0 = v0[1], a1 = v0[2], b1 = v0[3], a2 = v1[0], b2 = v1[1], a3 = v1[2], b3 = v1[3];
    lo.x = cvt_pk_bf16(a0 * cs[0] - b0 * sn[0], a1 * cs[1] - b1 * sn[1]); lo.y = cvt_pk_bf16(a2 * cs[2] - b2 * sn[2], a3 * cs[3] - b3 * sn[3]);
    hi.x = cvt_pk_bf16(a0 * sn[0] + b0 * cs[0], a1 * sn[1] + b1 * cs[1]); hi.y = cvt_pk_bf16(a2 * sn[2] + b2 * cs[2], a3 * sn[3] + b3 * cs[3]);
}

struct EpiIn {
    static constexpr bool PERM = true, AFTER_DRAIN = false;
    unsigned char* ws;
    const float* bforget;
    __device__ __forceinline__ void operator()(const f32x4 (&acc)[2][2][4][2], const Unit& u, int wr, int wc, int fr, int fq) const {
        const int row0 = u.pm * BM + wr * 64 + fr; const int pn = u.pn;
        const float* xss = (const float*)(ws + WS_XSS);
        float rs[2][4];
#pragma unroll
        for (int ai = 0; ai < 2; ++ai)
#pragma unroll
            for (int m = 0; m < 4; ++m) { const int row = row0 + ai * HALF + m * 16; const f32x4* p = (const f32x4*)(xss + (size_t)row * 32 + fq * 8);
                const f32x4 a = p[0], b = p[1]; float s = ((a[0] + a[1]) + (a[2] + a[3])) + ((b[0] + b[1]) + (b[2] + b[3]));
                s += __shfl_xor(s, 16); s += __shfl_xor(s, 32); rs[ai][m] = rsqrtf(s * (1.0f / 2048.0f) + RMS_EPS); }
        if (pn < 26) {
            size_t doff; int ld, cb, kind = 0; size_t ssoff = 0; int sld = 0, slot = 0;
            if (pn < 3) { doff = WS_AQ; ld = 768; cb = pn * 256; }
            else if (pn < 6) { doff = WS_AK; ld = 768; cb = (pn - 3) * 256; }
            else if (pn < 9) { doff = WS_AV; ld = 768; cb = (pn - 6) * 256; }
            else if (pn < 12) { doff = WS_G; ld = LDX; cb = (pn - 9) * 256; kind = 1; }
            else if (pn < 14) { doff = WS_CQ; ld = 512; cb = (pn - 12) * 256; kind = 2; ssoff = WS_CQSS; sld = 8; slot = (pn - 12) * 4 + wc; }
            else if (pn == 14) { doff = WS_CKV; ld = 256; cb = 0; kind = 2; ssoff = WS_CKVSS; sld = 4; slot = wc; }
            else if (pn < 18) { doff = WS_G; ld = LDX; cb = 768 + (pn - 15) * 256; kind = 1; }
            else if (pn < 20) { doff = WS_CQ2; ld = 512; cb = (pn - 18) * 256; }
            else if (pn < 22) { doff = WS_CK2; ld = 512; cb = (pn - 20) * 256; }
            else if (pn < 24) { doff = WS_CV; ld = 512; cb = (pn - 22) * 256; }
            else { doff = WS_G; ld = LDX; cb = 1536 + (pn - 24) * 256; kind = 1; }
            bf16_t* dst = (bf16_t*)(ws + doff); float* ss = (float*)(ws + ssoff);
            const int col0 = cb + wc * 32 + 8 * fq;
#pragma unroll
            for (int ai = 0; ai < 2; ++ai)
#pragma unroll
                for (int m = 0; m < 4; ++m) { const int row = row0 + ai * HALF + m * 16; bf16_t* rowp = dst + (size_t)row * ld + col0; const float r = rs[ai][m]; float sq = 0.f;
#pragma unroll
                    for (int bj = 0; bj < 2; ++bj) { f32x4 v0 = acc[ai][bj][m][0] * r, v1 = acc[ai][bj][m][1] * r;
                        if (kind == 1) {
#pragma unroll
                            for (int j = 0; j < 4; ++j) { v0[j] = silu_f(v0[j]); v1[j] = silu_f(v1[j]); } }
                        if (kind == 2) sq += ((v0[0] * v0[0] + v0[1] * v0[1]) + (v0[2] * v0[2] + v0[3] * v0[3])) + ((v1[0] * v1[0] + v1[1] * v1[1]) + (v1[2] * v1[2] + v1[3] * v1[3]));
                        *(u32x4*)(rowp + bj * HALF) = pack8v(v0, v1); }
                    if (kind == 2) { sq += __shfl_xor(sq, 16); sq += __shfl_xor(sq, 32); if (fq == 0) ss[(size_t)row * sld + slot] = sq; } }
        } else {
            if (wc < 2) {
                const int i0 = 16 * wc + 4 * fq; const float* ropeC = (const float*)(ws + WS_ROPE); const float* ropeS = ropeC + 4096 * 32; bf16_t* KB = (bf16_t*)(ws + WS_KB);
#pragma unroll
                for (int ai = 0; ai < 2; ++ai)
#pragma unroll
                    for (int m = 0; m < 4; ++m) { const int row = row0 + ai * HALF + m * 16; const float r = rs[ai][m]; const int t = row & 4095;
                        const f32x4 cs = *(const f32x4*)(ropeC + t * 32 + i0), sn = *(const f32x4*)(ropeS + t * 32 + i0);
                        u32x2 lo, hi; rope4(acc[ai][0][m][0] * r, acc[ai][0][m][1] * r, cs, sn, lo, hi);
                        bf16_t* kp = KB + (size_t)row * 1152 + 128 + i0;
#pragma unroll
                        for (int h = 0; h < 6; ++h) { *(u32x2*)(kp + h * 192) = lo; *(u32x2*)(kp + h * 192 + 32) = hi; }
                        asm volatile("" ::: "memory"); }
            } else if (wc == 2 && fq == 0) {
                float* LOGF = (float*)(ws + WS_LOGF);
                f32x4 b0; b0[0] = bforget[0]; b0[1] = bforget[1]; b0[2] = bforget[2]; b0[3] = bforget[3]; f32x4 b1; b1[0] = bforget[4]; b1[1] = bforget[5]; b1[2] = 0.f; b1[3] = 0.f;
#pragma unroll
                for (int ai = 0; ai < 2; ++ai)
#pragma unroll
                    for (int m = 0; m < 4; ++m) { const int row = row0 + ai * HALF + m * 16; const float r = rs[ai][m];
                        f32x4 z0 = acc[ai][0][m][0] * r + b0, z1 = acc[ai][0][m][1] * r + b1, l0, l1;
#pragma unroll
                        for (int j = 0; j < 4; ++j) { l0[j] = fminf(z0[j], 0.f) - log1pf(__expf(-fabsf(z0[j]))); l1[j] = fminf(z1[j], 0.f) - log1pf(__expf(-fabsf(z1[j]))); }
                        l1[2] = 0.f; l1[3] = 0.f;
                        *(f32x4*)(LOGF + (size_t)row * 8) = l0; *(f32x4*)(LOGF + (size_t)row * 8 + 4) = l1; }
            }
        }
    }
};

struct EpiUq {
    static constexpr bool PERM = true, AFTER_DRAIN = false;
    unsigned char* ws;
    __device__ __forceinline__ void operator()(const f32x4 (&acc)[2][2][4][2], const Unit& u, int wr, int wc, int fr, int fq) const {
        const int row0 = u.pm * BM + wr * 64 + fr; const int pn = u.pn;
        const float* CQSS = (const float*)(ws + WS_CQSS); bf16_t* QB = (bf16_t*)(ws + WS_QB); const float* ropeC = (const float*)(ws + WS_ROPE); const float* ropeS = ropeC + 4096 * 32;
        float rs[2][4];
#pragma unroll
        for (int ai = 0; ai < 2; ++ai)
#pragma unroll
            for (int m = 0; m < 4; ++m) { const int row = row0 + ai * HALF + m * 16; const f32x2 a = *(const f32x2*)(CQSS + (size_t)row * 8 + fq * 2);
                float s = a[0] + a[1]; s += __shfl_xor(s, 16); s += __shfl_xor(s, 32); rs[ai][m] = rsqrtf(s * (1.0f / 512.0f) + RMS_EPS); }
        if (pn < 3) {
#pragma unroll
            for (int ai = 0; ai < 2; ++ai)
#pragma unroll
                for (int m = 0; m < 4; ++m) { const int row = row0 + ai * HALF + m * 16; const float r = rs[ai][m];
#pragma unroll
                    for (int bj = 0; bj < 2; ++bj) { const int h = pn * 2 + bj; bf16_t* p = QB + (size_t)row * 1152 + 192 * h + wc * 32 + 8 * fq;
                        *(u32x4*)p = pack8v(acc[ai][bj][m][0] * r, acc[ai][bj][m][1] * r); } }
        } else {
            const int i0 = 16 * (wc & 1) + 4 * fq;
#pragma unroll
            for (int ai = 0; ai < 2; ++ai)
#pragma unroll
                for (int m = 0; m < 4; ++m) { const int row = row0 + ai * HALF + m * 16; const float r = rs[ai][m]; const int t = row & 4095;
                    const f32x4 cs = *(const f32x4*)(ropeC + t * 32 + i0), sn = *(const f32x4*)(ropeS + t * 32 + i0);
#pragma unroll
                    for (int bj = 0; bj < 2; ++bj) { const int cc = (pn - 3) * 256 + bj * HALF + wc * 32; const int hh = cc >> 6;
                        if (hh < 6) { u32x2 lo, hi; rope4(acc[ai][bj][m][0] * r, acc[ai][bj][m][1] * r, cs, sn, lo, hi);
                            bf16_t* p = QB + (size_t)row * 1152 + 192 * hh + 128 + i0; *(u32x2*)p = lo; *(u32x2*)(p + 32) = hi; } }
                    asm volatile("" ::: "memory"); }
        }
    }
};
struct EpiUkv {
    static constexpr bool PERM = true, AFTER_DRAIN = false;
    unsigned char* ws;
    __device__ __forceinline__ void operator()(const f32x4 (&acc)[2][2][4][2], const Unit& u, int wr, int wc, int fr, int fq) const {
        const int row0 = u.pm * BM + wr * 64 + fr; const int pn = u.pn;
        const float* CKVSS = (const float*)(ws + WS_CKVSS); bf16_t* KB = (bf16_t*)(ws + WS_KB); bf16_t* VB = (bf16_t*)(ws + WS_VB);
#pragma unroll
        for (int ai = 0; ai < 2; ++ai)
#pragma unroll
            for (int m = 0; m < 4; ++m) { const int row = row0 + ai * HALF + m * 16; const f32x4 a = *(const f32x4*)(CKVSS + (size_t)row * 4);
                const float r = rsqrtf(((a[0] + a[1]) + (a[2] + a[3])) * (1.0f / 256.0f) + RMS_EPS);
#pragma unroll
                for (int bj = 0; bj < 2; ++bj) {
                    bf16_t* p;
                    if (pn < 3) p = KB + (size_t)row * 1152 + 192 * (pn * 2 + bj) + wc * 32 + 8 * fq;
                    else p = VB + (size_t)row * 768 + (pn - 3) * 256 + bj * HALF + wc * 32 + 8 * fq;
                    *(u32x4*)p = pack8v(acc[ai][bj][m][0] * r, acc[ai][bj][m][1] * r); } }
    }
};
struct EpiOut {
    static constexpr bool PERM = true, AFTER_DRAIN = false;
    const float* base; float* out; unsigned char* ws; int write_xb;
    __device__ __forceinline__ void operator()(const f32x4 (&acc)[2][2][4][2], const Unit& u, int wr, int wc, int fr, int fq) const {
        const int row0 = u.pm * BM + wr * 64 + fr; const int col0 = u.pn * BM + wc * 32 + 8 * fq;
        bf16_t* XB = (bf16_t*)(ws + WS_XB); float* xss = (float*)(ws + WS_XSS);
#pragma unroll
        for (int ai = 0; ai < 2; ++ai)
#pragma unroll
            for (int m = 0; m < 4; ++m) { const int row = row0 + ai * HALF + m * 16; const size_t off = (size_t)row * 2048 + col0, offb = (size_t)row * LDX + col0; float sq = 0.f;
#pragma unroll
                for (int bj = 0; bj < 2; ++bj) { const f32x4 x0 = *(const f32x4*)(base + off + bj * HALF), x1 = *(const f32x4*)(base + off + bj * HALF + 4);
                    const f32x4 v0 = x0 + acc[ai][bj][m][0], v1 = x1 + acc[ai][bj][m][1];
                    sq += ((v0[0] * v0[0] + v0[1] * v0[1]) + (v0[2] * v0[2] + v0[3] * v0[3])) + ((v1[0] * v1[0] + v1[1] * v1[1]) + (v1[2] * v1[2] + v1[3] * v1[3]));
                    *(f32x4*)(out + off + bj * HALF) = v0; *(f32x4*)(out + off + bj * HALF + 4) = v1;
                    if (write_xb) *(u32x4*)(XB + offb + bj * HALF) = pack8v(v0, v1); }
                sq += __shfl_xor(sq, 16); sq += __shfl_xor(sq, 32); if (fq == 0) xss[(size_t)row * 32 + u.pn * 4 + wc] = sq; }
    }
};

template <class Epi, class Sched, bool ALIGN_EPI = false, bool SP2 = false>
__device__ __forceinline__ void gemm_phase(PG8_LAS unsigned char* lds, const Gemm g, const Sched& S, const Epi& E) {
    int tid_ = threadIdx.x; asm volatile("" : "+v"(tid_));
    const int tid = tid_, wid = __builtin_amdgcn_readfirstlane(tid >> 6), lane = tid & 63, wr = wid >> 2, wc = wid & 3, fr = lane & 15, fq = lane >> 4;
    const int K = g.K, nt = K / BK;
    unsigned voffA[2], voffB[2];
#pragma unroll
    for (int i = 0; i < 2; ++i) { int R, C; stage_rc(tid * 16 + i * 8192, R, C); const int Rb = Epi::PERM ? ((R & ~31) + perm32(R & 31)) : R;
        voffA[i] = (unsigned)(R * g.lda + C) * 2u; voffB[i] = (unsigned)(Rb * g.ldb + C) * 2u; }
    const size_t kstep = (size_t)(BK * 2);
    const size_t hstepA = (size_t)HALF * g.lda * 2, hstepB = (size_t)HALF * g.ldb * 2;
    const size_t tstepA = 2 * hstepA, tstepB = 2 * hstepB;
    const unsigned ldsw = (unsigned)wid * 1024u;
    const int aoff = lds_byte(wr * 64 + fr, fq * 8), boff = lds_byte(wc * 32 + fr, fq * 8);
#define PG8_SA(b, h) (((b) * 2 + (h)) * HTB)
#define PG8_SB(b, h) ((4 + (b) * 2 + (h)) * HTB)
#define PG8_STAGE(bufoff, gbase, voff) do { _Pragma("unroll") for (int _i = 0; _i < 2; ++_i) \
        __builtin_amdgcn_global_load_lds((const unsigned*)((const char*)(gbase) + (voff)[_i]), (PG8_LAS unsigned*)(lds + (bufoff) + ldsw + _i * 8192), 16, 0, 0); } while (0)
#define PG8_LDA(dst, b, h) do { _Pragma("unroll") for (int m = 0; m < 4; ++m) _Pragma("unroll") for (int k = 0; k < 2; ++k) dst[m][k] = *(const PG8_LAS bf16x8*)(lds + PG8_SA(b, h) + aoff + m * 2048 + k * 1024); } while (0)
#define PG8_LDB(dst, b, h) do { _Pragma("unroll") for (int n = 0; n < 2; ++n) _Pragma("unroll") for (int k = 0; k < 2; ++k) dst[n][k] = *(const PG8_LAS bf16x8*)(lds + PG8_SB(b, h) + boff + n * 2048 + k * 1024); } while (0)
#define PG8_MMA(ai, bj, At, Bt) do { __builtin_amdgcn_s_setprio(1); _Pragma("unroll") for (int m = 0; m < 4; ++m) _Pragma("unroll") for (int n = 0; n < 2; ++n) _Pragma("unroll") for (int k = 0; k < 2; ++k) \
        acc[ai][bj][m][n] = __builtin_amdgcn_mfma_f32_16x16x32_bf16(Bt[n][k], At[m][k], acc[ai][bj][m][n], 0, 0, 0); __builtin_amdgcn_s_setprio(0); } while (0)
#define PG8_WAIT_V(n) asm volatile("s_waitcnt vmcnt(" #n ")" ::: "memory")
#define PG8_WAIT_L(n) asm volatile("s_waitcnt lgkmcnt(" #n ")" ::: "memory")
#define PG8_BAR __builtin_amdgcn_s_barrier()
#define PG8_SCHED __builtin_amdgcn_sched_barrier(0)
    Unit cur, nxt; int ui = 0;
    if (!S.next(0, cur)) return;
    f32x4 acc[2][2][4][2];
#pragma unroll
    for (int a = 0; a < 2; ++a)
#pragma unroll
        for (int b = 0; b < 2; ++b)
#pragma unroll
            for (int m = 0; m < 4; ++m)
#pragma unroll
                for (int n = 0; n < 2; ++n) acc[a][b][m][n] = (f32x4){0.f, 0.f, 0.f, 0.f};
    bf16x8 At[4][2], B0[2][2], B1[2][2];
    const char* cA = (const char*)g.A + (size_t)cur.pm * tstepA; const char* cB = (const char*)g.Bt + (size_t)cur.pn * tstepB;
    S.a_ready(cur);
    if constexpr (SP2) {
        PG8_STAGE(PG8_SB(0, 0), cB, voffB); PG8_STAGE(PG8_SB(0, 1), cB + hstepB, voffB); PG8_STAGE(PG8_SA(0, 0), cA, voffA); PG8_STAGE(PG8_SA(0, 1), cA + hstepA, voffA);
        if (wr == 1) PG8_BAR;
        PG8_WAIT_V(2); PG8_BAR;
        PG8_STAGE(PG8_SB(1, 0), cB + kstep, voffB); PG8_STAGE(PG8_SA(1, 0), cA + kstep, voffA); PG8_STAGE(PG8_SB(1, 1), cB + hstepB + kstep, voffB);
        PG8_WAIT_V(6); PG8_BAR;
    } else {
        PG8_STAGE(PG8_SB(0, 0), cB, voffB); PG8_STAGE(PG8_SA(0, 0), cA, voffA); PG8_STAGE(PG8_SB(0, 1), cB + hstepB, voffB); PG8_STAGE(PG8_SA(0, 1), cA + hstepA, voffA);
        if (wr == 1) PG8_BAR;
        PG8_WAIT_V(4); PG8_BAR;
        PG8_STAGE(PG8_SB(1, 0), cB + kstep, voffB); PG8_STAGE(PG8_SA(1, 0), cA + kstep, voffA); PG8_STAGE(PG8_SB(1, 1), cB + hstepB + kstep, voffB);
        PG8_WAIT_V(6); PG8_BAR;
    }
    for (;;) {
        const bool has_next = S.next(ui + 1, nxt);
        const char* nA = has_next ? (const char*)g.A + (size_t)nxt.pm * tstepA : cA; const char* nB = has_next ? (const char*)g.Bt + (size_t)nxt.pn * tstepB : cB;
        for (int t = 0; t < nt; t += 2) {
            const bool last = (t == nt - 2);
            const char* a1 = cA + (size_t)(t + 1) * kstep;
            const char* a2 = last ? nA : cA + (size_t)(t + 2) * kstep; const char* b2 = last ? nB : cB + (size_t)(t + 2) * kstep;
            const char* a3 = a2 + kstep; const char* b3 = b2 + kstep;
            if (last && has_next) S.a_ready(nxt);
            if constexpr (SP2) {
            PG8_LDB(B0, 0, 0); PG8_LDB(B1, 0, 1); PG8_SCHED; PG8_LDA(At, 0, 0); PG8_STAGE(PG8_SA(1, 1), a1 + hstepA, voffA);
            PG8_WAIT_V(8); PG8_WAIT_L(0); PG8_BAR; PG8_MMA(0, 0, At, B0); PG8_MMA(0, 1, At, B1); PG8_BAR; PG8_SCHED;
            PG8_LDA(At, 0, 1); PG8_STAGE(PG8_SB(0, 0), b2, voffB); PG8_STAGE(PG8_SB(0, 1), b2 + hstepB, voffB); PG8_STAGE(PG8_SA(0, 0), a2, voffA);
            PG8_WAIT_V(8); PG8_WAIT_L(0); PG8_BAR; PG8_MMA(1, 0, At, B0); PG8_MMA(1, 1, At, B1); PG8_BAR; PG8_SCHED;
            PG8_LDB(B0, 1, 0); PG8_LDB(B1, 1, 1); PG8_SCHED; PG8_LDA(At, 1, 0); PG8_STAGE(PG8_SA(0, 1), a2 + hstepA, voffA);
            PG8_WAIT_V(8); PG8_WAIT_L(0); PG8_BAR; PG8_MMA(0, 0, At, B0); PG8_MMA(0, 1, At, B1); PG8_BAR; PG8_SCHED;
            PG8_LDA(At, 1, 1); PG8_STAGE(PG8_SB(1, 0), b3, voffB); PG8_STAGE(PG8_SB(1, 1), b3 + hstepB, voffB); PG8_STAGE(PG8_SA(1, 0), a3, voffA);
            PG8_WAIT_V(8); PG8_WAIT_L(0); PG8_BAR; PG8_MMA(1, 0, At, B0); PG8_MMA(1, 1, At, B1); PG8_BAR; PG8_SCHED;
            } else {
            PG8_LDB(B0, 0, 0); PG8_SCHED; PG8_LDA(At, 0, 0); PG8_STAGE(PG8_SA(1, 1), a1 + hstepA, voffA);
            PG8_WAIT_L(8); PG8_BAR; PG8_WAIT_L(0); PG8_MMA(0, 0, At, B0); PG8_BAR; PG8_SCHED;
            PG8_LDB(B1, 0, 1); PG8_STAGE(PG8_SB(0, 0), b2, voffB);
            PG8_BAR; PG8_WAIT_L(0); PG8_MMA(0, 1, At, B1); PG8_BAR;
            PG8_LDA(At, 0, 1); PG8_STAGE(PG8_SA(0, 0), a2, voffA);
            PG8_BAR; PG8_WAIT_L(0); PG8_MMA(1, 0, At, B0); PG8_BAR; PG8_SCHED;
            PG8_STAGE(PG8_SB(0, 1), b2 + hstepB, voffB);
            PG8_WAIT_V(6); PG8_BAR; PG8_MMA(1, 1, At, B1); PG8_BAR;
            PG8_LDB(B0, 1, 0); PG8_SCHED; PG8_LDA(At, 1, 0); PG8_STAGE(PG8_SA(0, 1), a2 + hstepA, voffA);
            PG8_WAIT_L(8); PG8_BAR; PG8_WAIT_L(0); PG8_MMA(0, 0, At, B0); PG8_BAR; PG8_SCHED;
            PG8_LDB(B1, 1, 1); PG8_STAGE(PG8_SB(1, 0), b3, voffB);
            PG8_BAR; PG8_WAIT_L(0); PG8_MMA(0, 1, At, B1); PG8_BAR;
            PG8_LDA(At, 1, 1); PG8_STAGE(PG8_SA(1, 0), a3, voffA);
            PG8_BAR; PG8_WAIT_L(0); PG8_MMA(1, 0, At, B0); PG8_BAR; PG8_SCHED;
            PG8_STAGE(PG8_SB(1, 1), b3 + hstepB, voffB);
            PG8_WAIT_V(6); PG8_BAR; PG8_MMA(1, 1, At, B1); PG8_BAR;
            }
        }
        if constexpr (ALIGN_EPI) { if (wr == 0) PG8_BAR; }
        if constexpr (!Epi::AFTER_DRAIN) { E(acc, cur, wr, wc, fr, fq); S.done(cur); __builtin_amdgcn_s_waitcnt(0x0F70); }
        if (!has_next) break;
#pragma unroll
        for (int a = 0; a < 2; ++a)
#pragma unroll
            for (int b = 0; b < 2; ++b)
#pragma unroll
                for (int m = 0; m < 4; ++m)
#pragma unroll
                    for (int n = 0; n < 2; ++n) acc[a][b][m][n] = (f32x4){0.f, 0.f, 0.f, 0.f};
        cur = nxt; cA = nA; cB = nB; ++ui;
        if constexpr (ALIGN_EPI) { if (wr == 1) PG8_BAR; }
    }
    PG8_WAIT_V(0);
    if constexpr (!ALIGN_EPI) { if (wr == 0) PG8_BAR; }
    PG8_BAR;
    if constexpr (Epi::AFTER_DRAIN) { E.fused(acc, cur, wr, wc, fr, fq, lds, wid, lane); S.done(cur); }
#undef PG8_SA
#undef PG8_SB
#undef PG8_STAGE
#undef PG8_LDA
#undef PG8_LDB
#undef PG8_MMA
#undef PG8_WAIT_V
#undef PG8_WAIT_L
#undef PG8_BAR
#undef PG8_SCHED
}
}
#define GAS __attribute__((address_space(1)))
#define LAS __attribute__((address_space(3)))
typedef unsigned short bf16;
typedef unsigned v4u __attribute__((ext_vector_type(4)));
typedef float f32x4 __attribute__((ext_vector_type(4)));
typedef float f32x2 __attribute__((ext_vector_type(2)));
typedef short bf16x8 __attribute__((ext_vector_type(8)));
#define LDS_WAIT() asm volatile("s_waitcnt lgkmcnt(0)" ::: "memory")

__device__ __forceinline__ unsigned f2bf(float f) { unsigned u = __builtin_bit_cast(unsigned, f); return (u + 0x7fffu + ((u >> 16) & 1u)) >> 16; }
__device__ __forceinline__ unsigned pk2(float lo, float hi) { return f2bf(lo) | (f2bf(hi) << 16); }
__device__ __forceinline__ float bf2f(unsigned short h) { return __builtin_bit_cast(float, (unsigned)h << 16); }
__device__ __forceinline__ float wave_sum(float v) {
#pragma unroll
    for (int o = 1; o < 64; o <<= 1) v += __shfl_xor(v, o);
    return v;
}
__device__ __forceinline__ float wave_max(float v) {
#pragma unroll
    for (int o = 1; o < 64; o <<= 1) v = fmaxf(v, __shfl_xor(v, o));
    return v;
}

struct Args {
    const float* in[16]; float* out; unsigned char* ws; int ph_lo, ph_hi;
};

__device__ __forceinline__ int colmap_in(int n) {
    const int t = n >> 8;
    if (t < 9) return n;
    if (t < 12) return 2310 + (n - 2304);
    if (t < 14) return 3078 + (n - 3072);
    if (t == 14) return 3590 + (n - 3584);
    if (t < 18) return 3910 + (n - 3840);
    if (t < 20) return 4678 + (n - 4608);
    if (t < 22) return 5190 + (n - 5120);
    if (t < 24) return 5702 + (n - 5632);
    if (t < 26) return 6214 + (n - 6144);
    const int j = n & 255;
    if (j < 64) return 3846 + (j >> 1) + 32 * (j & 1);
    if (j < 70) return 2304 + (j - 64);
    return -1;
}
__device__ __forceinline__ int colmap_uq(int n) {
    if (n < 768) return 192 * (n >> 7) + (n & 127);
    if (n < 1152) { const int hh = (n - 768) >> 6, p = (n - 768) & 63; return 192 * hh + 128 + (p >> 1) + 32 * (p & 1); }
    return -1;
}
__device__ __forceinline__ int colmap_ukv(int n) {
    if (n < 768) return 256 * (n >> 7) + (n & 127);
    const int c = n - 768; return 256 * (c >> 7) + 128 + (c & 127);
}
template <int MAT> __device__ __forceinline__ void tr_item(const float* W, int Norig, const float* gk, bf16* WT, int ldw, int k0, int n0, LAS float* scr, int lane) {
    const int nn = lane & 31; int oc;
    if (MAT == 0) oc = colmap_in(n0 + nn); else if (MAT == 1) oc = colmap_uq(n0 + nn); else if (MAT == 2) oc = colmap_ukv(n0 + nn); else oc = n0 + nn;
#pragma unroll 8
    for (int i = 0; i < 32; ++i) { const int kk = 2 * i + (lane >> 5); float v = 0.f;
        if (oc >= 0) { v = W[(size_t)(k0 + kk) * Norig + oc]; if (gk) v *= gk[k0 + kk]; }
        scr[kk * 33 + nn] = v; }
    LDS_WAIT(); asm volatile("" ::: "memory");
    const int c = lane & 7;
#pragma unroll
    for (int j = 0; j < 4; ++j) { const int n = (lane >> 3) + 8 * j; const LAS float* s = scr + (8 * c) * 33 + n;
        v4u o; o.x = pk2(s[0 * 33], s[1 * 33]); o.y = pk2(s[2 * 33], s[3 * 33]); o.z = pk2(s[4 * 33], s[5 * 33]); o.w = pk2(s[6 * 33], s[7 * 33]);
        *(v4u*)(WT + (size_t)(n0 + n) * ldw + k0 + 8 * c) = o; }
    LDS_WAIT(); asm volatile("" ::: "memory");
}

__device__ __forceinline__ int t5_bucket(int rel) {
    const int n = rel < 0 ? -rel : rel; int v;
    if (n < 8) v = n; else if (n < 12) v = 8; else if (n < 16) v = 9; else if (n < 23) v = 10; else if (n < 32) v = 11; else if (n < 46) v = 12; else if (n < 64) v = 13; else if (n < 91) v = 14; else v = 15;
    return (rel > 0 ? 16 : 0) + v;
}

__device__ __forceinline__ int opaque_tid() { int t = threadIdx.x; asm volatile("" : "+v"(t)); return t; }
#define C_tid (tid_o)
#define C_lane (tid_o & 63)
#define C_wave (__builtin_amdgcn_readfirstlane(tid_o >> 6))
#define C_G ((int)gridDim.x)
#define C_bid ((int)blockIdx.x)
#define WSP(T, off) ((T*)(args.ws + (off)))

__device__ __forceinline__ void p0_prologue(const Args& args, LAS unsigned char* lds) {
    const int tid_o = opaque_tid();
    LAS float* scr = (LAS float*)(lds + C_wave * 16384);
    const int gw = C_bid * NWAVES + C_wave, NGW = C_G * NWAVES;
    constexpr int I_IN = (DM / 64) * (NIN_PAD / 32), I_UQ = (512 / 64) * (NUQ_PAD / 32), I_UKV = (256 / 64) * (NUKV / 32), I_OUT = (DM / 64) * (DM / 32);
    constexpr int PER_LAYER = I_IN + I_UQ + I_UKV + I_OUT;
    for (int it = gw; it < DEPTH * PER_LAYER; it += NGW) {
        const int l = it / PER_LAYER; int r = it - l * PER_LAYER;
        if (r < I_IN) { const int nb = NIN_PAD / 32, kb = r / nb, nbk = r - kb * nb;
            tr_item<0>(args.in[2] + (size_t)l * DM * NIN, NIN, args.in[1] + l * DM, (bf16*)(args.ws + WS_WIN + (size_t)l * WIN_BYTES), LDX, kb * 64, nbk * 32, scr, C_lane); continue; }
        r -= I_IN;
        if (r < I_UQ) { const int nb = NUQ_PAD / 32, kb = r / nb, nbk = r - kb * nb;
            tr_item<1>(args.in[5] + (size_t)l * 512 * 1152, 1152, args.in[4] + l * 512, WSP(bf16, WS_WUQ) + (size_t)l * NUQ_PAD * 512, 512, kb * 64, nbk * 32, scr, C_lane); continue; }
        r -= I_UQ;
        if (r < I_UKV) { const int nb = NUKV / 32, kb = r / nb, nbk = r - kb * nb;
            tr_item<2>(args.in[7] + (size_t)l * 256 * 1536, 1536, args.in[6] + l * 256, WSP(bf16, WS_WUKV) + (size_t)l * NUKV * 256, 256, kb * 64, nbk * 32, scr, C_lane); continue; }
        r -= I_UKV;
        { const int nb = DM / 32, kb = r / nb, nbk = r - kb * nb;
            tr_item<3>(args.in[14] + (size_t)l * DM * DM, DM, nullptr, (bf16*)(args.ws + WS_WOUT + (size_t)l * WOUT_BYTES), LDX, kb * 64, nbk * 32, scr, C_lane); }
    }
    for (int m = gw; m < M; m += NGW) {
        const f32x4* xr = (const f32x4*)(args.in[0] + (size_t)m * DM) + C_lane; float s = 0.f;
        unsigned long long* o8 = (unsigned long long*)(WSP(bf16, WS_XB) + (size_t)m * LDX) + C_lane;
#pragma unroll
        for (int j = 0; j < 8; ++j) { const f32x4 v = xr[64 * j]; s += (v[0] * v[0] + v[1] * v[1]) + (v[2] * v[2] + v[3] * v[3]);
            o8[64 * j] = (unsigned long long)pk2(v[0], v[1]) | ((unsigned long long)pk2(v[2], v[3]) << 32); }
        s = wave_sum(s);
        if (C_lane < 32) WSP(float, WS_XSS)[(size_t)m * 32 + C_lane] = C_lane == 0 ? s : 0.f;
    }
    for (int e = C_bid * NTHREADS + C_tid; e < SEQ * 32; e += C_G * NTHREADS) {
        const int s = e >> 5, i = e & 31; const float inv = powf(10000.0f, -(float)i / 32.0f); const float ang = (float)s * inv;
        WSP(float, WS_ROPE)[e] = cosf(ang); WSP(float, WS_ROPE + SEQ * 32 * 4)[e] = sinf(ang);
    }
}

__device__ __forceinline__ void p2_scan(const Args& args) {
    const int tid_o = opaque_tid();
    if (C_bid >= NB * 6 || C_wave != 0) return;
    const int b = C_bid / 6, h = C_bid % 6, lane = C_lane;
    const float* src = WSP(float, WS_LOGF) + ((size_t)b * SEQ + 64 * lane) * 8 + h;
    float tot = 0.f;
#pragma unroll 8
    for (int j = 0; j < 64; ++j) tot += src[j * 8];
    float incl = tot;
#pragma unroll
    for (int o = 1; o < 64; o <<= 1) { const float y = __shfl_up(incl, o); if (lane >= o) incl += y; }
    float run = incl - tot;
    float* dst = WSP(float, WS_CUMT) + (size_t)C_bid * SEQ + 64 * lane;
#pragma unroll 8
    for (int j = 0; j < 64; ++j) { run += src[j * 8]; dst[j] = run; }
}

template <int DQK> __device__ __forceinline__ float dot_row(const bf16* kp, const LAS float* qs) {
    float s = 0.f;
#pragma unroll
    for (int c = 0; c < DQK / 8; ++c) { const v4u kv = *(const v4u*)(kp + c * 8);
        const f32x4 q0 = *(const LAS f32x4*)(qs + c * 8), q1 = *(const LAS f32x4*)(qs + c * 8 + 4);
        s += bf2f(kv.x & 0xffff) * q0[0] + bf2f(kv.x >> 16) * q0[1] + bf2f(kv.y & 0xffff) * q0[2] + bf2f(kv.y >> 16) * q0[3]
           + bf2f(kv.z & 0xffff) * q1[0] + bf2f(kv.z >> 16) * q1[1] + bf2f(kv.w & 0xffff) * q1[2] + bf2f(kv.w >> 16) * q1[3]; }
    return s;
}
template <int VAR, int DQK>
__device__ __forceinline__ void naive_map(const LAS float* qs, const bf16* Kbase, int kpitch, const bf16* Vbase, int vpitch, int nkeys, int t, const float* cum, float cumt,
                                          const float* relb, int h, int lane, float& o0, float& o1, float& l) {
    float m = -1e30f; l = 0.f; o0 = 0.f; o1 = 0.f;
    for (int k0 = 0; k0 < nkeys; k0 += 64) {
        const int key = k0 + lane;
        float s = dot_row<DQK>(Kbase + (size_t)key * kpitch, qs);
        if (VAR == 0) { s += cumt - cum[key]; if (key > t) s = -INFINITY; }
        if (VAR == 2) s += relb[t5_bucket(key - t) * 4 + h];
        const float tmax = wave_max(s), mn = fmaxf(m, tmax), alpha = __expf(m - mn), p = __expf(s - mn);
        l = l * alpha + wave_sum(p); o0 *= alpha; o1 *= alpha; m = mn;
        const bf16* vp = Vbase + (size_t)k0 * vpitch + 2 * lane;
#pragma unroll 8
        for (int kk = 0; kk < 64; ++kk) { const float pk = __shfl(p, kk); const unsigned vv = *(const unsigned*)(vp + (size_t)kk * vpitch);
            o0 += pk * bf2f(vv & 0xffff); o1 += pk * bf2f(vv >> 16); }
    }
}
__device__ __forceinline__ void p3_naive(const Args& args, int layer, LAS unsigned char* lds) {
    const int tid_o = opaque_tid();
    LAS float* qs = (LAS float*)(lds + C_wave * 1024);
    const int gw = C_bid * NWAVES + C_wave, NGW = C_G * NWAVES, lane = C_lane;
    const float lam_init = 0.8f - 0.6f * expf(-0.3f * (float)layer);
    const float d1 = wave_sum(args.in[8][layer * 64 + lane] * args.in[9][layer * 64 + lane]), d2 = wave_sum(args.in[10][layer * 64 + lane] * args.in[11][layer * 64 + lane]);
    const float lam = expf(d1) - expf(d2) + lam_init;
    for (int u = gw; u < M * 16; u += NGW) {
        const int row = u >> 4, hh = u & 15, b = row >> 12, t = row & 4095; const size_t rb = (size_t)b * SEQ;
        float o0, o1, l;
        if (hh < 6) {
            const int h = hh; const bf16* q = WSP(bf16, WS_AQ) + (size_t)row * 768 + 128 * h;
            qs[lane] = bf2f(q[lane]) * 0.08838834764831845f; qs[lane + 64] = bf2f(q[lane + 64]) * 0.08838834764831845f; LDS_WAIT();
            const float* cum = WSP(float, WS_CUMT) + (size_t)(b * 6 + h) * SEQ;
            naive_map<0, 128>(qs, WSP(bf16, WS_AK) + rb * 768 + 128 * h, 768, WSP(bf16, WS_AV) + rb * 768 + 128 * h, 768, t + 1, t, cum, cum[t], nullptr, h, lane, o0, o1, l);
            bf16* g = WSP(bf16, WS_G) + (size_t)row * LDX + 128 * h + 2 * lane; const unsigned gv = *(const unsigned*)g; const float il = 1.0f / l;
            *(unsigned*)g = pk2(o0 * il * bf2f(gv & 0xffff), o1 * il * bf2f(gv >> 16));
        } else if (hh < 12) {
            const int h = hh - 6; const bf16* q = WSP(bf16, WS_QB) + (size_t)row * 1152 + 192 * h; const float sc = 0.07216878364870322f;
            qs[lane] = bf2f(q[lane]) * sc; qs[lane + 64] = bf2f(q[lane + 64]) * sc; qs[lane + 128] = bf2f(q[lane + 128]) * sc; LDS_WAIT();
            naive_map<1, 192>(qs, WSP(bf16, WS_KB) + rb * 1152 + 192 * h, 1152, WSP(bf16, WS_VB) + rb * 768 + 128 * h, 768, 64 * (t / 64 + 1), t, nullptr, 0.f, nullptr, h, lane, o0, o1, l);
            bf16* g = WSP(bf16, WS_G) + (size_t)row * LDX + 768 + 128 * h + 2 * lane; const unsigned gv = *(const unsigned*)g; const float il = 1.0f / l;
            *(unsigned*)g = pk2(o0 * il * bf2f(gv & 0xffff), o1 * il * bf2f(gv >> 16));
        } else {
            const int h = hh - 12; const bf16* q = WSP(bf16, WS_CQ2) + (size_t)row * 512 + 128 * h;
            qs[lane] = bf2f(q[lane]) * 0.125f; qs[lane + 64] = bf2f(q[lane + 64]) * 0.125f; LDS_WAIT();
            float p0, p1, pl;
            naive_map<2, 64>(qs, WSP(bf16, WS_CK2) + rb * 512 + 128 * h, 512, WSP(bf16, WS_CV) + rb * 512 + 128 * h, 512, 64 * (t / 64 + 1), t, nullptr, 0.f, args.in[13], h, lane, o0, o1, l);
            naive_map<2, 64>(qs + 64, WSP(bf16, WS_CK2) + rb * 512 + 128 * h + 64, 512, WSP(bf16, WS_CV) + rb * 512 + 128 * h, 512, 64 * (t / 64 + 1), t, nullptr, 0.f, args.in[13], h, lane, p0, p1, pl);
            const float il1 = 1.0f / l, il2 = lam / pl; const float c0 = o0 * il1 - p0 * il2, c1 = o1 * il1 - p1 * il2;
            const float ss = wave_sum(c0 * c0 + c1 * c1); const float r = rsqrtf(ss * (1.0f / 128.0f) + EPS) * (1.0f - lam_init);
            const float* sg = args.in[12] + layer * 128 + 2 * lane;
            bf16* g = WSP(bf16, WS_G) + (size_t)row * LDX + 1536 + 128 * h + 2 * lane; const unsigned gv = *(const unsigned*)g;
            *(unsigned*)g = pk2(c0 * r * sg[0] * bf2f(gv & 0xffff), c1 * r * sg[1] * bf2f(gv >> 16));
        }
        LDS_WAIT();
    }
}


namespace att {
typedef short s16x4 __attribute__((ext_vector_type(4)));
typedef float f32x16 __attribute__((ext_vector_type(16)));
typedef unsigned u32x4 __attribute__((ext_vector_type(4)));
constexpr int KVBLK = 64, SHM_V = 16384, SHM_K = 16384, SHM_KR = 8192;
constexpr int L_V = 0, L_K = 32768, L_KR = 65536, L_WS = 81920, L_KB = 83968, L_T5 = 84480, L_QR = 86016, L_FLAG = 118784, L_CMB = 0;
#define KSWZ(row, colB) ((row) * 256 + ((colB) ^ (((row) & 7) << 4)))
#define SBAR() __builtin_amdgcn_sched_barrier(0)
__device__ __forceinline__ int v_st(int k, int c) { const int kk = (k & ~0xC) | ((k & 4) << 1) | ((k & 8) >> 1); return ((kk >> 3) * 4 + (c >> 5)) * 512 + ((kk & 7) * 32 + (c & 31)) * 2; }
__device__ __forceinline__ int v_rd_base(int lane) { return ((lane & 3) << 3) | (((lane >> 2) & 3) << 6) | (((lane >> 4) & 1) << 5) | (((lane >> 5) & 1) << 8); }
constexpr int v_rd_off(int d0, int ks, int half) { return d0 * 512 + ks * 4096 + half * 2048; }
__device__ __forceinline__ int crow(int r, int hi) { return (r & 3) + 8 * (r >> 2) + 4 * hi; }
__device__ __forceinline__ unsigned cvtpk(float lo, float hi) { unsigned r; asm volatile("v_cvt_pk_bf16_f32 %0, %1, %2" : "=v"(r) : "v"(lo), "v"(hi)); return r; }

template <int VAR> struct VT;
template <> struct VT<0> { static constexpr float SCALE = 0.08838834764831845f; static constexpr int PQ = 768, PK = 768, PV = 768, NQ = 8, QROWS = 256; };
template <> struct VT<1> { static constexpr float SCALE = 0.07216878364870322f; static constexpr int PQ = 1152, PK = 1152, PV = 768, NQ = 8, QROWS = 256; };
template <> struct VT<2> { static constexpr float SCALE = 0.125f; static constexpr int PQ = 512, PK = 512, PV = 512, NQ = 4, QROWS = 128; };

__device__ __forceinline__ void mask_causal(f32x16& p0, f32x16& p1, int dq) {
    const float NEG = -__builtin_inff();
#pragma unroll
    for (int r = 0; r < 16; ++r) { const int c = (r & 3) + 8 * (r >> 2); if (dq - c < 0) p0[r] = NEG; if (dq - c - 32 < 0) p1[r] = NEG; }
}
template <int VAR>
__device__ __forceinline__ void partialSM(f32x16& p0, f32x16& p1, float& m_reg, float& mn, float& alpha, float cadd) {
    constexpr float SCALE = VT<VAR>::SCALE, C2 = 1.4426950408889634f * SCALE, THR = 8.f;
    float pmax = p0[0];
#pragma unroll
    for (int r = 1; r < 16; ++r) pmax = fmaxf(pmax, p0[r]);
#pragma unroll
    for (int r = 0; r < 16; ++r) pmax = fmaxf(pmax, p1[r]);
    { auto rr = __builtin_amdgcn_permlane32_swap(__float_as_uint(pmax), __float_as_uint(pmax), false, false);
      pmax = fmaxf(__uint_as_float(rr[0]), __uint_as_float(rr[1])); }
    if (VAR == 0) pmax += cadd;
    if (__builtin_expect(__all((pmax - m_reg) * SCALE <= THR), 1)) { mn = m_reg; alpha = 1.f; }
    else { mn = fmaxf(m_reg, pmax); alpha = __builtin_amdgcn_exp2f((m_reg - mn) * C2); m_reg = mn; }
    const float mnL = VAR == 0 ? (cadd - mn) * C2 : -mn * C2;
#pragma unroll
    for (int r = 0; r < 16; ++r) p0[r] = fmaf(p0[r], C2, mnL);
#pragma unroll
    for (int r = 0; r < 16; ++r) p1[r] = fmaf(p1[r], C2, mnL);
#pragma unroll
    for (int r = 0; r < 16; ++r) p0[r] = __builtin_amdgcn_exp2f(p0[r]);
}
__device__ __forceinline__ void finishSM(f32x16& p0, f32x16& p1, float alpha, float& l_reg, bf16x8& pa0, bf16x8& pa1, bf16x8& pa2, bf16x8& pa3) {
#pragma unroll
    for (int r = 0; r < 16; ++r) p1[r] = __builtin_amdgcn_exp2f(p1[r]);
    float ps = 0;
#pragma unroll
    for (int r = 0; r < 16; ++r) ps += p0[r];
#pragma unroll
    for (int r = 0; r < 16; ++r) ps += p1[r];
    { auto rr = __builtin_amdgcn_permlane32_swap(__float_as_uint(ps), __float_as_uint(ps), false, false);
      ps = __uint_as_float(rr[0]) + __uint_as_float(rr[1]); }
    l_reg = l_reg * alpha + ps;
#define PK4(P, B_, OUT) do { unsigned a0 = cvtpk(P[B_+0], P[B_+1]), a1 = cvtpk(P[B_+2], P[B_+3]);                          \
        unsigned b0 = cvtpk(P[B_+4], P[B_+5]), b1 = cvtpk(P[B_+6], P[B_+7]);                                             \
        auto r0 = __builtin_amdgcn_permlane32_swap(a0, b0, false, false); auto r1 = __builtin_amdgcn_permlane32_swap(a1, b1, false, false); \
        u32x4 w = {r0[0], r1[0], r0[1], r1[1]}; OUT = *reinterpret_cast<bf16x8*>(&w); } while (0)
    PK4(p0, 0, pa0); PK4(p0, 8, pa1); PK4(p1, 0, pa2); PK4(p1, 8, pa3);
#undef PK4
}
template <int VAR, int KB>
__device__ __forceinline__ void qkt(f32x16& p0, f32x16& p1, const LAS unsigned char* lds, int r32, int hi, int lane, int wid, int map, const bf16x8* qr) {
    if (VAR == 0) {
        const LAS float* kb = (const LAS float*)(lds + L_KB) + KB * 64 + 4 * hi;
#pragma unroll
        for (int g = 0; g < 4; ++g) { const f32x4 a = *(const LAS f32x4*)(kb + 8 * g), b = *(const LAS f32x4*)(kb + 32 + 8 * g);
            p0[4 * g] = a[0]; p0[4 * g + 1] = a[1]; p0[4 * g + 2] = a[2]; p0[4 * g + 3] = a[3]; p1[4 * g] = b[0]; p1[4 * g + 1] = b[1]; p1[4 * g + 2] = b[2]; p1[4 * g + 3] = b[3]; }
    } else { p0 = f32x16{}; p1 = f32x16{}; }
    const LAS unsigned char* kbp[4];
#pragma unroll
    for (int dd = 0; dd < 4; ++dd) kbp[dd] = lds + L_K + KB * SHM_K + KSWZ(r32, (dd * 16 + hi * 8) * 2) + (VAR == 2 ? map * 128 : 0);
#pragma unroll
    for (int d0 = 0; d0 < VT<VAR>::NQ; ++d0) { const LAS unsigned char* a = kbp[d0 & 3] + (d0 >> 2) * 128;
        const bf16x8 b0 = *(const LAS bf16x8*)a, b1 = *(const LAS bf16x8*)(a + 32 * 256);
        __builtin_amdgcn_s_setprio(1);
        p0 = __builtin_amdgcn_mfma_f32_32x32x16_bf16(b0, qr[d0], p0, 0, 0, 0);
        p1 = __builtin_amdgcn_mfma_f32_32x32x16_bf16(b1, qr[d0], p1, 0, 0, 0);
        __builtin_amdgcn_s_setprio(0); }
    if (VAR == 1) {
        const int s = (r32 >> 1) & 7;
#pragma unroll
        for (int d0 = 0; d0 < 4; ++d0) { const LAS unsigned char* a = lds + L_KR + KB * SHM_KR + r32 * 128 + (((2 * d0 + hi) ^ s) << 4);
            const bf16x8 b0 = *(const LAS bf16x8*)a, b1 = *(const LAS bf16x8*)(a + 32 * 128);
            const bf16x8 q = *(const LAS bf16x8*)(lds + L_QR + wid * 4096 + d0 * 1024 + lane * 16);
            p0 = __builtin_amdgcn_mfma_f32_32x32x16_bf16(b0, q, p0, 0, 0, 0);
            p1 = __builtin_amdgcn_mfma_f32_32x32x16_bf16(b1, q, p1, 0, 0, 0); }
    }
}
template <int VB>
__device__ __forceinline__ void pv_tile(f32x16* o, int vb0, bf16x8 pa0, bf16x8 pa1, bf16x8 pa2, bf16x8 pa3) {
#define TRRD(dst, off) asm volatile("ds_read_b64_tr_b16 %0, %1 offset:%2" : "=&v"(dst) : "v"(vb0), "i"(off) : "memory")
#define PV_D0(d0) do { s16x4 l0, l1, l2, l3, h0, h1, h2, h3; constexpr int b_ = VB * SHM_V + v_rd_off(d0, 0, 0); \
        TRRD(l0, b_); TRRD(h0, b_ + 2048); TRRD(l1, b_ + 4096); TRRD(h1, b_ + 6144); TRRD(l2, b_ + 8192); TRRD(h2, b_ + 10240); TRRD(l3, b_ + 12288); TRRD(h3, b_ + 14336); \
        asm volatile("s_waitcnt lgkmcnt(0)" ::: "memory"); SBAR(); __builtin_amdgcn_s_setprio(1);   \
        o[d0] = __builtin_amdgcn_mfma_f32_32x32x16_bf16(pa0, (bf16x8){l0[0], l0[1], l0[2], l0[3], h0[0], h0[1], h0[2], h0[3]}, o[d0], 0, 0, 0);   \
        o[d0] = __builtin_amdgcn_mfma_f32_32x32x16_bf16(pa1, (bf16x8){l1[0], l1[1], l1[2], l1[3], h1[0], h1[1], h1[2], h1[3]}, o[d0], 0, 0, 0);   \
        o[d0] = __builtin_amdgcn_mfma_f32_32x32x16_bf16(pa2, (bf16x8){l2[0], l2[1], l2[2], l2[3], h2[0], h2[1], h2[2], h2[3]}, o[d0], 0, 0, 0);   \
        o[d0] = __builtin_amdgcn_mfma_f32_32x32x16_bf16(pa3, (bf16x8){l3[0], l3[1], l3[2], l3[3], h3[0], h3[1], h3[2], h3[3]}, o[d0], 0, 0, 0); __builtin_amdgcn_s_setprio(0); } while (0)
    PV_D0(0); PV_D0(1); PV_D0(2); PV_D0(3);
#undef PV_D0
#undef TRRD
}

template <int VAR>
__device__ __forceinline__ void attn_unit(unsigned char* ws, const float* relb, const float* subg, float lam, float lam1m, int b, int h, int qb, LAS unsigned char* lds) {
    typedef VT<VAR> T; constexpr float SCALE = T::SCALE;
    int tid_ = threadIdx.x; asm volatile("" : "+v"(tid_));
    const int tid = tid_, wid = __builtin_amdgcn_readfirstlane(tid >> 6), lane = tid & 63, r32 = lane & 31, hi = lane >> 5;
    const int wq = VAR == 2 ? (wid & 3) : wid, map = VAR == 2 ? (wid >> 2) : 0;
    const int P0 = qb * T::QROWS, qlo = P0 + wq * 32, NT = (P0 + T::QROWS) / KVBLK;
    const size_t rowb = (size_t)b * SEQ;
    const bf16* Qp; const bf16* Kp; const bf16* Vp; int gcol;
    if (VAR == 0) { Qp = (const bf16*)(ws + WS_AQ) + (rowb + qlo + r32) * 768 + 128 * h; Kp = (const bf16*)(ws + WS_AK) + rowb * 768 + 128 * h; Vp = (const bf16*)(ws + WS_AV) + rowb * 768 + 128 * h; gcol = 128 * h; }
    else if (VAR == 1) { Qp = (const bf16*)(ws + WS_QB) + (rowb + qlo + r32) * 1152 + 192 * h; Kp = (const bf16*)(ws + WS_KB) + rowb * 1152 + 192 * h; Vp = (const bf16*)(ws + WS_VB) + rowb * 768 + 128 * h; gcol = 768 + 128 * h; }
    else { Qp = (const bf16*)(ws + WS_CQ2) + (rowb + qlo + r32) * 512 + 128 * h + 64 * map; Kp = (const bf16*)(ws + WS_CK2) + rowb * 512 + 128 * h; Vp = (const bf16*)(ws + WS_CV) + rowb * 512 + 128 * h; gcol = 1536 + 128 * h; }
    const float* cum = (const float*)(ws + WS_CUMT) + (size_t)(b * 6 + h) * SEQ;
    LAS unsigned char* V_lds = lds + L_V; LAS unsigned char* K_lds = lds + L_K;
    LAS float* wsf = (LAS float*)(lds + L_WS) + wid * 64; LAS float* li_l = wsf; LAS float* al_l = wsf + 32;
    const float cqr = VAR == 0 ? cum[qlo + r32] * (1.0f / SCALE) : 0.f;
    float m_reg = VAR == 0 ? 0.f : -1e30f, l_reg = 0; f32x16 o[4] = {};
    const int sr = tid >> 4, sc = (tid & 15) * 8, vst0 = v_st(sr, sc), vst1 = v_st(32 + sr, sc), kws = KSWZ(sr, sc * 2);
    const int krr = tid >> 3, krc = tid & 7, krw = krr * 128 + ((krc ^ ((krr >> 1) & 7)) << 4);
    const int vb0 = (int)(uintptr_t)V_lds + v_rd_base(lane);
    bf16x8 qr[T::NQ];
#pragma unroll
    for (int d0 = 0; d0 < T::NQ; ++d0) qr[d0] = *(const bf16x8*)(Qp + d0 * 16 + hi * 8);
    if (VAR == 1) {
#pragma unroll
        for (int d0 = 0; d0 < 4; ++d0) *(LAS bf16x8*)(lds + L_QR + wid * 4096 + d0 * 1024 + lane * 16) = *(const bf16x8*)(Qp + 128 + d0 * 16 + hi * 8);
    }
    if (VAR == 2) { if (tid < 320) { const int rel = tid - 255; ((LAS float*)(lds + L_T5))[tid] = relb[t5_bucket(rel) * 4 + h] * (1.0f / SCALE); } }
    bf16x8 st_v0, st_v1, st_k0, st_k1, st_kr; float st_kb = 0.f;
#define ROWP(p, pitch, k0, rr) ((p) + (size_t)((k0) + (rr)) * (pitch) + sc)
#define VMW() asm volatile("s_waitcnt vmcnt(0)" ::: "memory")
#define SLOAD(k0) do { st_v0 = *(const bf16x8*)ROWP(Vp, T::PV, k0, sr); st_v1 = *(const bf16x8*)ROWP(Vp, T::PV, k0, 32 + sr);              \
                       st_k0 = *(const bf16x8*)ROWP(Kp, T::PK, k0, sr); st_k1 = *(const bf16x8*)ROWP(Kp, T::PK, k0, 32 + sr);              \
                       if (VAR == 1) st_kr = *(const bf16x8*)(Kp + (size_t)((k0) + krr) * 1152 + 128 + krc * 8);                            \
                       if (VAR == 0) { if (tid < 64) st_kb = cum[(k0) + tid]; } } while (0)
#define SWRITE(bf) do { *(LAS bf16x8*)(V_lds + (bf) * SHM_V + vst0) = st_v0; *(LAS bf16x8*)(V_lds + (bf) * SHM_V + vst1) = st_v1;         \
                        *(LAS bf16x8*)(K_lds + (bf) * SHM_K + kws) = st_k0; *(LAS bf16x8*)(K_lds + (bf) * SHM_K + kws + 32 * 256) = st_k1; \
                        if (VAR == 1) *(LAS bf16x8*)(lds + L_KR + (bf) * SHM_KR + krw) = st_kr;                                             \
                        if (VAR == 0) { if (tid < 64) ((LAS float*)(lds + L_KB))[(bf) * 64 + tid] = -st_kb * (1.0f / SCALE); } } while (0)
#define RESC(a) do { if (__any((a) < 1.f)) { if (hi == 0) al_l[r32] = (a); asm volatile("s_waitcnt lgkmcnt(0)" ::: "memory");              \
                     _Pragma("unroll") for (int d_ = 0; d_ < 4; ++d_) _Pragma("unroll") for (int r = 0; r < 16; ++r) o[d_][r] *= al_l[crow(r, hi)]; } } while (0)
#define KBASE(t) ((t) * KVBLK)
    const int qm = qlo + r32 - 4 * hi;
    const int t5b = (-qlo - r32 + 4 * hi + 255) * 4;
    const float b15 = VAR == 2 ? relb[15 * 4 + h] * (1.0f / SCALE) : 0.f;
#define MODIFY(P0_, P1_, t) do { const int kb_ = KBASE(t);                                                                               \
        if (VAR == 0) { if (kb_ + KVBLK - 1 > qlo) mask_causal(P0_, P1_, qm - kb_); }                                                   \
        else { if (kb_ > (qlo & ~63)) { _Pragma("unroll") for (int r = 0; r < 16; ++r) { P0_[r] = -__builtin_inff(); P1_[r] = -__builtin_inff(); } }   \
               else if (VAR == 2) { if (kb_ + 63 - qlo > -91) { const LAS unsigned char* tp = lds + L_T5 + t5b + kb_ * 4;                               \
                       _Pragma("unroll") for (int r = 0; r < 16; ++r) { const int c = (r & 3) + 8 * (r >> 2); P0_[r] += *(const LAS float*)(tp + c * 4); P1_[r] += *(const LAS float*)(tp + (c + 32) * 4); } } \
                   else { _Pragma("unroll") for (int r = 0; r < 16; ++r) { P0_[r] += b15; P1_[r] += b15; } } } } } while (0)
    f32x16 pA0, pA1, pB0, pB1; float mnA, mnB, alA, alB; bf16x8 pa0, pa1, pa2, pa3;
    SLOAD(0); VMW(); SWRITE(0);
    __syncthreads();
    SLOAD(KBASE(1));
    SBAR(); qkt<VAR, 0>(pA0, pA1, lds, r32, hi, lane, wid, map, qr);
    MODIFY(pA0, pA1, 0); partialSM<VAR>(pA0, pA1, m_reg, mnA, alA, cqr);
    VMW(); SWRITE(1);
    __syncthreads();
#define HALF_STEP(PX0, PX1, mnX, alX, PY0, PY1, alY, t, KB, VB, SB) do {                                                      \
        SBAR(); qkt<VAR, KB>(PX0, PX1, lds, r32, hi, lane, wid, map, qr);                                                     \
        finishSM(PY0, PY1, alY, l_reg, pa0, pa1, pa2, pa3); SBAR();                                                           \
        SLOAD(KBASE((t) + 1)); SBAR();                                                                                        \
        pv_tile<VB>(o, vb0, pa0, pa1, pa2, pa3); MODIFY(PX0, PX1, (t)); partialSM<VAR>(PX0, PX1, m_reg, mnX, alX, cqr);            \
        __syncthreads();                                                                                                      \
        VMW(); SWRITE(SB);                                                                                                    \
        RESC(alX); __syncthreads(); } while (0)
    for (int t = 1; t + 1 < NT; t += 2) {
        HALF_STEP(pB0, pB1, mnB, alB, pA0, pA1, alA, t, 1, 0, 0);
        HALF_STEP(pA0, pA1, mnA, alA, pB0, pB1, alB, t + 1, 0, 1, 1);
    }
    SBAR(); qkt<VAR, 1>(pB0, pB1, lds, r32, hi, lane, wid, map, qr); SBAR();
    finishSM(pA0, pA1, alA, l_reg, pa0, pa1, pa2, pa3); SBAR();
    pv_tile<0>(o, vb0, pa0, pa1, pa2, pa3);
    MODIFY(pB0, pB1, NT - 1); partialSM<VAR>(pB0, pB1, m_reg, mnB, alB, cqr); __syncthreads(); RESC(alB);
    finishSM(pB0, pB1, alB, l_reg, pa0, pa1, pa2, pa3); SBAR(); pv_tile<1>(o, vb0, pa0, pa1, pa2, pa3);
    if (hi == 0) li_l[r32] = l_reg; asm volatile("s_waitcnt lgkmcnt(0)" ::: "memory");
    float rli[16];
#pragma unroll
    for (int r = 0; r < 16; ++r) rli[r] = __builtin_amdgcn_rcpf(li_l[crow(r, hi)]);
    bf16* Gw = (bf16*)(ws + WS_G) + (rowb + qlo) * LDX + gcol;
#define STAGE_OUT(stg) do { const int row_ = lane >> 3, ch_ = lane & 7;                                                                  \
        _Pragma("unroll") for (int half_ = 0; half_ < 2; ++half_) {                                                                    \
            u32x4 gv_[4];                                                                                                              \
            _Pragma("unroll") for (int i_ = 0; i_ < 4; ++i_) gv_[i_] = *(const u32x4*)(Gw + (size_t)(i_ * 8 + row_) * LDX + half_ * 64 + ch_ * 8);   \
            _Pragma("unroll") for (int r = 0; r < 16; ++r) { const int orow = crow(r, hi);                                               \
                (stg)[orow * 64 + r32] = o[2 * half_][r]; (stg)[orow * 64 + 32 + r32] = o[2 * half_ + 1][r]; }                           \
            _Pragma("unroll") for (int i_ = 0; i_ < 4; ++i_) { const LAS float* sp_ = (stg) + (i_ * 8 + row_) * 64 + ch_ * 8;            \
                const f32x4 a_ = *(const LAS f32x4*)sp_, b_ = *(const LAS f32x4*)(sp_ + 4); const u32x4 g_ = gv_[i_]; u32x4 w_;          \
                w_.x = cvtpk(a_[0] * bf2f(g_.x & 0xffff), a_[1] * bf2f(g_.x >> 16)); w_.y = cvtpk(a_[2] * bf2f(g_.y & 0xffff), a_[3] * bf2f(g_.y >> 16));   \
                w_.z = cvtpk(b_[0] * bf2f(g_.z & 0xffff), b_[1] * bf2f(g_.z >> 16)); w_.w = cvtpk(b_[2] * bf2f(g_.w & 0xffff), b_[3] * bf2f(g_.w >> 16));   \
                *(u32x4*)(Gw + (size_t)(i_ * 8 + row_) * LDX + half_ * 64 + ch_ * 8) = w_; } } } while (0)
    if (VAR != 2) {
#pragma unroll
        for (int r = 0; r < 16; ++r) {
#pragma unroll
            for (int d0 = 0; d0 < 4; ++d0) o[d0][r] *= rli[r]; }
        __syncthreads();
        LAS float* stg = (LAS float*)(lds + wid * 8192);
        STAGE_OUT(stg);
        __syncthreads();
    } else {
        LAS float* cmb = (LAS float*)(lds + L_CMB) + wq * 4096;
        __syncthreads();
        if (map == 1) {
#pragma unroll
            for (int r = 0; r < 16; ++r) { const int orow = crow(r, hi); const float f = rli[r] * lam;
#pragma unroll
                for (int d0 = 0; d0 < 4; ++d0) cmb[orow * 128 + d0 * 32 + r32] = o[d0][r] * f; }
        }
        __syncthreads();
        if (map == 0) {
            float sg[4];
#pragma unroll
            for (int d0 = 0; d0 < 4; ++d0) sg[d0] = subg[d0 * 32 + r32];
#pragma unroll
            for (int r = 0; r < 16; ++r) { const int orow = crow(r, hi); float s = 0.f;
#pragma unroll
                for (int d0 = 0; d0 < 4; ++d0) { const float c = o[d0][r] * rli[r] - cmb[orow * 128 + d0 * 32 + r32]; o[d0][r] = c; s += c * c; }
#pragma unroll
                for (int x = 1; x < 32; x <<= 1) s += __shfl_xor(s, x);
                const float rn = rsqrtf(s * (1.0f / 128.0f) + EPS) * lam1m;
#pragma unroll
                for (int d0 = 0; d0 < 4; ++d0) o[d0][r] *= rn * sg[d0]; }
            LAS float* stg = cmb;
            STAGE_OUT(stg);
        }
        __syncthreads();
    }
#undef STAGE_OUT
#undef ROWP
#undef VMW
#undef SLOAD
#undef SWRITE
#undef RESC
#undef KBASE
#undef MODIFY
#undef HALF_STEP
}

struct OrderTab { unsigned short v[1280]; };
constexpr OrderTab make_order() {
    OrderTab t{}; int n = 0;
    for (int c = 320; c >= 1; --c) {
        if (c % 20 == 0 && c / 20 <= 16) { const int qb = c / 20 - 1; for (int bh = 0; bh < 24; ++bh) t.v[n++] = (unsigned short)(1 | (qb << 2) | (bh << 7)); }
        if (c % 16 == 0 && c / 16 <= 16) { const int qb = c / 16 - 1; for (int bh = 0; bh < 24; ++bh) t.v[n++] = (unsigned short)(0 | (qb << 2) | (bh << 7)); }
        if (c % 7 == 0 && c / 7 <= 32) { const int qb = c / 7 - 1; for (int bh = 0; bh < 16; ++bh) t.v[n++] = (unsigned short)(2 | (qb << 2) | (bh << 7)); }
    }
    return t;
}
__device__ const OrderTab g_order = make_order();
static_assert(make_order().v[1279] != 0 || true, "order table");
}

__device__ __forceinline__ void p3_attention(const Args& args, int layer, LAS unsigned char* lds) {
    const int tid_o = opaque_tid(); const int lane = tid_o & 63;
    const float lam_init = 0.8f - 0.6f * expf(-0.3f * (float)layer);
    const float d1 = wave_sum(args.in[8][layer * 64 + lane] * args.in[9][layer * 64 + lane]), d2 = wave_sum(args.in[10][layer * 64 + lane] * args.in[11][layer * 64 + lane]);
    const float lam = expf(d1) - expf(d2) + lam_init;
    unsigned* ctr = (unsigned*)(args.ws + WS_CTL) + 64 * (1 + layer);
    volatile LAS unsigned* flag = (volatile LAS unsigned*)(lds + att::L_FLAG);
    for (;;) {
        if (tid_o == 0) flag[0] = atomicAdd(ctr, 1u);
        __syncthreads();
        const unsigned idx = flag[0];
        if (idx >= 1280u) break;
        const unsigned code = att::g_order.v[idx]; const int type = code & 3, qb = (code >> 2) & 31, bh = code >> 7;
        if (type == 0) att::attn_unit<0>(args.ws, args.in[13], args.in[12] + layer * 128, lam, 1.0f - lam_init, bh / 6, bh % 6, qb, lds);
        else if (type == 1) att::attn_unit<1>(args.ws, args.in[13], args.in[12] + layer * 128, lam, 1.0f - lam_init, bh / 6, bh % 6, qb, lds);
        else att::attn_unit<2>(args.ws, args.in[13], args.in[12] + layer * 128, lam, 1.0f - lam_init, bh >> 2, bh & 3, qb, lds);
    }
    __syncthreads();
}

__device__ __forceinline__ void p5_final(const Args& args) {
    const int tid_o = opaque_tid();
    const int gw = C_bid * NWAVES + C_wave, NGW = C_G * NWAVES, lane = C_lane;
    for (int m = gw; m < M; m += NGW) {
        float s = lane < 32 ? WSP(float, WS_XSS)[(size_t)m * 32 + lane] : 0.f; s = wave_sum(s);
        const float r = rsqrtf(s * (1.0f / 2048.0f) + EPS);
        f32x4* xr = (f32x4*)(args.out + (size_t)m * DM) + lane; const f32x4* gr = (const f32x4*)args.in[15] + lane;
#pragma unroll
        for (int j = 0; j < 8; ++j) { const f32x4 v = xr[64 * j], g = gr[64 * j]; xr[64 * j] = v * r * g; }
    }
}

typedef GAS unsigned gu32;
#define RLX_AGENT __ATOMIC_RELAXED, __HIP_MEMORY_SCOPE_AGENT
constexpr int CW_BAR = 4096;
constexpr int LDS_BARST = RING_BYTES;
#define XB_TMO      128
#define XB_XCNT(j)  (256  + 64 * (j))
#define XB_XSUB(j)  (1280 + 64 * (j))
#define XB_XGEN(j)  (2304 + 64 * (j))
#define XB_TOP      3328
#define XB_TOPGEN   3392
#define XCD_BAR_WORDS 3456
#define XB_SPIN_CAP (1u << 18)

__device__ __forceinline__ unsigned xb_ld(unsigned* p)              { return __hip_atomic_load(p, __ATOMIC_RELAXED, __HIP_MEMORY_SCOPE_AGENT); }
__device__ __forceinline__ unsigned xb_add(unsigned* p, unsigned v) { return __hip_atomic_fetch_add(p, v, __ATOMIC_RELAXED, __HIP_MEMORY_SCOPE_AGENT); }
__device__ __forceinline__ unsigned xb_xcc_id() { return (unsigned)__builtin_amdgcn_s_getreg((3 << 11) | 20) & 0xFu; }
#define XB_SPIN(cond, bar) do { unsigned _sp = 0; while (cond) { __builtin_amdgcn_s_sleep(1); \
    if ((++_sp & 255u) == 0u) { if (xb_ld(&(bar)[XB_TMO])) break; if (_sp > XB_SPIN_CAP) { atomicAdd(&(bar)[XB_TMO], 1u); break; } } } } while (0)

struct XcdBarrier {
    unsigned* bar; unsigned x;
    volatile LAS unsigned* st;
};

__device__ __forceinline__ XcdBarrier xcd_barrier_post(unsigned* bar, volatile LAS unsigned* st) {
    XcdBarrier b; b.bar = bar; b.x = xb_xcc_id(); b.st = st;
    if (threadIdx.x == 0) (void)xb_add(&bar[XB_XCNT(b.x)], 1u);
    return b;
}
__device__ __forceinline__ void xcd_barrier_complete(unsigned* bar, unsigned x, unsigned& nloc, unsigned& nx) {
    const unsigned G = gridDim.x * gridDim.y * gridDim.z;
    unsigned sum, cnt, mine, sp = 0u;
    for (;;) {
        sum = 0u; cnt = 0u; mine = 0u;
#pragma unroll
        for (unsigned j = 0; j < 16; ++j) { const unsigned c = xb_ld(&bar[XB_XCNT(j)]); sum += c; cnt += (c > 0u) ? 1u : 0u; mine = (j == x) ? c : mine; }
        if (sum == G) break;
        __builtin_amdgcn_s_sleep(1);
        if ((++sp & 255u) == 0u) { if (xb_ld(&bar[XB_TMO])) break; if (sp > XB_SPIN_CAP) { atomicAdd(&bar[XB_TMO], 1u); break; } }
    }
    nloc = mine > 0u ? mine : 1u; nx = cnt > 0u ? cnt : 1u;
}

__device__ __forceinline__ void xcd_barrier(const XcdBarrier& b) {
    asm volatile("s_waitcnt vmcnt(0)" ::: "memory");
    __syncthreads();
    if (threadIdx.x == 0) {
        unsigned* bar = b.bar;
        __builtin_amdgcn_s_waitcnt(0);
        unsigned nloc = b.st[0], nx = b.st[1];
        if (nloc == 0u) { xcd_barrier_complete(bar, b.x, nloc, nx); b.st[0] = nloc; b.st[1] = nx; }
        const unsigned old = xb_add(&bar[XB_XSUB(b.x)], 1u);
        const unsigned gen = old / nloc;
        if (old + 1u == (gen + 1u) * nloc) {
            __builtin_amdgcn_fence(__ATOMIC_RELEASE, "agent");
            asm volatile("s_waitcnt vmcnt(0)" ::: "memory");
            const unsigned og = xb_add(&bar[XB_TOP], 1u);
            const unsigned tg = og / nx;
            if (og + 1u == (tg + 1u) * nx) xb_add(&bar[XB_TOPGEN], 1u);
            else XB_SPIN(xb_ld(&bar[XB_TOPGEN]) == tg, bar);
            __builtin_amdgcn_fence(__ATOMIC_ACQUIRE, "agent");
            xb_add(&bar[XB_XGEN(b.x)], 1u);
            asm volatile("s_waitcnt vmcnt(0)" ::: "memory");
        } else {
            XB_SPIN(xb_ld(&bar[XB_XGEN(b.x)]) == gen, bar);
            __builtin_amdgcn_fence(__ATOMIC_ACQUIRE, "agent");
            asm volatile("s_waitcnt vmcnt(0)" ::: "memory");
        }
    }
    __syncthreads();
}

#ifndef PROBE_REP1
#define PROBE_REP1 0
#endif
#ifndef PROBE_REP4
#define PROBE_REP4 0
#endif
#ifndef MK_NAIVE_ATTN
#define MK_NAIVE_ATTN 0
#endif
#ifndef MK_FUSED
#define MK_FUSED 1
#endif
constexpr int N_PHASES = 10;

__global__ void __launch_bounds__(NTHREADS, 2) fwd_kernel(Args args) {
    extern __shared__ __attribute__((aligned(16))) unsigned char lds_raw[];
    LAS unsigned char* lds = (LAS unsigned char*)lds_raw;
    const int lo = args.ph_lo, hi = args.ph_hi;
#if MK_FUSED
    if (threadIdx.x < 4) ((LAS unsigned*)(lds + LDS_BARST))[threadIdx.x] = 0u;
    __syncthreads();
    XcdBarrier bar = xcd_barrier_post((unsigned*)(args.ws + WS_CTL) + CW_BAR, (volatile LAS unsigned*)(lds + LDS_BARST));
#endif
#ifndef PH_MASK
#define PH_MASK 0x3ff
#endif
#define IN(k) (((PH_MASK >> ((k) > 4 ? (k) - 4 : (k))) & 1) && lo <= (k) && (k) < hi)
#if MK_FUSED
#define SEAM(k) do { if (IN(k) && IN((k) + 1)) { if ((k) == 0) cg::this_grid().sync(); else xcd_barrier(bar); } } while (0)
#else
#define SEAM(k) do { } while (0)
#endif
    if (IN(0)) { p0_prologue(args, lds); __syncthreads(); }
    SEAM(0);
#pragma unroll 1
    for (int l = 0; l < DEPTH; ++l) {
        const int pb = 1 + 4 * l;
        if (IN(pb)) {
            pg8::Gemm g{WSP(bf16, WS_XB), (const bf16*)(args.ws + WS_WIN + (size_t)l * WIN_BYTES), M, NIN_PAD, DM, LDX, LDX}; pg8::StaticOrder S; S.init(M, NIN_PAD, C_G, C_bid);
            pg8::EpiIn E{args.ws, args.in[3] + l * 6};
            pg8::gemm_phase<pg8::EpiIn, pg8::StaticOrder, true, true>(lds, g, S, E);
#if PROBE_REP1
            if (l == 0) { __syncthreads(); pg8::gemm_phase<pg8::EpiIn, pg8::StaticOrder, true, true>(lds, g, S, E); }
#endif
        }
        SEAM(pb);
        if (IN(pb + 1)) {
            p2_scan(args);
            { pg8::Gemm g{WSP(bf16, WS_CQ), WSP(bf16, WS_WUQ) + (size_t)l * NUQ_PAD * 512, M, NUQ_PAD, 512, 512, 512}; pg8::StaticOrder S; S.init(M, NUQ_PAD, C_G, C_bid);
              pg8::EpiUq E{args.ws};
              pg8::gemm_phase<pg8::EpiUq, pg8::StaticOrder, true, true>(lds, g, S, E); }
            { pg8::Gemm g{WSP(bf16, WS_CKV), WSP(bf16, WS_WUKV) + (size_t)l * NUKV * 256, M, NUKV, 256, 256, 256}; pg8::StaticOrder S; S.init(M, NUKV, C_G, (C_bid + 128) % C_G);
              pg8::EpiUkv E{args.ws};
              pg8::gemm_phase<pg8::EpiUkv, pg8::StaticOrder, true, true>(lds, g, S, E); }
        }
        SEAM(pb + 1);
        if (IN(pb + 2)) {
#if MK_NAIVE_ATTN
            p3_naive(args, l, lds); __syncthreads();
#else
            p3_attention(args, l, lds);
#endif
        }
        SEAM(pb + 2);
        if (IN(pb + 3)) {
            pg8::Gemm g{WSP(bf16, WS_G), (const bf16*)(args.ws + WS_WOUT + (size_t)l * WOUT_BYTES), M, DM, DM, LDX, LDX}; pg8::StaticOrder S; S.init(M, DM, C_G, C_bid);
            pg8::EpiOut E{l == 0 ? args.in[0] : args.out, args.out, args.ws, l + 1 < DEPTH};
            pg8::gemm_phase<pg8::EpiOut, pg8::StaticOrder, true, true>(lds, g, S, E);
#if PROBE_REP4
            if (l == 0) { __syncthreads(); pg8::gemm_phase<pg8::EpiOut, pg8::StaticOrder, true, true>(lds, g, S, E); }
#endif
        }
        SEAM(pb + 3);
    }
    if (IN(9)) p5_final(args);
#undef IN
#undef SEAM
}

extern "C" void kernel_launch(void* const* d_in, const int* in_sizes, int n_in, void* d_out, int out_size, void* d_ws, size_t ws_size, hipStream_t stream) {
    static int grid = 0;
    if (grid == 0) {
        if (n_in != 16 || in_sizes[0] != M * DM || out_size != M * DM || ws_size < WS_END) {
            fprintf(stderr, "kernel_launch: unexpected shapes (n_in %d, in0 %d, out %d, ws %zu; need ws >= %zu)\n", n_in, n_in > 0 ? in_sizes[0] : -1, out_size, ws_size, (size_t)WS_END); grid = -1; return; }
        int dev = 0, cus = 0, per_cu = 0;
        if (hipGetDevice(&dev) != hipSuccess || hipDeviceGetAttribute(&cus, hipDeviceAttributeMultiprocessorCount, dev) != hipSuccess) { fprintf(stderr, "kernel_launch: device query failed\n"); grid = -1; return; }
        if (hipFuncSetAttribute((const void*)fwd_kernel, hipFuncAttributeMaxDynamicSharedMemorySize, LDS_BYTES) != hipSuccess) { fprintf(stderr, "kernel_launch: hipFuncSetAttribute failed\n"); grid = -1; return; }
        if (hipOccupancyMaxActiveBlocksPerMultiprocessor(&per_cu, (const void*)fwd_kernel, NTHREADS, LDS_BYTES) != hipSuccess || per_cu < 1) {
            fprintf(stderr, "kernel_launch: occupancy query reports %d blocks per CU\n", per_cu); (void)hipGetLastError(); grid = -1; return; }
        grid = cus;
    }
    if (grid < 0) return;
    if (hipMemsetAsync((char*)d_ws + WS_CTL, 0, 65536, stream) != hipSuccess) { fprintf(stderr, "kernel_launch: memset failed\n"); return; }
    Args a{};
    for (int i = 0; i < 16; ++i) a.in[i] = (const float*)d_in[i];
    a.out = (float*)d_out; a.ws = (unsigned char*)d_ws;
#if MK_FUSED
    a.ph_lo = 0; a.ph_hi = N_PHASES;
    void* kargs[] = {&a};
    hipError_t e = hipLaunchCooperativeKernel((const void*)fwd_kernel, dim3(grid), dim3(NTHREADS), kargs, LDS_BYTES, stream);
    if (e != hipSuccess) fprintf(stderr, "kernel_launch: cooperative launch failed: %s (grid %d)\n", hipGetErrorString(e), grid);
#else
    for (int p = 0; p < N_PHASES; ++p) {
        a.ph_lo = p; a.ph_hi = p + 1;
        hipLaunchKernelGGL(fwd_kernel, dim3(grid), dim3(NTHREADS), LDS_BYTES, stream, a);
    }
#endif
}
```

```cpp
#include <hip/hip_runtime.h>
#include <hip/hip_cooperative_groups.h>
#include <cstdio>
#include <cstdint>
#include <cmath>
namespace cg = cooperative_groups;

constexpr int NB = 4, SEQ = 4096, DM = 2048, M = NB * SEQ, DEPTH = 2;
constexpr int NIN = 6726, NIN_PAD = 6912;
constexpr int NUQ_PAD = 1280, NUKV = 1536;
constexpr int LDX = 2112;
constexpr float EPS = 1e-6f;

constexpr size_t MiB = 1u << 20;
constexpr size_t WIN_BYTES = 28 * MiB, WOUT_BYTES = 9 * MiB;
constexpr size_t WS_CTL = 0, CTL_ZERO_BYTES = 1 * MiB;
constexpr size_t WS_WIN = 1 * MiB;
constexpr size_t WS_WUQ = WS_WIN + 56 * MiB;
constexpr size_t WS_WUKV = WS_WUQ + 5 * MiB / 2;
constexpr size_t WS_WOUT = WS_WUKV + 3 * MiB / 2;
constexpr size_t WS_ROPE = WS_WOUT + 18 * MiB;
constexpr size_t WS_XSS = WS_ROPE + 1 * MiB;
constexpr size_t WS_LOGF = WS_XSS + 2 * MiB;
constexpr size_t WS_CUMT = WS_LOGF + MiB / 2;
constexpr size_t WS_CQSS = WS_CUMT + MiB / 2;
constexpr size_t WS_CKVSS = WS_CQSS + MiB / 2;
constexpr size_t WS_XB = WS_CKVSS + MiB / 2;
constexpr size_t WS_G = WS_XB + 66 * MiB;
constexpr size_t WS_AQ = WS_G + 66 * MiB, WS_AK = WS_AQ + 24 * MiB, WS_AV = WS_AK + 24 * MiB;
constexpr size_t WS_CQ = WS_AV + 24 * MiB;
constexpr size_t WS_CKV = WS_CQ + 16 * MiB;
constexpr size_t WS_QB = WS_CKV + 8 * MiB, WS_KB = WS_QB + 36 * MiB, WS_VB = WS_KB + 36 * MiB;
constexpr size_t WS_CQ2 = WS_VB + 24 * MiB, WS_CK2 = WS_CQ2 + 16 * MiB, WS_CV = WS_CK2 + 16 * MiB;
constexpr size_t WS_END = WS_CV + 16 * MiB;
static_assert(WS_END <= 512 * MiB, "workspace map");

constexpr int RING_BYTES = 131072, LDS_BYTES = 147456;
constexpr int NWAVES = 8, NTHREADS = 512;

namespace pg8 {
#define PG8_LAS __attribute__((address_space(3)))
typedef unsigned short bf16_t;
typedef short bf16x8 __attribute__((ext_vector_type(8)));
typedef float f32x4 __attribute__((ext_vector_type(4)));
typedef unsigned u32x4 __attribute__((ext_vector_type(4)));
constexpr int BM = 256, BK = 64, HALF = 128, HTB = HALF * BK * 2  , STAGE_BYTES = 8 * HTB, NXCD = 8, WGM = 8;

__host__ __device__ __forceinline__ int lds_byte(int r, int c) { const int st = (r >> 4) * 2 + (c >> 5), rr = r & 15, cc = c & 31, ob = rr * 64 + cc * 2; return st * 1024 + (ob ^ (((ob >> 9) & 1) << 5)); }
__host__ __device__ __forceinline__ void stage_rc(int b, int& R, int& C) { const int st = b / 1024, sb = b % 1024, swz = sb ^ (((sb >> 9) & 1) << 5); R = (st >> 1) * 16 + swz / 64; C = (st & 1) * 32 + (swz % 64) / 2; }
__host__ __device__ __forceinline__ int perm32(int rho) { const int n = rho >> 4, i = rho & 15; return 8 * (i >> 2) + 4 * n + (i & 3); }

struct Unit { int pm, pn; };
struct Gemm { const bf16_t* A; const bf16_t* Bt; int M, N, K, lda, ldb; };

struct StaticOrder {
    int nM, nN, nwg, G, c;
    __host__ __device__ void init(int M, int N, int G_, int c_) { nM = M / BM; nN = N / BM; nwg = nM * nN; G = G_; c = c_; }
    __host__ __device__ bool next(int i, Unit& u) const {
        const long L = (long)i * G + c; if (L >= nwg) return false;
        int wgid = (int)L; { const int q = nwg / NXCD, r = nwg % NXCD, xcd = wgid % NXCD, off = wgid / NXCD; wgid = (xcd < r ? xcd * (q + 1) : r * (q + 1) + (xcd - r) * q) + off; }
        const int nig = WGM * nN, gid = wgid / nig, fm = gid * WGM, gsz = (nM - fm) < WGM ? (nM - fm) : WGM;
        u.pm = fm + ((wgid % nig) % gsz); u.pn = (wgid % nig) / gsz; return true;
    }
    __device__ __forceinline__ void a_ready(const Unit&) const {}
    __device__ __forceinline__ void done(const Unit&) const {}
};


__device__ __forceinline__ unsigned cvt_pk_bf16(float lo, float hi) { unsigned r; asm volatile("v_cvt_pk_bf16_f32 %0, %1, %2" : "=v"(r) : "v"(lo), "v"(hi)); return r; }
typedef float f32x2 __attribute__((ext_vector_type(2)));
typedef unsigned u32x2 __attribute__((ext_vector_type(2)));
constexpr float RMS_EPS = 1e-6f;
__device__ __forceinline__ float silu_f(float v) { return v / (1.0f + __expf(-v)); }
__device__ __forceinline__ u32x4 pack8v(f32x4 a, f32x4 b) { u32x4 w; w.x = cvt_pk_bf16(a[0], a[1]); w.y = cvt_pk_bf16(a[2], a[3]); w.z = cvt_pk_bf16(b[0], b[1]); w.w = cvt_pk_bf16(b[2], b[3]); return w; }
__device__ __forceinline__ void rope4(f32x4 v0, f32x4 v1, f32x4 cs, f32x4 sn, u32x2& lo, u32x2& hi) {
    const float a0 = v0[0], b0 = v0[1], a1 = v0[2], b1 = v0[3], a2 = v1[0], b2 = v1[1], a3 = v1[2], b3 = v1[3];
    lo.x = cvt_pk_bf16(a0 * cs[0] - b0 * sn[0], a1 * cs[1] - b1 * sn[1]); lo.y = cvt_pk_bf16(a2 * cs[2] - b2 * sn[2], a3 * cs[3] - b3 * sn[3]);
    hi.x = cvt_pk_bf16(a0 * sn[0] + b0 * cs[0], a1 * sn[1] + b1 * cs[1]); hi.y = cvt_pk_bf16(a2 * sn[2] + b2 * cs[2], a3 * sn[3] + b3 * cs[3]);
}

struct EpiIn {
    static constexpr bool PERM = true, AFTER_DRAIN = false;
    unsigned char* ws;
    const float* bforget;
    __device__ __forceinline__ void operator()(const f32x4 (&acc)[2][2][4][2], const Unit& u, int wr, int wc, int fr, int fq) const {
        const int row0 = u.pm * BM + wr * 64 + fr; const int pn = u.pn;
        const float* xss = (const float*)(ws + WS_XSS);
        float rs[2][4];
#pragma unroll
        for (int ai = 0; ai < 2; ++ai)
#pragma unroll
            for (int m = 0; m < 4; ++m) { const int row = row0 + ai * HALF + m * 16; const f32x4* p = (const f32x4*)(xss + (size_t)row * 32 + fq * 8);
                const f32x4 a = p[0], b = p[1]; float s = ((a[0] + a[1]) + (a[2] + a[3])) + ((b[0] + b[1]) + (b[2] + b[3]));
                s += __shfl_xor(s, 16); s += __shfl_xor(s, 32); rs[ai][m] = rsqrtf(s * (1.0f / 2048.0f) + RMS_EPS); }
        if (pn < 26) {
            size_t doff; int ld, cb, kind = 0; size_t ssoff = 0; int sld = 0, slot = 0;
            if (pn < 3) { doff = WS_AQ; ld = 768; cb = pn * 256; }
            else if (pn < 6) { doff = WS_AK; ld = 768; cb = (pn - 3) * 256; }
            else if (pn < 9) { doff = WS_AV; ld = 768; cb = (pn - 6) * 256; }
            else if (pn < 12) { doff = WS_G; ld = LDX; cb = (pn - 9) * 256; kind = 1; }
            else if (pn < 14) { doff = WS_CQ; ld = 512; cb = (pn - 12) * 256; kind = 2; ssoff = WS_CQSS; sld = 8; slot = (pn - 12) * 4 + wc; }
            else if (pn == 14) { doff = WS_CKV; ld = 256; cb = 0; kind = 2; ssoff = WS_CKVSS; sld = 4; slot = wc; }
            else if (pn < 18) { doff = WS_G; ld = LDX; cb = 768 + (pn - 15) * 256; kind = 1; }
            else if (pn < 20) { doff = WS_CQ2; ld = 512; cb = (pn - 18) * 256; }
            else if (pn < 22) { doff = WS_CK2; ld = 512; cb = (pn - 20) * 256; }
            else if (pn < 24) { doff = WS_CV; ld = 512; cb = (pn - 22) * 256; }
            else { doff = WS_G; ld = LDX; cb = 1536 + (pn - 24) * 256; kind = 1; }
            bf16_t* dst = (bf16_t*)(ws + doff); float* ss = (float*)(ws + ssoff);
            const int col0 = cb + wc * 32 + 8 * fq;
#pragma unroll
            for (int ai = 0; ai < 2; ++ai)
#pragma unroll
                for (int m = 0; m < 4; ++m) { const int row = row0 + ai * HALF + m * 16; bf16_t* rowp = dst + (size_t)row * ld + col0; const float r = rs[ai][m]; float sq = 0.f;
#pragma unroll
                    for (int bj = 0; bj < 2; ++bj) { f32x4 v0 = acc[ai][bj][m][0] * r, v1 = acc[ai][bj][m][1] * r;
                        if (kind == 1) {
#pragma unroll
                            for (int j = 0; j < 4; ++j) { v0[j] = silu_f(v0[j]); v1[j] = silu_f(v1[j]); } }
                        if (kind == 2) sq += ((v0[0] * v0[0] + v0[1] * v0[1]) + (v0[2] * v0[2] + v0[3] * v0[3])) + ((v1[0] * v1[0] + v1[1] * v1[1]) + (v1[2] * v1[2] + v1[3] * v1[3]));
                        *(u32x4*)(rowp + bj * HALF) = pack8v(v0, v1); }
                    if (kind == 2) { sq += __shfl_xor(sq, 16); sq += __shfl_xor(sq, 32); if (fq == 0) ss[(size_t)row * sld + slot] = sq; } }
        } else {
            if (wc < 2) {
                const int i0 = 16 * wc + 4 * fq; const float* ropeC = (const float*)(ws + WS_ROPE); const float* ropeS = ropeC + 4096 * 32; bf16_t* KB = (bf16_t*)(ws + WS_KB);
#pragma unroll
                for (int ai = 0; ai < 2; ++ai)
#pragma unroll
                    for (int m = 0; m < 4; ++m) { const int row = row0 + ai * HALF + m * 16; const float r = rs[ai][m]; const int t = row & 4095;
                        const f32x4 cs = *(const f32x4*)(ropeC + t * 32 + i0), sn = *(const f32x4*)(ropeS + t * 32 + i0);
                        u32x2 lo, hi; rope4(acc[ai][0][m][0] * r, acc[ai][0][m][1] * r, cs, sn, lo, hi);
                        bf16_t* kp = KB + (size_t)row * 1152 + 128 + i0;
#pragma unroll
                        for (int h = 0; h < 6; ++h) { *(u32x2*)(kp + h * 192) = lo; *(u32x2*)(kp + h * 192 + 32) = hi; }
                        asm volatile("" ::: "memory"); }
            } else if (wc == 2 && fq == 0) {
                float* LOGF = (float*)(ws + WS_LOGF);
                f32x4 b0; b0[0] = bforget[0]; b0[1] = bforget[1]; b0[2] = bforget[2]; b0[3] = bforget[3]; f32x4 b1; b1[0] = bforget[4]; b1[1] = bforget[5]; b1[2] = 0.f; b1[3] = 0.f;
#pragma unroll
                for (int ai = 0; ai < 2; ++ai)
#pragma unroll
                    for (int m = 0; m < 4; ++m) { const int row = row0 + ai * HALF + m * 16; const float r = rs[ai][m];
                        f32x4 z0 = acc[ai][0][m][0] * r + b0, z1 = acc[ai][0][m][1] * r + b1, l0, l1;
#pragma unroll
                        for (int j = 0; j < 4; ++j) { l0[j] = fminf(z0[j], 0.f) - log1pf(__expf(-fabsf(z0[j]))); l1[j] = fminf(z1[j], 0.f) - log1pf(__expf(-fabsf(z1[j]))); }
                        l1[2] = 0.f; l1[3] = 0.f;
                        *(f32x4*)(LOGF + (size_t)row * 8) = l0; *(f32x4*)(LOGF + (size_t)row * 8 + 4) = l1; }
            }
        }
    }
};

struct EpiUq {
    static constexpr bool PERM = true, AFTER_DRAIN = false;
    unsigned char* ws;
    __device__ __forceinline__ void operator()(const f32x4 (&acc)[2][2][4][2], const Unit& u, int wr, int wc, int fr, int fq) const {
        const int row0 = u.pm * BM + wr * 64 + fr; const int pn = u.pn;
        const float* CQSS = (const float*)(ws + WS_CQSS); bf16_t* QB = (bf16_t*)(ws + WS_QB); const float* ropeC = (const float*)(ws + WS_ROPE); const float* ropeS = ropeC + 4096 * 32;
        float rs[2][4];
#pragma unroll
        for (int ai = 0; ai < 2; ++ai)
#pragma unroll
            for (int m = 0; m < 4; ++m) { const int row = row0 + ai * HALF + m * 16; const f32x2 a = *(const f32x2*)(CQSS + (size_t)row * 8 + fq * 2);
                float s = a[0] + a[1]; s += __shfl_xor(s, 16); s += __shfl_xor(s, 32); rs[ai][m] = rsqrtf(s * (1.0f / 512.0f) + RMS_EPS); }
        if (pn < 3) {
#pragma unroll
            for (int ai = 0; ai < 2; ++ai)
#pragma unroll
                for (int m = 0; m < 4; ++m) { const int row = row0 + ai * HALF + m * 16; const float r = rs[ai][m];
#pragma unroll
                    for (int bj = 0; bj < 2; ++bj) { const int h = pn * 2 + bj; bf16_t* p = QB + (size_t)row * 1152 + 192 * h + wc * 32 + 8 * fq;
                        *(u32x4*)p = pack8v(acc[ai][bj][m][0] * r, acc[ai][bj][m][1] * r); } }
        } else {
            const int i0 = 16 * (wc & 1) + 4 * fq;
#pragma unroll
            for (int ai = 0; ai < 2; ++ai)
#pragma unroll
                for (int m = 0; m < 4; ++m) { const int row = row0 + ai * HALF + m * 16; const float r = rs[ai][m]; const int t = row & 4095;
                    const f32x4 cs = *(const f32x4*)(ropeC + t * 32 + i0), sn = *(const f32x4*)(ropeS + t * 32 + i0);
#pragma unroll
                    for (int bj = 0; bj < 2; ++bj) { const int cc = (pn - 3) * 256 + bj * HALF + wc * 32; const int hh = cc >> 6;
                        if (hh < 6) { u32x2 lo, hi; rope4(acc[ai][bj][m][0] * r, acc[ai][bj][m][1] * r, cs, sn, lo, hi);
                            bf16_t* p = QB + (size_t)row * 1152 + 192 * hh + 128 + i0; *(u32x2*)p = lo; *(u32x2*)(p + 32) = hi; } }
                    asm volatile("" ::: "memory"); }
        }
    }
};
struct EpiUkv {
    static constexpr bool PERM = true, AFTER_DRAIN = false;
    unsigned char* ws;
    __device__ __forceinline__ void operator()(const f32x4 (&acc)[2][2][4][2], const Unit& u, int wr, int wc, int fr, int fq) const {
        const int row0 = u.pm * BM + wr * 64 + fr; const int pn = u.pn;
        const float* CKVSS = (const float*)(ws + WS_CKVSS); bf16_t* KB = (bf16_t*)(ws + WS_KB); bf16_t* VB = (bf16_t*)(ws + WS_VB);
#pragma unroll
        for (int ai = 0; ai < 2; ++ai)
#pragma unroll
            for (int m = 0; m < 4; ++m) { const int row = row0 + ai * HALF + m * 16; const f32x4 a = *(const f32x4*)(CKVSS + (size_t)row * 4);
                const float r = rsqrtf(((a[0] + a[1]) + (a[2] + a[3])) * (1.0f / 256.0f) + RMS_EPS);
#pragma unroll
                for (int bj = 0; bj < 2; ++bj) {
                    bf16_t* p;
                    if (pn < 3) p = KB + (size_t)row * 1152 + 192 * (pn * 2 + bj) + wc * 32 + 8 * fq;
                    else p = VB + (size_t)row * 768 + (pn - 3) * 256 + bj * HALF + wc * 32 + 8 * fq;
                    *(u32x4*)p = pack8v(acc[ai][bj][m][0] * r, acc[ai][bj][m][1] * r); } }
    }
};
struct EpiOut {
    static constexpr bool PERM = true, AFTER_DRAIN = false;
    const float* base; float* out; unsigned char* ws; int write_xb;
    __device__ __forceinline__ void operator()(const f32x4 (&acc)[2][2][4][2], const Unit& u, int wr, int wc, int fr, int fq) const {
        const int row0 = u.pm * BM + wr * 64 + fr; const int col0 = u.pn * BM + wc * 32 + 8 * fq;
        bf16_t* XB = (bf16_t*)(ws + WS_XB); float* xss = (float*)(ws + WS_XSS);
#pragma unroll
        for (int ai = 0; ai < 2; ++ai)
#pragma unroll
            for (int m = 0; m < 4; ++m) { const int row = row0 + ai * HALF + m * 16; const size_t off = (size_t)row * 2048 + col0, offb = (size_t)row * LDX + col0; float sq = 0.f;
#pragma unroll
                for (int bj = 0; bj < 2; ++bj) { const f32x4 x0 = *(const f32x4*)(base + off + bj * HALF), x1 = *(const f32x4*)(base + off + bj * HALF + 4);
                    const f32x4 v0 = x0 + acc[ai][bj][m][0], v1 = x1 + acc[ai][bj][m][1];
                    sq += ((v0[0] * v0[0] + v0[1] * v0[1]) + (v0[2] * v0[2] + v0[3] * v0[3])) + ((v1[0] * v1[0] + v1[1] * v1[1]) + (v1[2] * v1[2] + v1[3] * v1[3]));
                    *(f32x4*)(out + off + bj * HALF) = v0; *(f32x4*)(out + off + bj * HALF + 4) = v1;
                    if (write_xb) *(u32x4*)(XB + offb + bj * HALF) = pack8v(v0, v1); }
                sq += __shfl_xor(sq, 16); sq += __shfl_xor(sq, 32); if (fq == 0) xss[(size_t)row * 32 + u.pn * 4 + wc] = sq; }
    }
};

template <class Epi, class Sched, bool ALIGN_EPI = false, bool SP2 = false>
__device__ __forceinline__ void gemm_phase(PG8_LAS unsigned char* lds, const Gemm g, const Sched& S, const Epi& E) {
    int tid_ = threadIdx.x; asm volatile("" : "+v"(tid_));
    const int tid = tid_, wid = __builtin_amdgcn_readfirstlane(tid >> 6), lane = tid & 63, wr = wid >> 2, wc = wid & 3, fr = lane & 15, fq = lane >> 4;
    const int K = g.K, nt = K / BK;
    unsigned voffA[2], voffB[2];
#pragma unroll
    for (int i = 0; i < 2; ++i) { int R, C; stage_rc(tid * 16 + i * 8192, R, C); const int Rb = Epi::PERM ? ((R & ~31) + perm32(R & 31)) : R;
        voffA[i] = (unsigned)(R * g.lda + C) * 2u; voffB[i] = (unsigned)(Rb * g.ldb + C) * 2u; }
    const size_t kstep = (size_t)(BK * 2);
    const size_t hstepA = (size_t)HALF * g.lda * 2, hstepB = (size_t)HALF * g.ldb * 2;
    const size_t tstepA = 2 * hstepA, tstepB = 2 * hstepB;
    const unsigned ldsw = (unsigned)wid * 1024u;
    const int aoff = lds_byte(wr * 64 + fr, fq * 8), boff = lds_byte(wc * 32 + fr, fq * 8);
#define PG8_SA(b, h) (((b) * 2 + (h)) * HTB)
#define PG8_SB(b, h) ((4 + (b) * 2 + (h)) * HTB)
#define PG8_STAGE(bufoff, gbase, voff) do { _Pragma("unroll") for (int _i = 0; _i < 2; ++_i) \
        __builtin_amdgcn_global_load_lds((const unsigned*)((const char*)(gbase) + (voff)[_i]), (PG8_LAS unsigned*)(lds + (bufoff) + ldsw + _i * 8192), 16, 0, 0); } while (0)
#define PG8_LDA(dst, b, h) do { _Pragma("unroll") for (int m = 0; m < 4; ++m) _Pragma("unroll") for (int k = 0; k < 2; ++k) dst[m][k] = *(const PG8_LAS bf16x8*)(lds + PG8_SA(b, h) + aoff + m * 2048 + k * 1024); } while (0)
#define PG8_LDB(dst, b, h) do { _Pragma("unroll") for (int n = 0; n < 2; ++n) _Pragma("unroll") for (int k = 0; k < 2; ++k) dst[n][k] = *(const PG8_LAS bf16x8*)(lds + PG8_SB(b, h) + boff + n * 2048 + k * 1024); } while (0)
#define PG8_MMA(ai, bj, At, Bt) do { __builtin_amdgcn_s_setprio(1); _Pragma("unroll") for (int m = 0; m < 4; ++m) _Pragma("unroll") for (int n = 0; n < 2; ++n) _Pragma("unroll") for (int k = 0; k < 2; ++k) \
        acc[ai][bj][m][n] = __builtin_amdgcn_mfma_f32_16x16x32_bf16(Bt[n][k], At[m][k], acc[ai][bj][m][n], 0, 0, 0); __builtin_amdgcn_s_setprio(0); } while (0)
#define PG8_WAIT_V(n) asm volatile("s_waitcnt vmcnt(" #n ")" ::: "memory")
#define PG8_WAIT_L(n) asm volatile("s_waitcnt lgkmcnt(" #n ")" ::: "memory")
#define PG8_BAR __builtin_amdgcn_s_barrier()
#define PG8_SCHED __builtin_amdgcn_sched_barrier(0)
    Unit cur, nxt; int ui = 0;
    if (!S.next(0, cur)) return;
    f32x4 acc[2][2][4][2];
#pragma unroll
    for (int a = 0; a < 2; ++a)
#pragma unroll
        for (int b = 0; b < 2; ++b)
#pragma unroll
            for (int m = 0; m < 4; ++m)
#pragma unroll
                for (int n = 0; n < 2; ++n) acc[a][b][m][n] = (f32x4){0.f, 0.f, 0.f, 0.f};
    bf16x8 At[4][2], B0[2][2], B1[2][2];
    const char* cA = (const char*)g.A + (size_t)cur.pm * tstepA; const char* cB = (const char*)g.Bt + (size_t)cur.pn * tstepB;
    S.a_ready(cur);
    if constexpr (SP2) {
        PG8_STAGE(PG8_SB(0, 0), cB, voffB); PG8_STAGE(PG8_SB(0, 1), cB + hstepB, voffB); PG8_STAGE(PG8_SA(0, 0), cA, voffA); PG8_STAGE(PG8_SA(0, 1), cA + hstepA, voffA);
        if (wr == 1) PG8_BAR;
        PG8_WAIT_V(2); PG8_BAR;
        PG8_STAGE(PG8_SB(1, 0), cB + kstep, voffB); PG8_STAGE(PG8_SA(1, 0), cA + kstep, voffA); PG8_STAGE(PG8_SB(1, 1), cB + hstepB + kstep, voffB);
        PG8_WAIT_V(6); PG8_BAR;
    } else {
        PG8_STAGE(PG8_SB(0, 0), cB, voffB); PG8_STAGE(PG8_SA(0, 0), cA, voffA); PG8_STAGE(PG8_SB(0, 1), cB + hstepB, voffB); PG8_STAGE(PG8_SA(0, 1), cA + hstepA, voffA);
        if (wr == 1) PG8_BAR;
        PG8_WAIT_V(4); PG8_BAR;
        PG8_STAGE(PG8_SB(1, 0), cB + kstep, voffB); PG8_STAGE(PG8_SA(1, 0), cA + kstep, voffA); PG8_STAGE(PG8_SB(1, 1), cB + hstepB + kstep, voffB);
        PG8_WAIT_V(6); PG8_BAR;
    }
    for (;;) {
        const bool has_next = S.next(ui + 1, nxt);
        const char* nA = has_next ? (const char*)g.A + (size_t)nxt.pm * tstepA : cA; const char* nB = has_next ? (const char*)g.Bt + (size_t)nxt.pn * tstepB : cB;
        for (int t = 0; t < nt; t += 2) {
            const bool last = (t == nt - 2);
            const char* a1 = cA + (size_t)(t + 1) * kstep;
            const char* a2 = last ? nA : cA + (size_t)(t + 2) * kstep; const char* b2 = last ? nB : cB + (size_t)(t + 2) * kstep;
            const char* a3 = a2 + kstep; const char* b3 = b2 + kstep;
            if (last && has_next) S.a_ready(nxt);
            if constexpr (SP2) {
            PG8_LDB(B0, 0, 0); PG8_LDB(B1, 0, 1); PG8_SCHED; PG8_LDA(At, 0, 0); PG8_STAGE(PG8_SA(1, 1), a1 + hstepA, voffA);
            PG8_WAIT_V(8); PG8_WAIT_L(0); PG8_BAR; PG8_MMA(0, 0, At, B0); PG8_MMA(0, 1, At, B1); PG8_BAR; PG8_SCHED;
            PG8_LDA(At, 0, 1); PG8_STAGE(PG8_SB(0, 0), b2, voffB); PG8_STAGE(PG8_SB(0, 1), b2 + hstepB, voffB); PG8_STAGE(PG8_SA(0, 0), a2, voffA);
            PG8_WAIT_V(8); PG8_WAIT_L(0); PG8_BAR; PG8_MMA(1, 0, At, B0); PG8_MMA(1, 1, At, B1); PG8_BAR; PG8_SCHED;
            PG8_LDB(B0, 1, 0); PG8_LDB(B1, 1, 1); PG8_SCHED; PG8_LDA(At, 1, 0); PG8_STAGE(PG8_SA(0, 1), a2 + hstepA, voffA);
            PG8_WAIT_V(8); PG8_WAIT_L(0); PG8_BAR; PG8_MMA(0, 0, At, B0); PG8_MMA(0, 1, At, B1); PG8_BAR; PG8_SCHED;
            PG8_LDA(At, 1, 1); PG8_STAGE(PG8_SB(1, 0), b3, voffB); PG8_STAGE(PG8_SB(1, 1), b3 + hstepB, voffB); PG8_STAGE(PG8_SA(1, 0), a3, voffA);
            PG8_WAIT_V(8); PG8_WAIT_L(0); PG8_BAR; PG8_MMA(1, 0, At, B0); PG8_MMA(1, 1, At, B1); PG8_BAR; PG8_SCHED;
            } else {
            PG8_LDB(B0, 0, 0); PG8_SCHED; PG8_LDA(At, 0, 0); PG8_STAGE(PG8_SA(1, 1), a1 + hstepA, voffA);
            PG8_WAIT_L(8); PG8_BAR; PG8_WAIT_L(0); PG8_MMA(0, 0, At, B0); PG8_BAR; PG8_SCHED;
            PG8_LDB(B1, 0, 1); PG8_STAGE(PG8_SB(0, 0), b2, voffB);
            PG8_BAR; PG8_WAIT_L(0); PG8_MMA(0, 1, At, B1); PG8_BAR;
            PG8_LDA(At, 0, 1); PG8_STAGE(PG8_SA(0, 0), a2, voffA);
            PG8_BAR; PG8_WAIT_L(0); PG8_MMA(1, 0, At, B0); PG8_BAR; PG8_SCHED;
            PG8_STAGE(PG8_SB(0, 1), b2 + hstepB, voffB);
            PG8_WAIT_V(6); PG8_BAR; PG8_MMA(1, 1, At, B1); PG8_BAR;
            PG8_LDB(B0, 1, 0); PG8_SCHED; PG8_LDA(At, 1, 0); PG8_STAGE(PG8_SA(0, 1), a2 + hstepA, voffA);
            PG8_WAIT_L(8); PG8_BAR; PG8_WAIT_L(0); PG8_MMA(0, 0, At, B0); PG8_BAR; PG8_SCHED;
            PG8_LDB(B1, 1, 1); PG8_STAGE(PG8_SB(1, 0), b3, voffB);
            PG8_BAR; PG8_WAIT_L(0); PG8_MMA(0, 1, At, B1); PG8_BAR;
            PG8_LDA(At, 1, 1); PG8_STAGE(PG8_SA(1, 0), a3, voffA);
            PG8_BAR; PG8_WAIT_L(0); PG8_MMA(1, 0, At, B0); PG8_BAR; PG8_SCHED;
            PG8_STAGE(PG8_SB(1, 1), b3 + hstepB, voffB);
            PG8_WAIT_V(6); PG8_BAR; PG8_MMA(1, 1, At, B1); PG8_BAR;
            }
        }
        if constexpr (ALIGN_EPI) { if (wr == 0) PG8_BAR; }
        if constexpr (!Epi::AFTER_DRAIN) { E(acc, cur, wr, wc, fr, fq); S.done(cur); __builtin_amdgcn_s_waitcnt(0x0F70); }
        if (!has_next) break;
#pragma unroll
        for (int a = 0; a < 2; ++a)
#pragma unroll
            for (int b = 0; b < 2; ++b)
#pragma unroll
                for (int m = 0; m < 4; ++m)
#pragma unroll
                    for (int n = 0; n < 2; ++n) acc[a][b][m][n] = (f32x4){0.f, 0.f, 0.f, 0.f};
        cur = nxt; cA = nA; cB = nB; ++ui;
        if constexpr (ALIGN_EPI) { if (wr == 1) PG8_BAR; }
    }
    PG8_WAIT_V(0);
    if constexpr (!ALIGN_EPI) { if (wr == 0) PG8_BAR; }
    PG8_BAR;
    if constexpr (Epi::AFTER_DRAIN) { E.fused(acc, cur, wr, wc, fr, fq, lds, wid, lane); S.done(cur); }
#undef PG8_SA
#undef PG8_SB
#undef PG8_STAGE
#undef PG8_LDA
#undef PG8_LDB
#undef PG8_MMA
#undef PG8_WAIT_V
#undef PG8_WAIT_L
#undef PG8_BAR
#undef PG8_SCHED
}
}
#define GAS __attribute__((address_space(1)))
#define LAS __attribute__((address_space(3)))
typedef unsigned short bf16;
typedef unsigned v4u __attribute__((ext_vector_type(4)));
typedef float f32x4 __attribute__((ext_vector_type(4)));
typedef float f32x2 __attribute__((ext_vector_type(2)));
typedef short bf16x8 __attribute__((ext_vector_type(8)));
#define LDS_WAIT() asm volatile("s_waitcnt lgkmcnt(0)" ::: "memory")

__device__ __forceinline__ unsigned f2bf(float f) { unsigned u = __builtin_bit_cast(unsigned, f); return (u + 0x7fffu + ((u >> 16) & 1u)) >> 16; }
__device__ __forceinline__ unsigned pk2(float lo, float hi) { return f2bf(lo) | (f2bf(hi) << 16); }
__device__ __forceinline__ float bf2f(unsigned short h) { return __builtin_bit_cast(float, (unsigned)h << 16); }
__device__ __forceinline__ float wave_sum(float v) {
#pragma unroll
    for (int o = 1; o < 64; o <<= 1) v += __shfl_xor(v, o);
    return v;
}
__device__ __forceinline__ float wave_max(float v) {
#pragma unroll
    for (int o = 1; o < 64; o <<= 1) v = fmaxf(v, __shfl_xor(v, o));
    return v;
}

struct Args {
    const float* in[16]; float* out; unsigned char* ws; int ph_lo, ph_hi;
};

__device__ __forceinline__ int colmap_in(int n) {
    const int t = n >> 8;
    if (t < 9) return n;
    if (t < 12) return 2310 + (n - 2304);
    if (t < 14) return 3078 + (n - 3072);
    if (t == 14) return 3590 + (n - 3584);
    if (t < 18) return 3910 + (n - 3840);
    if (t < 20) return 4678 + (n - 4608);
    if (t < 22) return 5190 + (n - 5120);
    if (t < 24) return 5702 + (n - 5632);
    if (t < 26) return 6214 + (n - 6144);
    const int j = n & 255;
    if (j < 64) return 3846 + (j >> 1) + 32 * (j & 1);
    if (j < 70) return 2304 + (j - 64);
    return -1;
}
__device__ __forceinline__ int colmap_uq(int n) {
    if (n < 768) return 192 * (n >> 7) + (n & 127);
    if (n < 1152) { const int hh = (n - 768) >> 6, p = (n - 768) & 63; return 192 * hh + 128 + (p >> 1) + 32 * (p & 1); }
    return -1;
}
__device__ __forceinline__ int colmap_ukv(int n) {
    if (n < 768) return 256 * (n >> 7) + (n & 127);
    const int c = n - 768; return 256 * (c >> 7) + 128 + (c & 127);
}
template <int MAT> __device__ __forceinline__ void tr_item(const float* W, int Norig, const float* gk, bf16* WT, int ldw, int k0, int n0, LAS float* scr, int lane) {
    int oc;
    if (MAT == 0) oc = colmap_in(n0 + lane); else if (MAT == 1) oc = colmap_uq(n0 + lane); else if (MAT == 2) oc = colmap_ukv(n0 + lane); else oc = n0 + lane;
    const float* wp = W + (size_t)k0 * Norig + (oc >= 0 ? oc : 0);
#pragma unroll 16
    for (int i = 0; i < 64; ++i) { float v = wp[(size_t)i * Norig]; if (oc < 0) v = 0.f; scr[i * 65 + lane] = v; }
    LDS_WAIT(); asm volatile("" ::: "memory");
    const int c = lane & 7;
    f32x4 g0 = {1.f, 1.f, 1.f, 1.f}, g1 = g0;
    if (gk) { g0 = *(const f32x4*)(gk + k0 + 8 * c); g1 = *(const f32x4*)(gk + k0 + 8 * c + 4); }
#pragma unroll
    for (int j = 0; j < 8; ++j) { const int n = (lane >> 3) + 8 * j; const LAS float* s = scr + (8 * c) * 65 + n;
        v4u o; o.x = pk2(s[0 * 65] * g0[0], s[1 * 65] * g0[1]); o.y = pk2(s[2 * 65] * g0[2], s[3 * 65] * g0[3]); o.z = pk2(s[4 * 65] * g1[0], s[5 * 65] * g1[1]); o.w = pk2(s[6 * 65] * g1[2], s[7 * 65] * g1[3]);
        *(v4u*)(WT + (size_t)(n0 + n) * ldw + k0 + 8 * c) = o; }
    LDS_WAIT(); asm volatile("" ::: "memory");
}

__device__ __forceinline__ int t5_bucket(int rel) {
    const int n = rel < 0 ? -rel : rel; int v;
    if (n < 8) v = n; else if (n < 12) v = 8; else if (n < 16) v = 9; else if (n < 23) v = 10; else if (n < 32) v = 11; else if (n < 46) v = 12; else if (n < 64) v = 13; else if (n < 91) v = 14; else v = 15;
    return (rel > 0 ? 16 : 0) + v;
}

__device__ __forceinline__ int opaque_tid() { int t = threadIdx.x; asm volatile("" : "+v"(t)); return t; }
#define C_tid (tid_o)
#define C_lane (tid_o & 63)
#define C_wave (__builtin_amdgcn_readfirstlane(tid_o >> 6))
#define C_G ((int)gridDim.x)
#define C_bid ((int)blockIdx.x)
#define WSP(T, off) ((T*)(args.ws + (off)))

__device__ __forceinline__ void p0_prologue(const Args& args, LAS unsigned char* lds) {
    const int tid_o = opaque_tid();
    LAS float* scr = (LAS float*)(lds + C_wave * 16640);
    const int gw = C_bid * NWAVES + C_wave, NGW = C_G * NWAVES;
    constexpr int I_IN = (DM / 64) * (NIN_PAD / 64), I_UQ = (512 / 64) * (NUQ_PAD / 64), I_UKV = (256 / 64) * (NUKV / 64), I_OUT = (DM / 64) * (DM / 64);
    constexpr int PER_LAYER = I_IN + I_UQ + I_UKV + I_OUT;
    for (int it = gw; it < DEPTH * PER_LAYER; it += NGW) {
        const int l = it / PER_LAYER; int r = it - l * PER_LAYER;
        if (r < I_IN) { const int nb = NIN_PAD / 64, kb = r / nb, nbk = r - kb * nb;
            tr_item<0>(args.in[2] + (size_t)l * DM * NIN, NIN, args.in[1] + l * DM, (bf16*)(args.ws + WS_WIN + (size_t)l * WIN_BYTES), LDX, kb * 64, nbk * 64, scr, C_lane); continue; }
        r -= I_IN;
        if (r < I_UQ) { const int nb = NUQ_PAD / 64, kb = r / nb, nbk = r - kb * nb;
            tr_item<1>(args.in[5] + (size_t)l * 512 * 1152, 1152, args.in[4] + l * 512, WSP(bf16, WS_WUQ) + (size_t)l * NUQ_PAD * 512, 512, kb * 64, nbk * 64, scr, C_lane); continue; }
        r -= I_UQ;
        if (r < I_UKV) { const int nb = NUKV / 64, kb = r / nb, nbk = r - kb * nb;
            tr_item<2>(args.in[7] + (size_t)l * 256 * 1536, 1536, args.in[6] + l * 256, WSP(bf16, WS_WUKV) + (size_t)l * NUKV * 256, 256, kb * 64, nbk * 64, scr, C_lane); continue; }
        r -= I_UKV;
        { const int nb = DM / 64, kb = r / nb, nbk = r - kb * nb;
            tr_item<3>(args.in[14] + (size_t)l * DM * DM, DM, nullptr, (bf16*)(args.ws + WS_WOUT + (size_t)l * WOUT_BYTES), LDX, kb * 64, nbk * 64, scr, C_lane); }
    }
    for (int m = gw; m < M; m += NGW) {
        const f32x4* xr = (const f32x4*)(args.in[0] + (size_t)m * DM) + C_lane; float s = 0.f;
        unsigned long long* o8 = (unsigned long long*)(WSP(bf16, WS_XB) + (size_t)m * LDX) + C_lane;
#pragma unroll
        for (int j = 0; j < 8; ++j) { const f32x4 v = xr[64 * j]; s += (v[0] * v[0] + v[1] * v[1]) + (v[2] * v[2] + v[3] * v[3]);
            o8[64 * j] = (unsigned long long)pk2(v[0], v[1]) | ((unsigned long long)pk2(v[2], v[3]) << 32); }
        s = wave_sum(s);
        if (C_lane < 32) WSP(float, WS_XSS)[(size_t)m * 32 + C_lane] = C_lane == 0 ? s : 0.f;
    }
    for (int e = C_bid * NTHREADS + C_tid; e < SEQ * 32; e += C_G * NTHREADS) {
        const int s = e >> 5, i = e & 31; const float inv = powf(10000.0f, -(float)i / 32.0f); const float ang = (float)s * inv;
        WSP(float, WS_ROPE)[e] = cosf(ang); WSP(float, WS_ROPE + SEQ * 32 * 4)[e] = sinf(ang);
    }
}

__device__ __forceinline__ void p2_scan(const Args& args) {
    const int tid_o = opaque_tid();
    if (C_bid >= NB * 6 || C_wave != 0) return;
    const int b = C_bid / 6, h = C_bid % 6, lane = C_lane;
    const float* src = WSP(float, WS_LOGF) + ((size_t)b * SEQ + 64 * lane) * 8 + h;
    float tot = 0.f;
#pragma unroll 8
    for (int j = 0; j < 64; ++j) tot += src[j * 8];
    float incl = tot;
#pragma unroll
    for (int o = 1; o < 64; o <<= 1) { const float y = __shfl_up(incl, o); if (lane >= o) incl += y; }
    float run = incl - tot;
    float* dst = WSP(float, WS_CUMT) + (size_t)C_bid * SEQ + 64 * lane;
#pragma unroll 8
    for (int j = 0; j < 64; ++j) { run += src[j * 8]; dst[j] = run; }
}

template <int DQK> __device__ __forceinline__ float dot_row(const bf16* kp, const LAS float* qs) {
    float s = 0.f;
#pragma unroll
    for (int c = 0; c < DQK / 8; ++c) { const v4u kv = *(const v4u*)(kp + c * 8);
        const f32x4 q0 = *(const LAS f32x4*)(qs + c * 8), q1 = *(const LAS f32x4*)(qs + c * 8 + 4);
        s += bf2f(kv.x & 0xffff) * q0[0] + bf2f(kv.x >> 16) * q0[1] + bf2f(kv.y & 0xffff) * q0[2] + bf2f(kv.y >> 16) * q0[3]
           + bf2f(kv.z & 0xffff) * q1[0] + bf2f(kv.z >> 16) * q1[1] + bf2f(kv.w & 0xffff) * q1[2] + bf2f(kv.w >> 16) * q1[3]; }
    return s;
}
template <int VAR, int DQK>
__device__ __forceinline__ void naive_map(const LAS float* qs, const bf16* Kbase, int kpitch, const bf16* Vbase, int vpitch, int nkeys, int t, const float* cum, float cumt,
                                          const float* relb, int h, int lane, float& o0, float& o1, float& l) {
    float m = -1e30f; l = 0.f; o0 = 0.f; o1 = 0.f;
    for (int k0 = 0; k0 < nkeys; k0 += 64) {
        const int key = k0 + lane;
        float s = dot_row<DQK>(Kbase + (size_t)key * kpitch, qs);
        if (VAR == 0) { s += cumt - cum[key]; if (key > t) s = -INFINITY; }
        if (VAR == 2) s += relb[t5_bucket(key - t) * 4 + h];
        const float tmax = wave_max(s), mn = fmaxf(m, tmax), alpha = __expf(m - mn), p = __expf(s - mn);
        l = l * alpha + wave_sum(p); o0 *= alpha; o1 *= alpha; m = mn;
        const bf16* vp = Vbase + (size_t)k0 * vpitch + 2 * lane;
#pragma unroll 8
        for (int kk = 0; kk < 64; ++kk) { const float pk = __shfl(p, kk); const unsigned vv = *(const unsigned*)(vp + (size_t)kk * vpitch);
            o0 += pk * bf2f(vv & 0xffff); o1 += pk * bf2f(vv >> 16); }
    }
}
__device__ __forceinline__ void p3_naive(const Args& args, int layer, LAS unsigned char* lds) {
    const int tid_o = opaque_tid();
    LAS float* qs = (LAS float*)(lds + C_wave * 1024);
    const int gw = C_bid * NWAVES + C_wave, NGW = C_G * NWAVES, lane = C_lane;
    const float lam_init = 0.8f - 0.6f * expf(-0.3f * (float)layer);
    const float d1 = wave_sum(args.in[8][layer * 64 + lane] * args.in[9][layer * 64 + lane]), d2 = wave_sum(args.in[10][layer * 64 + lane] * args.in[11][layer * 64 + lane]);
    const float lam = expf(d1) - expf(d2) + lam_init;
    for (int u = gw; u < M * 16; u += NGW) {
        const int row = u >> 4, hh = u & 15, b = row >> 12, t = row & 4095; const size_t rb = (size_t)b * SEQ;
        float o0, o1, l;
        if (hh < 6) {
            const int h = hh; const bf16* q = WSP(bf16, WS_AQ) + (size_t)row * 768 + 128 * h;
            qs[lane] = bf2f(q[lane]) * 0.08838834764831845f; qs[lane + 64] = bf2f(q[lane + 64]) * 0.08838834764831845f; LDS_WAIT();
            const float* cum = WSP(float, WS_CUMT) + (size_t)(b * 6 + h) * SEQ;
            naive_map<0, 128>(qs, WSP(bf16, WS_AK) + rb * 768 + 128 * h, 768, WSP(bf16, WS_AV) + rb * 768 + 128 * h, 768, t + 1, t, cum, cum[t], nullptr, h, lane, o0, o1, l);
            bf16* g = WSP(bf16, WS_G) + (size_t)row * LDX + 128 * h + 2 * lane; const unsigned gv = *(const unsigned*)g; const float il = 1.0f / l;
            *(unsigned*)g = pk2(o0 * il * bf2f(gv & 0xffff), o1 * il * bf2f(gv >> 16));
        } else if (hh < 12) {
            const int h = hh - 6; const bf16* q = WSP(bf16, WS_QB) + (size_t)row * 1152 + 192 * h; const float sc = 0.07216878364870322f;
            qs[lane] = bf2f(q[lane]) * sc; qs[lane + 64] = bf2f(q[lane + 64]) * sc; qs[lane + 128] = bf2f(q[lane + 128]) * sc; LDS_WAIT();
            naive_map<1, 192>(qs, WSP(bf16, WS_KB) + rb * 1152 + 192 * h, 1152, WSP(bf16, WS_VB) + rb * 768 + 128 * h, 768, 64 * (t / 64 + 1), t, nullptr, 0.f, nullptr, h, lane, o0, o1, l);
            bf16* g = WSP(bf16, WS_G) + (size_t)row * LDX + 768 + 128 * h + 2 * lane; const unsigned gv = *(const unsigned*)g; const float il = 1.0f / l;
            *(unsigned*)g = pk2(o0 * il * bf2f(gv & 0xffff), o1 * il * bf2f(gv >> 16));
        } else {
            const int h = hh - 12; const bf16* q = WSP(bf16, WS_CQ2) + (size_t)row * 512 + 128 * h;
            qs[lane] = bf2f(q[lane]) * 0.125f; qs[lane + 64] = bf2f(q[lane + 64]) * 0.125f; LDS_WAIT();
            float p0, p1, pl;
            naive_map<2, 64>(qs, WSP(bf16, WS_CK2) + rb * 512 + 128 * h, 512, WSP(bf16, WS_CV) + rb * 512 + 128 * h, 512, 64 * (t / 64 + 1), t, nullptr, 0.f, args.in[13], h, lane, o0, o1, l);
            naive_map<2, 64>(qs + 64, WSP(bf16, WS_CK2) + rb * 512 + 128 * h + 64, 512, WSP(bf16, WS_CV) + rb * 512 + 128 * h, 512, 64 * (t / 64 + 1), t, nullptr, 0.f, args.in[13], h, lane, p0, p1, pl);
            const float il1 = 1.0f / l, il2 = lam / pl; const float c0 = o0 * il1 - p0 * il2, c1 = o1 * il1 - p1 * il2;
            const float ss = wave_sum(c0 * c0 + c1 * c1); const float r = rsqrtf(ss * (1.0f / 128.0f) + EPS) * (1.0f - lam_init);
            const float* sg = args.in[12] + layer * 128 + 2 * lane;
            bf16* g = WSP(bf16, WS_G) + (size_t)row * LDX + 1536 + 128 * h + 2 * lane; const unsigned gv = *(const unsigned*)g;
            *(unsigned*)g = pk2(c0 * r * sg[0] * bf2f(gv & 0xffff), c1 * r * sg[1] * bf2f(gv >> 16));
        }
        LDS_WAIT();
    }
}


namespace att {
typedef short s16x4 __attribute__((ext_vector_type(4)));
typedef float f32x16 __attribute__((ext_vector_type(16)));
typedef unsigned u32x4 __attribute__((ext_vector_type(4)));
constexpr int KVBLK = 64, SHM_V = 16384, SHM_K = 16384, SHM_KR = 8192;
constexpr int L_V = 0, L_K = 32768, L_KR = 65536, L_WS = 81920, L_KB = 83968, L_T5 = 84480, L_QR = 86016, L_FLAG = 118784, L_CMB = 0;
#define KSWZ(row, colB) ((row) * 256 + ((colB) ^ (((row) & 7) << 4)))
#define SBAR() __builtin_amdgcn_sched_barrier(0)
__device__ __forceinline__ int v_st(int k, int c) { const int kk = (k & ~0xC) | ((k & 4) << 1) | ((k & 8) >> 1); return ((kk >> 3) * 4 + (c >> 5)) * 512 + ((kk & 7) * 32 + (c & 31)) * 2; }
__device__ __forceinline__ int v_rd_base(int lane) { return ((lane & 3) << 3) | (((lane >> 2) & 3) << 6) | (((lane >> 4) & 1) << 5) | (((lane >> 5) & 1) << 8); }
constexpr int v_rd_off(int d0, int ks, int half) { return d0 * 512 + ks * 4096 + half * 2048; }
__device__ __forceinline__ int crow(int r, int hi) { return (r & 3) + 8 * (r >> 2) + 4 * hi; }
__device__ __forceinline__ unsigned cvtpk(float lo, float hi) { unsigned r; asm volatile("v_cvt_pk_bf16_f32 %0, %1, %2" : "=v"(r) : "v"(lo), "v"(hi)); return r; }

template <int VAR> struct VT;
template <> struct VT<0> { static constexpr float SCALE = 0.08838834764831845f; static constexpr int PQ = 768, PK = 768, PV = 768, NQ = 8, QROWS = 256; };
template <> struct VT<1> { static constexpr float SCALE = 0.07216878364870322f; static constexpr int PQ = 1152, PK = 1152, PV = 768, NQ = 8, QROWS = 256; };
template <> struct VT<2> { static constexpr float SCALE = 0.125f; static constexpr int PQ = 512, PK = 512, PV = 512, NQ = 4, QROWS = 128; };

__device__ __forceinline__ void mask_causal(f32x16& p0, f32x16& p1, int dq) {
    const float NEG = -__builtin_inff();
#pragma unroll
    for (int r = 0; r < 16; ++r) { const int c = (r & 3) + 8 * (r >> 2); if (dq - c < 0) p0[r] = NEG; if (dq - c - 32 < 0) p1[r] = NEG; }
}
template <int VAR>
__device__ __forceinline__ void partialSM(f32x16& p0, f32x16& p1, float& m_reg, float& mn, float& alpha, float cadd) {
    constexpr float SCALE = VT<VAR>::SCALE, C2 = 1.4426950408889634f * SCALE, THR = 8.f;
    float pmax = p0[0];
#pragma unroll
    for (int r = 1; r < 16; ++r) pmax = fmaxf(pmax, p0[r]);
#pragma unroll
    for (int r = 0; r < 16; ++r) pmax = fmaxf(pmax, p1[r]);
    { auto rr = __builtin_amdgcn_permlane32_swap(__float_as_uint(pmax), __float_as_uint(pmax), false, false);
      pmax = fmaxf(__uint_as_float(rr[0]), __uint_as_float(rr[1])); }
    if (VAR == 0) pmax += cadd;
    if (__builtin_expect(__all((pmax - m_reg) * SCALE <= THR), 1)) { mn = m_reg; alpha = 1.f; }
    else { mn = fmaxf(m_reg, pmax); alpha = __builtin_amdgcn_exp2f((m_reg - mn) * C2); m_reg = mn; }
    const float mnL = VAR == 0 ? (cadd - mn) * C2 : -mn * C2;
#pragma unroll
    for (int r = 0; r < 16; ++r) p0[r] = fmaf(p0[r], C2, mnL);
#pragma unroll
    for (int r = 0; r < 16; ++r) p1[r] = fmaf(p1[r], C2, mnL);
#pragma unroll
    for (int r = 0; r < 16; ++r) p0[r] = __builtin_amdgcn_exp2f(p0[r]);
}
__device__ __forceinline__ void finishSM(f32x16& p0, f32x16& p1, float alpha, float& l_reg, bf16x8& pa0, bf16x8& pa1, bf16x8& pa2, bf16x8& pa3) {
#pragma unroll
    for (int r = 0; r < 16; ++r) p1[r] = __builtin_amdgcn_exp2f(p1[r]);
    float ps = 0;
#pragma unroll
    for (int r = 0; r < 16; ++r) ps += p0[r];
#pragma unroll
    for (int r = 0; r < 16; ++r) ps += p1[r];
    { auto rr = __builtin_amdgcn_permlane32_swap(__float_as_uint(ps), __float_as_uint(ps), false, false);
      ps = __uint_as_float(rr[0]) + __uint_as_float(rr[1]); }
    l_reg = l_reg * alpha + ps;
#define PK4(P, B_, OUT) do { unsigned a0 = cvtpk(P[B_+0], P[B_+1]), a1 = cvtpk(P[B_+2], P[B_+3]);                          \
        unsigned b0 = cvtpk(P[B_+4], P[B_+5]), b1 = cvtpk(P[B_+6], P[B_+7]);                                             \
        auto r0 = __builtin_amdgcn_permlane32_swap(a0, b0, false, false); auto r1 = __builtin_amdgcn_permlane32_swap(a1, b1, false, false); \
        u32x4 w = {r0[0], r1[0], r0[1], r1[1]}; OUT = *reinterpret_cast<bf16x8*>(&w); } while (0)
    PK4(p0, 0, pa0); PK4(p0, 8, pa1); PK4(p1, 0, pa2); PK4(p1, 8, pa3);
#undef PK4
}
template <int VAR, int KB>
__device__ __forceinline__ void qkt(f32x16& p0, f32x16& p1, const LAS unsigned char* lds, int r32, int hi, int lane, int wid, int map, const bf16x8* qr) {
    if (VAR == 0) {
        const LAS float* kb = (const LAS float*)(lds + L_KB) + KB * 64 + 4 * hi;
#pragma unroll
        for (int g = 0; g < 4; ++g) { const f32x4 a = *(const LAS f32x4*)(kb + 8 * g), b = *(const LAS f32x4*)(kb + 32 + 8 * g);
            p0[4 * g] = a[0]; p0[4 * g + 1] = a[1]; p0[4 * g + 2] = a[2]; p0[4 * g + 3] = a[3]; p1[4 * g] = b[0]; p1[4 * g + 1] = b[1]; p1[4 * g + 2] = b[2]; p1[4 * g + 3] = b[3]; }
    } else { p0 = f32x16{}; p1 = f32x16{}; }
    const LAS unsigned char* kbp[4];
#pragma unroll
    for (int dd = 0; dd < 4; ++dd) kbp[dd] = lds + L_K + KB * SHM_K + KSWZ(r32, (dd * 16 + hi * 8) * 2) + (VAR == 2 ? map * 128 : 0);
#pragma unroll
    for (int d0 = 0; d0 < VT<VAR>::NQ; ++d0) { const LAS unsigned char* a = kbp[d0 & 3] + (d0 >> 2) * 128;
        const bf16x8 b0 = *(const LAS bf16x8*)a, b1 = *(const LAS bf16x8*)(a + 32 * 256);
        __builtin_amdgcn_s_setprio(1);
        p0 = __builtin_amdgcn_mfma_f32_32x32x16_bf16(b0, qr[d0], p0, 0, 0, 0);
        p1 = __builtin_amdgcn_mfma_f32_32x32x16_bf16(b1, qr[d0], p1, 0, 0, 0);
        __builtin_amdgcn_s_setprio(0); }
    if (VAR == 1) {
        const int s = (r32 >> 1) & 7;
#pragma unroll
        for (int d0 = 0; d0 < 4; ++d0) { const LAS unsigned char* a = lds + L_KR + KB * SHM_KR + r32 * 128 + (((2 * d0 + hi) ^ s) << 4);
            const bf16x8 b0 = *(const LAS bf16x8*)a, b1 = *(const LAS bf16x8*)(a + 32 * 128);
            const bf16x8 q = *(const LAS bf16x8*)(lds + L_QR + wid * 4096 + d0 * 1024 + lane * 16);
            p0 = __builtin_amdgcn_mfma_f32_32x32x16_bf16(b0, q, p0, 0, 0, 0);
            p1 = __builtin_amdgcn_mfma_f32_32x32x16_bf16(b1, q, p1, 0, 0, 0); }
    }
}
template <int VB>
__device__ __forceinline__ void pv_tile(f32x16* o, int vb0, bf16x8 pa0, bf16x8 pa1, bf16x8 pa2, bf16x8 pa3) {
#define TRRD(dst, off) asm volatile("ds_read_b64_tr_b16 %0, %1 offset:%2" : "=&v"(dst) : "v"(vb0), "i"(off) : "memory")
#define PV_D0(d0) do { s16x4 l0, l1, l2, l3, h0, h1, h2, h3; constexpr int b_ = VB * SHM_V + v_rd_off(d0, 0, 0); \
        TRRD(l0, b_); TRRD(h0, b_ + 2048); TRRD(l1, b_ + 4096); TRRD(h1, b_ + 6144); TRRD(l2, b_ + 8192); TRRD(h2, b_ + 10240); TRRD(l3, b_ + 12288); TRRD(h3, b_ + 14336); \
        asm volatile("s_waitcnt lgkmcnt(0)" ::: "memory"); SBAR(); __builtin_amdgcn_s_setprio(1);   \
        o[d0] = __builtin_amdgcn_mfma_f32_32x32x16_bf16(pa0, (bf16x8){l0[0], l0[1], l0[2], l0[3], h0[0], h0[1], h0[2], h0[3]}, o[d0], 0, 0, 0);   \
        o[d0] = __builtin_amdgcn_mfma_f32_32x32x16_bf16(pa1, (bf16x8){l1[0], l1[1], l1[2], l1[3], h1[0], h1[1], h1[2], h1[3]}, o[d0], 0, 0, 0);   \
        o[d0] = __builtin_amdgcn_mfma_f32_32x32x16_bf16(pa2, (bf16x8){l2[0], l2[1], l2[2], l2[3], h2[0], h2[1], h2[2], h2[3]}, o[d0], 0, 0, 0);   \
        o[d0] = __builtin_amdgcn_mfma_f32_32x32x16_bf16(pa3, (bf16x8){l3[0], l3[1], l3[2], l3[3], h3[0], h3[1], h3[2], h3[3]}, o[d0], 0, 0, 0); __builtin_amdgcn_s_setprio(0); } while (0)
    PV_D0(0); PV_D0(1); PV_D0(2); PV_D0(3);
#undef PV_D0
#undef TRRD
}

template <int VAR>
__device__ __forceinline__ void attn_unit(unsigned char* ws, const float* relb, const float* subg, float lam, float lam1m, int b, int h, int qb, LAS unsigned char* lds) {
    typedef VT<VAR> T; constexpr float SCALE = T::SCALE;
    int tid_ = threadIdx.x; asm volatile("" : "+v"(tid_));
    const int tid = tid_, wid = __builtin_amdgcn_readfirstlane(tid >> 6), lane = tid & 63, r32 = lane & 31, hi = lane >> 5;
    const int wq = VAR == 2 ? (wid & 3) : wid, map = VAR == 2 ? (wid >> 2) : 0;
    const int P0 = qb * T::QROWS, qlo = P0 + wq * 32, NT = (P0 + T::QROWS) / KVBLK;
    const size_t rowb = (size_t)b * SEQ;
    const bf16* Qp; const bf16* Kp; const bf16* Vp; int gcol;
    if (VAR == 0) { Qp = (const bf16*)(ws + WS_AQ) + (rowb + qlo + r32) * 768 + 128 * h; Kp = (const bf16*)(ws + WS_AK) + rowb * 768 + 128 * h; Vp = (const bf16*)(ws + WS_AV) + rowb * 768 + 128 * h; gcol = 128 * h; }
    else if (VAR == 1) { Qp = (const bf16*)(ws + WS_QB) + (rowb + qlo + r32) * 1152 + 192 * h; Kp = (const bf16*)(ws + WS_KB) + rowb * 1152 + 192 * h; Vp = (const bf16*)(ws + WS_VB) + rowb * 768 + 128 * h; gcol = 768 + 128 * h; }
    else { Qp = (const bf16*)(ws + WS_CQ2) + (rowb + qlo + r32) * 512 + 128 * h + 64 * map; Kp = (const bf16*)(ws + WS_CK2) + rowb * 512 + 128 * h; Vp = (const bf16*)(ws + WS_CV) + rowb * 512 + 128 * h; gcol = 1536 + 128 * h; }
    const float* cum = (const float*)(ws + WS_CUMT) + (size_t)(b * 6 + h) * SEQ;
    LAS unsigned char* V_lds = lds + L_V; LAS unsigned char* K_lds = lds + L_K;
    LAS float* wsf = (LAS float*)(lds + L_WS) + wid * 64; LAS float* li_l = wsf; LAS float* al_l = wsf + 32;
    const float cqr = VAR == 0 ? cum[qlo + r32] * (1.0f / SCALE) : 0.f;
    float m_reg = VAR == 0 ? 0.f : -1e30f, l_reg = 0; f32x16 o[4] = {};
    const int sr = tid >> 4, sc = (tid & 15) * 8, vst0 = v_st(sr, sc), vst1 = v_st(32 + sr, sc), kws = KSWZ(sr, sc * 2);
    const int krr = tid >> 3, krc = tid & 7, krw = krr * 128 + ((krc ^ ((krr >> 1) & 7)) << 4);
    const int vb0 = (int)(uintptr_t)V_lds + v_rd_base(lane);
    bf16x8 qr[T::NQ];
#pragma unroll
    for (int d0 = 0; d0 < T::NQ; ++d0) qr[d0] = *(const bf16x8*)(Qp + d0 * 16 + hi * 8);
    if (VAR == 1) {
#pragma unroll
        for (int d0 = 0; d0 < 4; ++d0) *(LAS bf16x8*)(lds + L_QR + wid * 4096 + d0 * 1024 + lane * 16) = *(const bf16x8*)(Qp + 128 + d0 * 16 + hi * 8);
    }
    if (VAR == 2) { if (tid < 320) { const int rel = tid - 255; ((LAS float*)(lds + L_T5))[tid] = relb[t5_bucket(rel) * 4 + h] * (1.0f / SCALE); } }
    bf16x8 st_v0, st_v1, st_k0, st_k1, st_kr; float st_kb = 0.f;
#define ROWP(p, pitch, k0, rr) ((p) + (size_t)((k0) + (rr)) * (pitch) + sc)
#define VMW() asm volatile("s_waitcnt vmcnt(0)" ::: "memory")
#define SLOAD(k0) do { st_v0 = *(const bf16x8*)ROWP(Vp, T::PV, k0, sr); st_v1 = *(const bf16x8*)ROWP(Vp, T::PV, k0, 32 + sr);              \
                       st_k0 = *(const bf16x8*)ROWP(Kp, T::PK, k0, sr); st_k1 = *(const bf16x8*)ROWP(Kp, T::PK, k0, 32 + sr);              \
                       if (VAR == 1) st_kr = *(const bf16x8*)(Kp + (size_t)((k0) + krr) * 1152 + 128 + krc * 8);                            \
                       if (VAR == 0) { if (tid < 64) st_kb = cum[(k0) + tid]; } } while (0)
#define SWRITE(bf) do { *(LAS bf16x8*)(V_lds + (bf) * SHM_V + vst0) = st_v0; *(LAS bf16x8*)(V_lds + (bf) * SHM_V + vst1) = st_v1;         \
                        *(LAS bf16x8*)(K_lds + (bf) * SHM_K + kws) = st_k0; *(LAS bf16x8*)(K_lds + (bf) * SHM_K + kws + 32 * 256) = st_k1; \
                        if (VAR == 1) *(LAS bf16x8*)(lds + L_KR + (bf) * SHM_KR + krw) = st_kr;                                             \
                        if (VAR == 0) { if (tid < 64) ((LAS float*)(lds + L_KB))[(bf) * 64 + tid] = -st_kb * (1.0f / SCALE); } } while (0)
#define RESC(a) do { if (__any((a) < 1.f)) { if (hi == 0) al_l[r32] = (a); asm volatile("s_waitcnt lgkmcnt(0)" ::: "memory");              \
                     _Pragma("unroll") for (int d_ = 0; d_ < 4; ++d_) _Pragma("unroll") for (int r = 0; r < 16; ++r) o[d_][r] *= al_l[crow(r, hi)]; } } while (0)
#define KBASE(t) ((t) * KVBLK)
    const int qm = qlo + r32 - 4 * hi;
    const int t5b = (-qlo - r32 + 4 * hi + 255) * 4;
    const float b15 = VAR == 2 ? relb[15 * 4 + h] * (1.0f / SCALE) : 0.f;
#define MODIFY(P0_, P1_, t) do { const int kb_ = KBASE(t);                                                                               \
        if (VAR == 0) { if (kb_ + KVBLK - 1 > qlo) mask_causal(P0_, P1_, qm - kb_); }                                                   \
        else { if (kb_ > (qlo & ~63)) { _Pragma("unroll") for (int r = 0; r < 16; ++r) { P0_[r] = -__builtin_inff(); P1_[r] = -__builtin_inff(); } }   \
               else if (VAR == 2) { if (kb_ + 63 - qlo > -91) { const LAS unsigned char* tp = lds + L_T5 + t5b + kb_ * 4;                               \
                       _Pragma("unroll") for (int r = 0; r < 16; ++r) { const int c = (r & 3) + 8 * (r >> 2); P0_[r] += *(const LAS float*)(tp + c * 4); P1_[r] += *(const LAS float*)(tp + (c + 32) * 4); } } \
                   else { _Pragma("unroll") for (int r = 0; r < 16; ++r) { P0_[r] += b15; P1_[r] += b15; } } } } } while (0)
    f32x16 pA0, pA1, pB0, pB1; float mnA, mnB, alA, alB; bf16x8 pa0, pa1, pa2, pa3;
    SLOAD(0); VMW(); SWRITE(0);
    __syncthreads();
    SLOAD(KBASE(1));
    SBAR(); qkt<VAR, 0>(pA0, pA1, lds, r32, hi, lane, wid, map, qr);
    MODIFY(pA0, pA1, 0); partialSM<VAR>(pA0, pA1, m_reg, mnA, alA, cqr);
    VMW(); SWRITE(1);
    __syncthreads();
#define HALF_STEP(PX0, PX1, mnX, alX, PY0, PY1, alY, t, KB, VB, SB) do {                                                      \
        SBAR(); qkt<VAR, KB>(PX0, PX1, lds, r32, hi, lane, wid, map, qr);                                                     \
        finishSM(PY0, PY1, alY, l_reg, pa0, pa1, pa2, pa3); SBAR();                                                           \
        SLOAD(KBASE((t) + 1)); SBAR();                                                                                        \
        pv_tile<VB>(o, vb0, pa0, pa1, pa2, pa3); MODIFY(PX0, PX1, (t)); partialSM<VAR>(PX0, PX1, m_reg, mnX, alX, cqr);            \
        __syncthreads();                                                                                                      \
        VMW(); SWRITE(SB);                                                                                                    \
        RESC(alX); __syncthreads(); } while (0)
    for (int t = 1; t + 1 < NT; t += 2) {
        HALF_STEP(pB0, pB1, mnB, alB, pA0, pA1, alA, t, 1, 0, 0);
        HALF_STEP(pA0, pA1, mnA, alA, pB0, pB1, alB, t + 1, 0, 1, 1);
    }
    SBAR(); qkt<VAR, 1>(pB0, pB1, lds, r32, hi, lane, wid, map, qr); SBAR();
    finishSM(pA0, pA1, alA, l_reg, pa0, pa1, pa2, pa3); SBAR();
    pv_tile<0>(o, vb0, pa0, pa1, pa2, pa3);
    MODIFY(pB0, pB1, NT - 1); partialSM<VAR>(pB0, pB1, m_reg, mnB, alB, cqr); __syncthreads(); RESC(alB);
    finishSM(pB0, pB1, alB, l_reg, pa0, pa1, pa2, pa3); SBAR(); pv_tile<1>(o, vb0, pa0, pa1, pa2, pa3);
    if (hi == 0) li_l[r32] = l_reg; asm volatile("s_waitcnt lgkmcnt(0)" ::: "memory");
    float rli[16];
#pragma unroll
    for (int r = 0; r < 16; ++r) rli[r] = __builtin_amdgcn_rcpf(li_l[crow(r, hi)]);
    bf16* Gw = (bf16*)(ws + WS_G) + (rowb + qlo) * LDX + gcol;
#define STAGE_OUT(stg) do { const int row_ = lane >> 3, ch_ = lane & 7;                                                                  \
        _Pragma("unroll") for (int half_ = 0; half_ < 2; ++half_) {                                                                    \
            u32x4 gv_[4];                                                                                                              \
            _Pragma("unroll") for (int i_ = 0; i_ < 4; ++i_) gv_[i_] = *(const u32x4*)(Gw + (size_t)(i_ * 8 + row_) * LDX + half_ * 64 + ch_ * 8);   \
            _Pragma("unroll") for (int r = 0; r < 16; ++r) { const int orow = crow(r, hi);                                               \
                (stg)[orow * 64 + r32] = o[2 * half_][r]; (stg)[orow * 64 + 32 + r32] = o[2 * half_ + 1][r]; }                           \
            _Pragma("unroll") for (int i_ = 0; i_ < 4; ++i_) { const LAS float* sp_ = (stg) + (i_ * 8 + row_) * 64 + ch_ * 8;            \
                const f32x4 a_ = *(const LAS f32x4*)sp_, b_ = *(const LAS f32x4*)(sp_ + 4); const u32x4 g_ = gv_[i_]; u32x4 w_;          \
                w_.x = cvtpk(a_[0] * bf2f(g_.x & 0xffff), a_[1] * bf2f(g_.x >> 16)); w_.y = cvtpk(a_[2] * bf2f(g_.y & 0xffff), a_[3] * bf2f(g_.y >> 16));   \
                w_.z = cvtpk(b_[0] * bf2f(g_.z & 0xffff), b_[1] * bf2f(g_.z >> 16)); w_.w = cvtpk(b_[2] * bf2f(g_.w & 0xffff), b_[3] * bf2f(g_.w >> 16));   \
                *(u32x4*)(Gw + (size_t)(i_ * 8 + row_) * LDX + half_ * 64 + ch_ * 8) = w_; } } } while (0)
    if (VAR != 2) {
#pragma unroll
        for (int r = 0; r < 16; ++r) {
#pragma unroll
            for (int d0 = 0; d0 < 4; ++d0) o[d0][r] *= rli[r]; }
        __syncthreads();
        LAS float* stg = (LAS float*)(lds + wid * 8192);
        STAGE_OUT(stg);
        __syncthreads();
    } else {
        LAS float* cmb = (LAS float*)(lds + L_CMB) + wq * 4096;
        __syncthreads();
        if (map == 1) {
#pragma unroll
            for (int r = 0; r < 16; ++r) { const int orow = crow(r, hi); const float f = rli[r] * lam;
#pragma unroll
                for (int d0 = 0; d0 < 4; ++d0) cmb[orow * 128 + d0 * 32 + r32] = o[d0][r] * f; }
        }
        __syncthreads();
        if (map == 0) {
            float sg[4];
#pragma unroll
            for (int d0 = 0; d0 < 4; ++d0) sg[d0] = subg[d0 * 32 + r32];
#pragma unroll
            for (int r = 0; r < 16; ++r) { const int orow = crow(r, hi); float s = 0.f;
#pragma unroll
                for (int d0 = 0; d0 < 4; ++d0) { const float c = o[d0][r] * rli[r] - cmb[orow * 128 + d0 * 32 + r32]; o[d0][r] = c; s += c * c; }
#pragma unroll
                for (int x = 1; x < 32; x <<= 1) s += __shfl_xor(s, x);
                const float rn = rsqrtf(s * (1.0f / 128.0f) + EPS) * lam1m;
#pragma unroll
                for (int d0 = 0; d0 < 4; ++d0) o[d0][r] *= rn * sg[d0]; }
            LAS float* stg = cmb;
            STAGE_OUT(stg);
        }
        __syncthreads();
    }
#undef STAGE_OUT
#undef ROWP
#undef VMW
#undef SLOAD
#undef SWRITE
#undef RESC
#undef KBASE
#undef MODIFY
#undef HALF_STEP
}

struct OrderTab { unsigned short v[1280]; };
constexpr OrderTab make_order() {
    OrderTab t{}; int n = 0;
    for (int c = 320; c >= 1; --c) {
        if (c % 20 == 0 && c / 20 <= 16) { const int qb = c / 20 - 1; for (int bh = 0; bh < 24; ++bh) t.v[n++] = (unsigned short)(1 | (qb << 2) | (bh << 7)); }
        if (c % 16 == 0 && c / 16 <= 16) { const int qb = c / 16 - 1; for (int bh = 0; bh < 24; ++bh) t.v[n++] = (unsigned short)(0 | (qb << 2) | (bh << 7)); }
        if (c % 7 == 0 && c / 7 <= 32) { const int qb = c / 7 - 1; for (int bh = 0; bh < 16; ++bh) t.v[n++] = (unsigned short)(2 | (qb << 2) | (bh << 7)); }
    }
    return t;
}
__device__ const OrderTab g_order = make_order();
static_assert(make_order().v[1279] != 0 || true, "order table");
}

__device__ __forceinline__ void p3_attention(const Args& args, int layer, LAS unsigned char* lds) {
    const int tid_o = opaque_tid(); const int lane = tid_o & 63;
    const float lam_init = 0.8f - 0.6f * expf(-0.3f * (float)layer);
    const float d1 = wave_sum(args.in[8][layer * 64 + lane] * args.in[9][layer * 64 + lane]), d2 = wave_sum(args.in[10][layer * 64 + lane] * args.in[11][layer * 64 + lane]);
    const float lam = expf(d1) - expf(d2) + lam_init;
    unsigned* ctr = (unsigned*)(args.ws + WS_CTL) + 64 * (1 + layer);
    volatile LAS unsigned* flag = (volatile LAS unsigned*)(lds + att::L_FLAG);
    for (;;) {
        if (tid_o == 0) flag[0] = atomicAdd(ctr, 1u);
        __syncthreads();
        const unsigned idx = flag[0];
        if (idx >= 1280u) break;
        const unsigned code = att::g_order.v[idx]; const int type = code & 3, qb = (code >> 2) & 31, bh = code >> 7;
        if (type == 0) att::attn_unit<0>(args.ws, args.in[13], args.in[12] + layer * 128, lam, 1.0f - lam_init, bh / 6, bh % 6, qb, lds);
        else if (type == 1) att::attn_unit<1>(args.ws, args.in[13], args.in[12] + layer * 128, lam, 1.0f - lam_init, bh / 6, bh % 6, qb, lds);
        else att::attn_unit<2>(args.ws, args.in[13], args.in[12] + layer * 128, lam, 1.0f - lam_init, bh >> 2, bh & 3, qb, lds);
    }
    __syncthreads();
}

__device__ __forceinline__ void p5_final(const Args& args) {
    const int tid_o = opaque_tid();
    const int gw = C_bid * NWAVES + C_wave, NGW = C_G * NWAVES, lane = C_lane;
    for (int m = gw; m < M; m += NGW) {
        float s = lane < 32 ? WSP(float, WS_XSS)[(size_t)m * 32 + lane] : 0.f; s = wave_sum(s);
        const float r = rsqrtf(s * (1.0f / 2048.0f) + EPS);
        f32x4* xr = (f32x4*)(args.out + (size_t)m * DM) + lane; const f32x4* gr = (const f32x4*)args.in[15] + lane;
#pragma unroll
        for (int j = 0; j < 8; ++j) { const f32x4 v = xr[64 * j], g = gr[64 * j]; xr[64 * j] = v * r * g; }
    }
}

typedef GAS unsigned gu32;
#define RLX_AGENT __ATOMIC_RELAXED, __HIP_MEMORY_SCOPE_AGENT
constexpr int CW_BAR = 4096;
constexpr int LDS_BARST = LDS_BYTES - 64;
#define XB_TMO      128
#define XB_XCNT(j)  (256  + 64 * (j))
#define XB_XSUB(j)  (1280 + 64 * (j))
#define XB_XGEN(j)  (2304 + 64 * (j))
#define XB_TOP      3328
#define XB_TOPGEN   3392
#define XCD_BAR_WORDS 3456
#define XB_SPIN_CAP (1u << 18)

__device__ __forceinline__ unsigned xb_ld(unsigned* p)              { return __hip_atomic_load(p, __ATOMIC_RELAXED, __HIP_MEMORY_SCOPE_AGENT); }
__device__ __forceinline__ unsigned xb_add(unsigned* p, unsigned v) { return __hip_atomic_fetch_add(p, v, __ATOMIC_RELAXED, __HIP_MEMORY_SCOPE_AGENT); }
__device__ __forceinline__ unsigned xb_xcc_id() { return (unsigned)__builtin_amdgcn_s_getreg((3 << 11) | 20) & 0xFu; }
#define XB_SPIN(cond, bar) do { unsigned _sp = 0; while (cond) { __builtin_amdgcn_s_sleep(1); \
    if ((++_sp & 255u) == 0u) { if (xb_ld(&(bar)[XB_TMO])) break; if (_sp > XB_SPIN_CAP) { atomicAdd(&(bar)[XB_TMO], 1u); break; } } } } while (0)

struct XcdBarrier {
    unsigned* bar; unsigned x;
    volatile LAS unsigned* st;
};

__device__ __forceinline__ XcdBarrier xcd_barrier_post(unsigned* bar, volatile LAS unsigned* st) {
    XcdBarrier b; b.bar = bar; b.x = xb_xcc_id(); b.st = st;
    if (threadIdx.x == 0) (void)xb_add(&bar[XB_XCNT(b.x)], 1u);
    return b;
}
__device__ __forceinline__ void xcd_barrier_complete(unsigned* bar, unsigned x, unsigned& nloc, unsigned& nx) {
    const unsigned G = gridDim.x * gridDim.y * gridDim.z;
    unsigned sum, cnt, mine, sp = 0u;
    for (;;) {
        sum = 0u; cnt = 0u; mine = 0u;
#pragma unroll
        for (unsigned j = 0; j < 16; ++j) { const unsigned c = xb_ld(&bar[XB_XCNT(j)]); sum += c; cnt += (c > 0u) ? 1u : 0u; mine = (j == x) ? c : mine; }
        if (sum == G) break;
        __builtin_amdgcn_s_sleep(1);
        if ((++sp & 255u) == 0u) { if (xb_ld(&bar[XB_TMO])) break; if (sp > XB_SPIN_CAP) { atomicAdd(&bar[XB_TMO], 1u); break; } }
    }
    nloc = mine > 0u ? mine : 1u; nx = cnt > 0u ? cnt : 1u;
}

__device__ __forceinline__ void xcd_barrier(const XcdBarrier& b) {
    asm volatile("s_waitcnt vmcnt(0)" ::: "memory");
    __syncthreads();
    if (threadIdx.x == 0) {
        unsigned* bar = b.bar;
        __builtin_amdgcn_s_waitcnt(0);
        unsigned nloc = b.st[0], nx = b.st[1];
        if (nloc == 0u) { xcd_barrier_complete(bar, b.x, nloc, nx); b.st[0] = nloc; b.st[1] = nx; }
        const unsigned old = xb_add(&bar[XB_XSUB(b.x)], 1u);
        const unsigned gen = old / nloc;
        if (old + 1u == (gen + 1u) * nloc) {
            __builtin_amdgcn_fence(__ATOMIC_RELEASE, "agent");
            asm volatile("s_waitcnt vmcnt(0)" ::: "memory");
            const unsigned og = xb_add(&bar[XB_TOP], 1u);
            const unsigned tg = og / nx;
            if (og + 1u == (tg + 1u) * nx) xb_add(&bar[XB_TOPGEN], 1u);
            else XB_SPIN(xb_ld(&bar[XB_TOPGEN]) == tg, bar);
            __builtin_amdgcn_fence(__ATOMIC_ACQUIRE, "agent");
            xb_add(&bar[XB_XGEN(b.x)], 1u);
            asm volatile("s_waitcnt vmcnt(0)" ::: "memory");
        } else {
            XB_SPIN(xb_ld(&bar[XB_XGEN(b.x)]) == gen, bar);
            __builtin_amdgcn_fence(__ATOMIC_ACQUIRE, "agent");
            asm volatile("s_waitcnt vmcnt(0)" ::: "memory");
        }
    }
    __syncthreads();
}

#ifndef PROBE_REP1
#define PROBE_REP1 0
#endif
#ifndef PROBE_REP4
#define PROBE_REP4 0
#endif
#ifndef MK_NAIVE_ATTN
#define MK_NAIVE_ATTN 0
#endif
#ifndef MK_FUSED
#define MK_FUSED 1
#endif
constexpr int N_PHASES = 10;

__global__ void __launch_bounds__(NTHREADS, 2) fwd_kernel(Args args) {
    extern __shared__ __attribute__((aligned(16))) unsigned char lds_raw[];
    LAS unsigned char* lds = (LAS unsigned char*)lds_raw;
    const int lo = args.ph_lo, hi = args.ph_hi;
#if MK_FUSED
    if (threadIdx.x < 4) ((LAS unsigned*)(lds + LDS_BARST))[threadIdx.x] = 0u;
    __syncthreads();
    if (args.ph_lo < 0) cg::this_grid().sync();
    XcdBarrier bar = xcd_barrier_post((unsigned*)(args.ws + WS_CTL) + CW_BAR, (volatile LAS unsigned*)(lds + LDS_BARST));
#endif
#ifndef PH_MASK
#define PH_MASK 0x3ff
#endif
#define IN(k) (((PH_MASK >> ((k) > 4 ? (k) - 4 : (k))) & 1) && lo <= (k) && (k) < hi)
#if MK_FUSED
#define SEAM(k) do { if (IN(k) && IN((k) + 1)) { xcd_barrier(bar); } } while (0)
#else
#define SEAM(k) do { } while (0)
#endif
    if (IN(0)) { p0_prologue(args, lds); __syncthreads(); }
    SEAM(0);
#pragma unroll 1
    for (int l = 0; l < DEPTH; ++l) {
        const int pb = 1 + 4 * l;
        if (IN(pb)) {
            pg8::Gemm g{WSP(bf16, WS_XB), (const bf16*)(args.ws + WS_WIN + (size_t)l * WIN_BYTES), M, NIN_PAD, DM, LDX, LDX}; pg8::StaticOrder S; S.init(M, NIN_PAD, C_G, C_bid);
            pg8::EpiIn E{args.ws, args.in[3] + l * 6};
            pg8::gemm_phase<pg8::EpiIn, pg8::StaticOrder, true, true>(lds, g, S, E);
#if PROBE_REP1
            if (l == 0) { __syncthreads(); pg8::gemm_phase<pg8::EpiIn, pg8::StaticOrder, true, true>(lds, g, S, E); }
#endif
        }
        SEAM(pb);
        if (IN(pb + 1)) {
            p2_scan(args);
            { pg8::Gemm g{WSP(bf16, WS_CQ), WSP(bf16, WS_WUQ) + (size_t)l * NUQ_PAD * 512, M, NUQ_PAD, 512, 512, 512}; pg8::StaticOrder S; S.init(M, NUQ_PAD, C_G, C_bid);
              pg8::EpiUq E{args.ws};
              pg8::gemm_phase<pg8::EpiUq, pg8::StaticOrder, true, true>(lds, g, S, E); }
            { pg8::Gemm g{WSP(bf16, WS_CKV), WSP(bf16, WS_WUKV) + (size_t)l * NUKV * 256, M, NUKV, 256, 256, 256}; pg8::StaticOrder S; S.init(M, NUKV, C_G, (C_bid + 128) % C_G);
              pg8::EpiUkv E{args.ws};
              pg8::gemm_phase<pg8::EpiUkv, pg8::StaticOrder, true, true>(lds, g, S, E); }
        }
        SEAM(pb + 1);
        if (IN(pb + 2)) {
#if MK_NAIVE_ATTN
            p3_naive(args, l, lds); __syncthreads();
#else
            p3_attention(args, l, lds);
#endif
        }
        SEAM(pb + 2);
        if (IN(pb + 3)) {
            pg8::Gemm g{WSP(bf16, WS_G), (const bf16*)(args.ws + WS_WOUT + (size_t)l * WOUT_BYTES), M, DM, DM, LDX, LDX}; pg8::StaticOrder S; S.init(M, DM, C_G, C_bid);
            pg8::EpiOut E{l == 0 ? args.in[0] : args.out, args.out, args.ws, l + 1 < DEPTH};
            pg8::gemm_phase<pg8::EpiOut, pg8::StaticOrder, true, true>(lds, g, S, E);
#if PROBE_REP4
            if (l == 0) { __syncthreads(); pg8::gemm_phase<pg8::EpiOut, pg8::StaticOrder, true, true>(lds, g, S, E); }
#endif
        }
        SEAM(pb + 3);
    }
    if (IN(9)) p5_final(args);
#undef IN
#undef SEAM
}

extern "C" void kernel_launch(void* const* d_in, const int* in_sizes, int n_in, void* d_out, int out_size, void* d_ws, size_t ws_size, hipStream_t stream) {
    static int grid = 0;
    if (grid == 0) {
        if (n_in != 16 || in_sizes[0] != M * DM || out_size != M * DM || ws_size < WS_END) {
            fprintf(stderr, "kernel_launch: unexpected shapes (n_in %d, in0 %d, out %d, ws %zu; need ws >= %zu)\n", n_in, n_in > 0 ? in_sizes[0] : -1, out_size, ws_size, (size_t)WS_END); grid = -1; return; }
        int dev = 0, cus = 0, per_cu = 0;
        if (hipGetDevice(&dev) != hipSuccess || hipDeviceGetAttribute(&cus, hipDeviceAttributeMultiprocessorCount, dev) != hipSuccess) { fprintf(stderr, "kernel_launch: device query failed\n"); grid = -1; return; }
        if (hipFuncSetAttribute((const void*)fwd_kernel, hipFuncAttributeMaxDynamicSharedMemorySize, LDS_BYTES) != hipSuccess) { fprintf(stderr, "kernel_launch: hipFuncSetAttribute failed\n"); grid = -1; return; }
        if (hipOccupancyMaxActiveBlocksPerMultiprocessor(&per_cu, (const void*)fwd_kernel, NTHREADS, LDS_BYTES) != hipSuccess || per_cu < 1) {
            fprintf(stderr, "kernel_launch: occupancy query reports %d blocks per CU\n", per_cu); (void)hipGetLastError(); grid = -1; return; }
        grid = cus;
    }
    if (grid < 0) return;
    if (hipMemsetAsync((char*)d_ws + WS_CTL, 0, 65536, stream) != hipSuccess) { fprintf(stderr, "kernel_launch: memset failed\n"); return; }
    Args a{};
    for (int i = 0; i < 16; ++i) a.in[i] = (const float*)d_in[i];
    a.out = (float*)d_out; a.ws = (unsigned char*)d_ws;
#if MK_FUSED
    a.ph_lo = 0; a.ph_hi = N_PHASES;
    void* kargs[] = {&a};
    hipError_t e = hipLaunchCooperativeKernel((const void*)fwd_kernel, dim3(grid), dim3(NTHREADS), kargs, LDS_BYTES, stream);
    if (e != hipSuccess) fprintf(stderr, "kernel_launch: cooperative launch failed: %s (grid %d)\n", hipGetErrorString(e), grid);
#else
    for (int p = 0; p < N_PHASES; ++p) {
        a.ph_lo = p; a.ph_hi = p + 1;
        hipLaunchKernelGGL(fwd_kernel, dim3(grid), dim3(NTHREADS), LDS_BYTES, stream, a);
    }
#endif
}
```
